# Optimizing an MI355X kernel written in HIP

```python
import math
import jax, jax.numpy as jnp
from jax import lax
import numpy as np

D_MODEL = 1024
BATCH = 8
SEQ = 4096
DEPTH = 1

N_META = 16
BLOCK = 128
PAD = BLOCK - N_META
RET_HEADS = 4
RET_DK = 128
RET_DV = 128
FOX_HEADS = 8
FOX_HD = 64
MIX_WIDTH = RET_HEADS * RET_DV + FOX_HEADS * FOX_HD
IN_SIZES = (RET_HEADS * RET_DK, RET_HEADS * RET_DK, RET_HEADS * RET_DV, RET_HEADS * RET_DV, FOX_HEADS * FOX_HD, FOX_HEADS * FOX_HD, FOX_HEADS * FOX_HD, FOX_HEADS)
IN_COLS = sum(IN_SIZES)
N_EXPERTS = 64
TOP_K = 6
N_GROUPS = 8
TOPK_GROUPS = 4
EXPERT_FF = 256
SHARED_FF = 256
ROUTED_SCALE = 2.5
DISPATCH_BLOCK = 128
ROPE_BASE = 10000.0
LN_EPS = 1e-5
NEG_INF = -1e30
ALPHA = (2.0 * DEPTH) ** 0.25
BETA = (8.0 * DEPTH) ** -0.25

kernel_name = 'hybrid_retention_fox_moe_block'


def layer_norm(x, g, b):
    xf = x.astype(jnp.float32)
    xc = xf - jnp.mean(xf, -1, keepdims=True)
    var = jnp.mean(xc * xc, -1, keepdims=True)
    y = xc * lax.rsqrt(var + LN_EPS) * g.astype(jnp.float32) + b.astype(jnp.float32)
    return y.astype(x.dtype)


def head_norm(y):
    yc = y - jnp.mean(y, -1, keepdims=True)
    return yc * lax.rsqrt(jnp.mean(yc * yc, -1, keepdims=True) + LN_EPS)


def rotary(t, pos):
    half = t.shape[-1] // 2
    inv = ROPE_BASE ** (-jnp.arange(half, dtype=jnp.float32) / half)
    ang = pos[:, None] * inv[None, :]
    cos = jnp.cos(ang)[None, :, None, :]
    sin = jnp.sin(ang)[None, :, None, :]
    t1, t2 = t[..., :half], t[..., half:]
    return jnp.concatenate([t1 * cos - t2 * sin, t2 * cos + t1 * sin], -1)


def retention(q, k, v):
    b, lp, h, dk = q.shape
    dv = v.shape[-1]
    nc = lp // BLOCK
    lg = jnp.log1p(-jnp.exp2(-5.0 - jnp.arange(h, dtype=jnp.float32)))
    idx = jnp.arange(BLOCK, dtype=jnp.float32)
    rel = idx[:, None] - idx[None, :]
    causal = rel >= 0
    dmask = jnp.where(causal[None], jnp.exp(jnp.where(causal, rel, 0.0)[None] * lg[:, None, None]), 0.0)
    zeta = jnp.exp((BLOCK - 1.0 - idx)[None, :] * lg[:, None])
    xi = jnp.exp((idx + 1.0)[None, :] * lg[:, None])
    g_chunk = jnp.exp(BLOCK * lg)
    qc = q.reshape(b, nc, BLOCK, h, dk)
    kc = k.reshape(b, nc, BLOCK, h, dk)
    vc = v.reshape(b, nc, BLOCK, h, dv)
    scores = jnp.einsum('bnihd,bnjhd->bnhij', qc, kc) * dmask[None, None]
    inner = jnp.einsum('bnhij,bnjhe->bnihe', scores, vc)
    kv = jnp.einsum('bnjhd,hj,bnjhe->bnhde', kc, zeta, vc)

    def step(state, kv_n):
        return g_chunk[None, :, None, None] * state + kv_n, state

    _, prev = lax.scan(step, jnp.zeros((b, h, dk, dv), q.dtype), jnp.moveaxis(kv, 1, 0))
    prev = jnp.moveaxis(prev, 0, 1)
    cross = jnp.einsum('bnihd,hi,bnhde->bnihe', qc, xi, prev)
    return (inner + cross).reshape(b, lp, h, dv)


def forgetting_attention(q, k, v, logf):
    b, lp, h, d = q.shape
    scale = d ** -0.5
    c = jnp.transpose(jnp.cumsum(logf, axis=1), (0, 2, 1))
    kpos = jnp.arange(lp)
    outs = []
    for i in range(lp // BLOCK):
        q0, kend = i * BLOCK, (i + 1) * BLOCK
        s = jnp.einsum('bqhd,bkhd->bhqk', q[:, q0:kend], k[:, :kend]) * scale
        s = s + c[:, :, q0:kend, None] - c[:, :, None, :kend]
        qpos = jnp.arange(q0, kend)
        mask = (kpos[None, :kend] <= qpos[:, None]) & (kpos[None, :kend] >= PAD)
        p = jax.nn.softmax(jnp.where(mask[None, None], s, NEG_INF), axis=-1)
        outs.append(jnp.einsum('bhqk,bkhd->bqhd', p, v[:, :kend]))
    return jnp.concatenate(outs, axis=1)


def hybrid_mixer(h, w_in, b_forget, w_out):
    b, l, _ = h.shape
    lp = l + PAD
    proj = jnp.einsum('bld,dc->blc', h, w_in).astype(jnp.float32)
    points, acc = [], 0
    for sz in IN_SIZES[:-1]:
        acc += sz
        points.append(acc)
    rq, rk, rv, rg, fq, fk, fv, ff = jnp.split(proj, points, axis=-1)
    logf = jax.nn.log_sigmoid(ff + b_forget.astype(jnp.float32))

    def pad(t):
        return jnp.pad(t, ((0, 0), (PAD, 0), (0, 0)))

    def heads(t, nh):
        return pad(t).reshape(b, lp, nh, -1)

    pos = jnp.arange(lp, dtype=jnp.float32) - PAD
    ret = retention(rotary(heads(rq, RET_HEADS), pos),
                    rotary(heads(rk, RET_HEADS), pos) * (RET_DK ** -0.5),
                    heads(rv, RET_HEADS))[:, PAD:]
    ret = head_norm(ret).reshape(b, l, RET_HEADS * RET_DV) * jax.nn.silu(rg)
    fox = forgetting_attention(heads(fq, FOX_HEADS), heads(fk, FOX_HEADS), heads(fv, FOX_HEADS), pad(logf))[:, PAD:]
    fox = fox.reshape(b, l, FOX_HEADS * FOX_HD)
    mixed = jnp.concatenate([ret, fox], axis=-1).astype(h.dtype)
    return jnp.einsum('blc,cd->bld', mixed, w_out)


def swiglu(t, wg, wu, wd):
    return (jax.nn.silu(t @ wg) * (t @ wu)) @ wd


def routed_experts(t, w_router, router_bias, we_gate, we_up, we_down):
    n, d = t.shape
    scores = jax.nn.sigmoid((t @ w_router).astype(jnp.float32))
    biased = scores + router_bias.astype(jnp.float32)
    grp = biased.reshape(n, N_GROUPS, N_EXPERTS // N_GROUPS)
    group_score = jnp.sum(lax.top_k(grp, 2)[0], axis=-1)
    _, top_groups = lax.top_k(group_score, TOPK_GROUPS)
    gmask = jnp.any(top_groups[:, :, None] == jnp.arange(N_GROUPS)[None, None, :], axis=1)
    emask = jnp.repeat(gmask, N_EXPERTS // N_GROUPS, axis=1)
    _, top_e = lax.top_k(jnp.where(emask, biased, NEG_INF), TOP_K)
    gates = jnp.take_along_axis(scores, top_e, axis=1)
    gates = gates / jnp.sum(gates, -1, keepdims=True) * ROUTED_SCALE
    nk = n * TOP_K
    e_flat = top_e.reshape(nk)
    tok_flat = jnp.repeat(jnp.arange(n, dtype=jnp.int32), TOP_K)
    order = jnp.argsort(e_flat)
    e_s, tok_s, g_s = e_flat[order], tok_flat[order], gates.reshape(nk)[order]
    counts = jnp.bincount(e_flat, length=N_EXPERTS)
    padded = (counts + DISPATCH_BLOCK - 1) // DISPATCH_BLOCK * DISPATCH_BLOCK
    start = jnp.cumsum(counts) - counts
    pend = jnp.cumsum(padded)
    pstart = pend - padded
    dest = pstart[e_s] + jnp.arange(nk, dtype=jnp.int32) - start[e_s]
    n_blocks = -(-(nk + N_EXPERTS * (DISPATCH_BLOCK - 1)) // DISPATCH_BLOCK)
    rows = n_blocks * DISPATCH_BLOCK
    buf_tok = jnp.full((rows,), n, jnp.int32).at[dest].set(tok_s)
    buf_gate = jnp.zeros((rows,), jnp.float32).at[dest].set(g_s)
    blk_e = jnp.minimum(jnp.searchsorted(pend, jnp.arange(n_blocks, dtype=jnp.int32) * DISPATCH_BLOCK, side='right'), N_EXPERTS - 1)
    t_pad = jnp.concatenate([t, jnp.zeros((1, d), t.dtype)], axis=0)

    def step(acc, blk):
        tok, gate, e = blk
        y = swiglu(t_pad[tok], we_gate[e], we_up[e], we_down[e])
        return acc.at[tok].add(y * gate[:, None].astype(y.dtype)), None

    acc, _ = lax.scan(step, jnp.zeros((n + 1, d), t.dtype),
                      (buf_tok.reshape(n_blocks, DISPATCH_BLOCK), buf_gate.reshape(n_blocks, DISPATCH_BLOCK), blk_e))
    return acc[:n]


def setup_inputs(seed: int = 0) -> dict:
    key = jax.random.key(seed)
    ks = jax.random.split(key, 19)

    def nrm(k, shape, scale):
        return jax.random.normal(k, shape, jnp.float32) * scale

    return {
        'x': nrm(ks[0], (BATCH, SEQ, D_MODEL), 1.0),
        'meta': nrm(ks[1], (N_META, D_MODEL), 1.0),
        'ln0_g': 1.0 + nrm(ks[2], (D_MODEL,), 0.01),
        'ln0_b': nrm(ks[3], (D_MODEL,), 0.01),
        'w_in': nrm(ks[4], (DEPTH, D_MODEL, IN_COLS), D_MODEL ** -0.5),
        'b_forget': jax.random.uniform(ks[5], (DEPTH, FOX_HEADS), jnp.float32, 1.0, 4.0),
        'w_out': nrm(ks[6], (DEPTH, MIX_WIDTH, D_MODEL), BETA * MIX_WIDTH ** -0.5),
        'ln1_g': 1.0 + nrm(ks[7], (DEPTH, D_MODEL), 0.01),
        'ln1_b': nrm(ks[8], (DEPTH, D_MODEL), 0.01),
        'w_router': nrm(ks[9], (DEPTH, D_MODEL, N_EXPERTS), D_MODEL ** -0.5),
        'router_bias': nrm(ks[10], (DEPTH, N_EXPERTS), 0.01),
        'we_gate': nrm(ks[11], (DEPTH, N_EXPERTS, D_MODEL, EXPERT_FF), D_MODEL ** -0.5),
        'we_up': nrm(ks[12], (DEPTH, N_EXPERTS, D_MODEL, EXPERT_FF), D_MODEL ** -0.5),
        'we_down': nrm(ks[13], (DEPTH, N_EXPERTS, EXPERT_FF, D_MODEL), BETA * EXPERT_FF ** -0.5),
        'ws_gate': nrm(ks[14], (DEPTH, D_MODEL, SHARED_FF), D_MODEL ** -0.5),
        'ws_up': nrm(ks[15], (DEPTH, D_MODEL, SHARED_FF), D_MODEL ** -0.5),
        'ws_down': nrm(ks[16], (DEPTH, SHARED_FF, D_MODEL), BETA * SHARED_FF ** -0.5),
        'ln2_g': 1.0 + nrm(ks[17], (DEPTH, D_MODEL), 0.01),
        'ln2_b': nrm(ks[18], (DEPTH, D_MODEL), 0.01),
    }


def reference(x, meta, ln0_g, ln0_b, w_in, b_forget, w_out, ln1_g, ln1_b, w_router, router_bias,
              we_gate, we_up, we_down, ws_gate, ws_up, ws_down, ln2_g, ln2_b):
    b, s, d = x.shape
    h = jnp.concatenate([jnp.broadcast_to(meta[None].astype(x.dtype), (b, N_META, d)), x], axis=1)
    h = layer_norm(h, ln0_g, ln0_b)
    l = h.shape[1]
    for i in range(DEPTH):
        h = layer_norm(ALPHA * h + hybrid_mixer(h, w_in[i], b_forget[i], w_out[i]), ln1_g[i], ln1_b[i])
        t = h.reshape(b * l, d)
        moe = swiglu(t, ws_gate[i], ws_up[i], ws_down[i]) + routed_experts(t, w_router[i], router_bias[i], we_gate[i], we_up[i], we_down[i])
        h = layer_norm(ALPHA * h + moe.reshape(b, l, d), ln2_g[i], ln2_b[i])
    return h[:, N_META:]
```

```cpp
#include <hip/hip_runtime.h>
#include <stdint.h>
#include <cstdio>

typedef unsigned short bf16_t;

constexpr int NB = 8, SEQ = 4096, DM = 1024, NMETA = 16, NX = NB * SEQ;
constexpr int LT = 4352;
constexpr int XPOS0 = 256;
constexpr int RMETA0 = 240;
constexpr int FMETA0 = 128;
constexpr int INC = 3592, NEXP = 64, TOPK = 6, EFF = 256;
constexpr int CAP = 32768;
constexpr float LN_EPS = 1e-5f;
constexpr float ALPHA = 1.189207115002721f;
constexpr float LOG2E = 1.4426950408889634f;
constexpr float C2 = 0.125f * LOG2E;
constexpr float RK_SCALE = 0.08838834764831845f;
constexpr float ROUTED_SCALE = 2.5f;

constexpr size_t MiB = 1u << 20;
constexpr size_t WS_CTL = 0;
constexpr size_t WS_LOGF = 1 * MiB;
constexpr size_t WS_BIAS = 3 * MiB;
constexpr size_t WS_ASG = 5 * MiB;
constexpr size_t WS_TOKL = 6 * MiB;
constexpr size_t WS_GATEL = 14 * MiB;
constexpr size_t WS_LOGITS = 22 * MiB;
constexpr size_t WS_XN = 30 * MiB;
constexpr size_t WS_A = 96 * MiB;
constexpr size_t BUFE = (size_t)NB * LT * 512;
constexpr size_t WS_RQ = WS_A;
constexpr size_t WS_MIXED = WS_A + 7 * BUFE * 2;
constexpr size_t WS_Y = WS_A;
constexpr size_t WS_END = 512 * MiB;
constexpr int CW_CNT = 1024;

__device__ __forceinline__ float bf2f(bf16_t v) { return __uint_as_float(((unsigned)v) << 16); }
__device__ __forceinline__ bf16_t f2bf(float f) { unsigned u = __float_as_uint(f); return (bf16_t)((u + 0x7fffu + ((u >> 16) & 1u)) >> 16); }
__device__ __forceinline__ float wave_sum(float v) {
#pragma unroll
    for (int o = 1; o < 64; o <<= 1) v += __shfl_xor(v, o);
    return v;
}

__global__ void __launch_bounds__(256) k_ln0(const float* __restrict__ x, const float* __restrict__ meta, const float* __restrict__ g, const float* __restrict__ bta,
                                            const float* __restrict__ w_in, const float* __restrict__ b_forget, bf16_t* XN, float* LOGF) {
    __shared__ float wf[1024 * 8];
    for (int i = threadIdx.x; i < 1024 * 8; i += 256) { int k = i >> 3, h = i & 7; wf[i] = w_in[(size_t)k * INC + 3584 + h]; }
    __syncthreads();
    const int lane = threadIdx.x & 63, wave = threadIdx.x >> 6;
    const int gw = blockIdx.x * 4 + wave, ngw = gridDim.x * 4;
    for (int row = gw; row < NX + NMETA; row += ngw) {
        const float* src = row < NX ? x + (size_t)row * DM : meta + (size_t)(row - NX) * DM;
        float4 v[4]; float s = 0.f;
#pragma unroll
        for (int j = 0; j < 4; ++j) { v[j] = ((const float4*)src)[lane + 64 * j]; s += (v[j].x + v[j].y) + (v[j].z + v[j].w); }
        const float mean = wave_sum(s) * (1.f / DM);
        float s2 = 0.f;
#pragma unroll
        for (int j = 0; j < 4; ++j) { v[j].x -= mean; v[j].y -= mean; v[j].z -= mean; v[j].w -= mean; s2 += (v[j].x * v[j].x + v[j].y * v[j].y) + (v[j].z * v[j].z + v[j].w * v[j].w); }
        const float rstd = 1.f / sqrtf(wave_sum(s2) * (1.f / DM) + LN_EPS);
        float f[8];
#pragma unroll
        for (int h = 0; h < 8; ++h) f[h] = 0.f;
#pragma unroll
        for (int j = 0; j < 4; ++j) {
            const float4 gg = ((const float4*)g)[lane + 64 * j], bb = ((const float4*)bta)[lane + 64 * j];
            float y0 = v[j].x * rstd * gg.x + bb.x, y1 = v[j].y * rstd * gg.y + bb.y, y2 = v[j].z * rstd * gg.z + bb.z, y3 = v[j].w * rstd * gg.w + bb.w;
            uint2 o; o.x = (unsigned)f2bf(y0) | ((unsigned)f2bf(y1) << 16); o.y = (unsigned)f2bf(y2) | ((unsigned)f2bf(y3) << 16);
            ((uint2*)(XN + (size_t)row * DM))[lane + 64 * j] = o;
            const int k0 = 4 * (lane + 64 * j);
#pragma unroll
            for (int h = 0; h < 8; ++h) f[h] += y0 * wf[(k0 + 0) * 8 + h] + y1 * wf[(k0 + 1) * 8 + h] + y2 * wf[(k0 + 2) * 8 + h] + y3 * wf[(k0 + 3) * 8 + h];
        }
        float z = 0.f;
#pragma unroll
        for (int h = 0; h < 8; ++h) { const float t = wave_sum(f[h]); if (lane == h) z = t; }
        if (lane < 8) { z += b_forget[lane]; LOGF[(size_t)row * 8 + lane] = fminf(z, 0.f) - log1pf(expf(-fabsf(z))); }
    }
}

__global__ void __launch_bounds__(64) k_bias(const float* __restrict__ LOGF, float* BIAS) {
    const int bh = blockIdx.x, b = bh >> 3, h = bh & 7, lane = threadIdx.x;
    float* out = BIAS + (size_t)bh * LT;
    for (int p = lane; p < XPOS0; p += 64) if (p < FMETA0 || p >= FMETA0 + NMETA) out[p] = -1e30f;
    float carry = 0.f;
    for (int t0 = 0; t0 < NMETA + SEQ; t0 += 64) {
        const int t = t0 + lane; float v = 0.f;
        if (t < NMETA + SEQ) { const int row = t < NMETA ? NX + t : b * SEQ + t - NMETA; v = LOGF[(size_t)row * 8 + h]; }
#pragma unroll
        for (int o = 1; o < 64; o <<= 1) { const float u = __shfl_up(v, o); if (lane >= o) v += u; }
        v += carry;
        if (t < NMETA + SEQ) { const int pos = t < NMETA ? FMETA0 + t : XPOS0 + t - NMETA; out[pos] = -v * LOG2E; }
        carry = __shfl(v, 63);
    }
}

template <class AF, class BF, class EF>
__global__ void __launch_bounds__(256) naive_gemm(int M, int N, int K, int padarg, AF af, BF bf, EF ef) {
    __shared__ float As[16][65];
    __shared__ float Bs[16][65];
    const int tx = threadIdx.x & 15, ty = threadIdx.x >> 4;
    const int m0 = blockIdx.y * 64, n0 = blockIdx.x * 64;
    float acc[4][4];
#pragma unroll
    for (int i = 0; i < 4; ++i)
#pragma unroll
        for (int j = 0; j < 4; ++j) acc[i][j] = 0.f;
    for (int k0 = 0; k0 < K; k0 += 16) {
        for (int i = threadIdx.x; i < 1024; i += 256) { const int m = i >> 4, k = i & 15; As[k][m] = (m0 + m < M) ? af(m0 + m, k0 + k) : 0.f; }
        for (int i = threadIdx.x; i < 1024; i += 256) { const int k = i >> 6, n = i & 63; Bs[k][n] = (n0 + n < N) ? bf(k0 + k, n0 + n) : 0.f; }
        __syncthreads();
#pragma unroll
        for (int k = 0; k < 16; ++k) {
            float a[4], b[4];
#pragma unroll
            for (int i = 0; i < 4; ++i) { a[i] = As[k][ty * 4 + i]; b[i] = Bs[k][tx * 4 + i]; }
#pragma unroll
            for (int i = 0; i < 4; ++i)
#pragma unroll
                for (int j = 0; j < 4; ++j) acc[i][j] += a[i] * b[j];
        }
        __syncthreads();
    }
#pragma unroll
    for (int i = 0; i < 4; ++i)
#pragma unroll
        for (int j = 0; j < 4; ++j) { const int m = m0 + ty * 4 + i, n = n0 + tx * 4 + j; if (m < M && n < N) ef(m, n, acc[i][j]); }
}
struct AF_bf16 { const bf16_t* p; int ld; int pad; __device__ float operator()(int m, int k) const { return bf2f(p[(size_t)m * ld + k]); } };
struct BF_f32 { const float* p; int ld; int pad; __device__ float operator()(int k, int n) const { return p[(size_t)k * ld + n]; } };
struct EF_inproj {
    bf16_t* bufs;
    __device__ void operator()(int row, int col, float v) const {
        const int g = col >> 9, cc = col & 511;
        if (g == 1) v *= RK_SCALE; else if (g == 3) v = v / (1.f + __expf(-v)); else if (g == 4) v *= C2;
        const bf16_t o = f2bf(v);
        bf16_t* base = bufs + (size_t)g * BUFE;
        if (row < NX) { const int b = row >> 12, i = row & 4095; base[((size_t)b * LT + XPOS0 + i) * 512 + cc] = o; }
        else { const int pos = (g < 4 ? RMETA0 : FMETA0) + (row - NX); for (int b = 0; b < NB; ++b) base[((size_t)b * LT + pos) * 512 + cc] = o; }
    }
};
struct EF_outproj { float* y; const bf16_t* XN; __device__ void operator()(int row, int col, float v) const { const size_t o = (size_t)row * DM + col; y[o] = v + ALPHA * bf2f(XN[o]); } };
struct EF_store { float* p; int ld; int pad; __device__ void operator()(int row, int col, float v) const { p[(size_t)row * ld + col] = v; } };

__global__ void __launch_bounds__(256) k_rotary(bf16_t* RQ, bf16_t* RK) {
    const size_t idx = (size_t)blockIdx.x * 256 + threadIdx.x;
    if (idx >= (size_t)NB * (NMETA + SEQ) * 256) return;
    const int j = (int)(idx & 63), h = (int)((idx >> 6) & 3); const size_t r = idx >> 8; const int t = (int)(r % (NMETA + SEQ)), b = (int)(r / (NMETA + SEQ));
    const int pos = RMETA0 + t;
    const double inv = exp2(-(double)j * (13.287712379549449 / 64.0));
    double rv = (double)t * inv * 0.15915494309189535; rv -= floor(rv);
    const float fr = (float)rv, s = __builtin_amdgcn_sinf(fr), c = __builtin_amdgcn_cosf(fr);
    bf16_t* p = RQ + ((size_t)b * LT + pos) * 512 + h * 128 + j;
    float x1 = bf2f(p[0]), x2 = bf2f(p[64]); p[0] = f2bf(x1 * c - x2 * s); p[64] = f2bf(x2 * c + x1 * s);
    p = RK + ((size_t)b * LT + pos) * 512 + h * 128 + j;
    x1 = bf2f(p[0]); x2 = bf2f(p[64]); p[0] = f2bf(x1 * c - x2 * s); p[64] = f2bf(x2 * c + x1 * s);
}

__device__ __forceinline__ void unpack8(const uint4 u, float* d) {
    d[0] = __uint_as_float(u.x << 16); d[1] = __uint_as_float(u.x & 0xffff0000u); d[2] = __uint_as_float(u.y << 16); d[3] = __uint_as_float(u.y & 0xffff0000u);
    d[4] = __uint_as_float(u.z << 16); d[5] = __uint_as_float(u.z & 0xffff0000u); d[6] = __uint_as_float(u.w << 16); d[7] = __uint_as_float(u.w & 0xffff0000u);
}

__global__ void __launch_bounds__(64) k_ret_naive(const bf16_t* __restrict__ RQ, const bf16_t* __restrict__ RK, const bf16_t* __restrict__ RV, const bf16_t* __restrict__ RG, bf16_t* MIXED) {
    __shared__ float Ks[64 * 128];
    __shared__ float Vs[64 * 128];
    const int blk = blockIdx.x, qt = blk & 63, h = (blk >> 6) & 3, b = blk >> 8, lane = threadIdx.x;
    const int i = qt * 64 + lane, qpos = XPOS0 + i;
    const float lg2g = log2f(1.f - exp2f(-5.f - (float)h));
    float q[128], o[128];
    const bf16_t* qp = RQ + ((size_t)b * LT + qpos) * 512 + h * 128;
#pragma unroll
    for (int d = 0; d < 128; d += 8) unpack8(*(const uint4*)(qp + d), q + d);
#pragma unroll
    for (int e = 0; e < 128; ++e) o[e] = 0.f;
    const int last_pos = XPOS0 + qt * 64 + 63;
    for (int kp0 = 192; kp0 <= last_pos; kp0 += 64) {
        __syncthreads();
        for (int c = lane; c < 1024; c += 64) {
            const int key = c >> 4, d8 = (c & 15) * 8; const size_t off = ((size_t)b * LT + kp0 + key) * 512 + h * 128 + d8;
            unpack8(*(const uint4*)(RK + off), Ks + key * 128 + d8); unpack8(*(const uint4*)(RV + off), Vs + key * 128 + d8);
        }
        __syncthreads();
        for (int s = 0; s < 64; ++s) {
            const int kpos = kp0 + s;
            if (kpos < RMETA0) continue;
            float sc = 0.f;
#pragma unroll
            for (int d = 0; d < 128; d += 4) { const float4 kk = *(const float4*)(Ks + s * 128 + d); sc += q[d] * kk.x + q[d + 1] * kk.y + q[d + 2] * kk.z + q[d + 3] * kk.w; }
            const float w = (kpos <= qpos) ? sc * exp2f((float)(qpos - kpos) * lg2g) : 0.f;
#pragma unroll
            for (int e = 0; e < 128; e += 4) { const float4 vv = *(const float4*)(Vs + s * 128 + e); o[e] += w * vv.x; o[e + 1] += w * vv.y; o[e + 2] += w * vv.z; o[e + 3] += w * vv.w; }
        }
    }
    float mean = 0.f;
#pragma unroll
    for (int e = 0; e < 128; ++e) mean += o[e];
    mean *= (1.f / 128.f);
    float var = 0.f;
#pragma unroll
    for (int e = 0; e < 128; ++e) { o[e] -= mean; var += o[e] * o[e]; }
    const float rstd = 1.f / sqrtf(var * (1.f / 128.f) + LN_EPS);
    const bf16_t* gp = RG + ((size_t)b * LT + qpos) * 512 + h * 128;
    bf16_t* op = MIXED + ((size_t)b * SEQ + i) * DM + h * 128;
#pragma unroll
    for (int e = 0; e < 128; e += 8) {
        float gg[8]; unpack8(*(const uint4*)(gp + e), gg);
        uint4 w;
        w.x = (unsigned)f2bf(o[e] * rstd * gg[0]) | ((unsigned)f2bf(o[e + 1] * rstd * gg[1]) << 16);
        w.y = (unsigned)f2bf(o[e + 2] * rstd * gg[2]) | ((unsigned)f2bf(o[e + 3] * rstd * gg[3]) << 16);
        w.z = (unsigned)f2bf(o[e + 4] * rstd * gg[4]) | ((unsigned)f2bf(o[e + 5] * rstd * gg[5]) << 16);
        w.w = (unsigned)f2bf(o[e + 6] * rstd * gg[6]) | ((unsigned)f2bf(o[e + 7] * rstd * gg[7]) << 16);
        *(uint4*)(op + e) = w;
    }
}

__global__ void __launch_bounds__(64) k_fox_naive(const bf16_t* __restrict__ FQ, const bf16_t* __restrict__ FK, const bf16_t* __restrict__ FV, const float* __restrict__ BIAS, bf16_t* MIXED) {
    __shared__ float Ks[64 * 64];
    __shared__ float Vs[64 * 64];
    __shared__ float Bsh[64];
    const int blk = blockIdx.x, qt = blk & 63, h = (blk >> 6) & 7, b = blk >> 9, lane = threadIdx.x;
    const int i = qt * 64 + lane, qpos = XPOS0 + i;
    float q[64], o[64];
    const bf16_t* qp = FQ + ((size_t)b * LT + qpos) * 512 + h * 64;
#pragma unroll
    for (int d = 0; d < 64; d += 8) unpack8(*(const uint4*)(qp + d), q + d);
#pragma unroll
    for (int e = 0; e < 64; ++e) o[e] = 0.f;
    float m = -1e30f, l = 0.f;
    const int last_pos = XPOS0 + qt * 64 + 63;
    for (int kp0 = FMETA0; kp0 <= last_pos; kp0 += 64) {
        __syncthreads();
        for (int c = lane; c < 512; c += 64) {
            const int key = c >> 3, d8 = (c & 7) * 8; const size_t off = ((size_t)b * LT + kp0 + key) * 512 + h * 64 + d8;
            unpack8(*(const uint4*)(FK + off), Ks + key * 64 + d8); unpack8(*(const uint4*)(FV + off), Vs + key * 64 + d8);
        }
        Bsh[lane] = BIAS[(size_t)(b * 8 + h) * LT + kp0 + lane];
        __syncthreads();
        for (int s = 0; s < 64; ++s) {
            float sc = Bsh[s];
#pragma unroll
            for (int d = 0; d < 64; d += 4) { const float4 kk = *(const float4*)(Ks + s * 64 + d); sc += q[d] * kk.x + q[d + 1] * kk.y + q[d + 2] * kk.z + q[d + 3] * kk.w; }
            if (kp0 + s > qpos) sc = -1e30f;
            const float mn = fmaxf(m, sc), f = exp2f(m - mn), p = exp2f(sc - mn);
            m = mn; l = l * f + p;
#pragma unroll
            for (int e = 0; e < 64; e += 4) { const float4 vv = *(const float4*)(Vs + s * 64 + e); o[e] = o[e] * f + p * vv.x; o[e + 1] = o[e + 1] * f + p * vv.y; o[e + 2] = o[e + 2] * f + p * vv.z; o[e + 3] = o[e + 3] * f + p * vv.w; }
        }
    }
    const float rl = 1.f / l;
    bf16_t* op = MIXED + ((size_t)b * SEQ + i) * DM + 512 + h * 64;
#pragma unroll
    for (int e = 0; e < 64; e += 8) {
        uint4 w;
        w.x = (unsigned)f2bf(o[e] * rl) | ((unsigned)f2bf(o[e + 1] * rl) << 16); w.y = (unsigned)f2bf(o[e + 2] * rl) | ((unsigned)f2bf(o[e + 3] * rl) << 16);
        w.z = (unsigned)f2bf(o[e + 4] * rl) | ((unsigned)f2bf(o[e + 5] * rl) << 16); w.w = (unsigned)f2bf(o[e + 6] * rl) | ((unsigned)f2bf(o[e + 7] * rl) << 16);
        *(uint4*)(op + e) = w;
    }
}

__global__ void __launch_bounds__(256) k_ln_rows(const float* __restrict__ y, const float* __restrict__ g, const float* __restrict__ bta, bf16_t* H) {
    const int lane = threadIdx.x & 63, wave = threadIdx.x >> 6;
    const int gw = blockIdx.x * 4 + wave, ngw = gridDim.x * 4;
    for (int row = gw; row < NX; row += ngw) {
        const float* src = y + (size_t)row * DM;
        float4 v[4]; float s = 0.f;
#pragma unroll
        for (int j = 0; j < 4; ++j) { v[j] = ((const float4*)src)[lane + 64 * j]; s += (v[j].x + v[j].y) + (v[j].z + v[j].w); }
        const float mean = wave_sum(s) * (1.f / DM);
        float s2 = 0.f;
#pragma unroll
        for (int j = 0; j < 4; ++j) { v[j].x -= mean; v[j].y -= mean; v[j].z -= mean; v[j].w -= mean; s2 += (v[j].x * v[j].x + v[j].y * v[j].y) + (v[j].z * v[j].z + v[j].w * v[j].w); }
        const float rstd = 1.f / sqrtf(wave_sum(s2) * (1.f / DM) + LN_EPS);
#pragma unroll
        for (int j = 0; j < 4; ++j) {
            const float4 gg = ((const float4*)g)[lane + 64 * j], bb = ((const float4*)bta)[lane + 64 * j];
            uint2 o; o.x = (unsigned)f2bf(v[j].x * rstd * gg.x + bb.x) | ((unsigned)f2bf(v[j].y * rstd * gg.y + bb.y) << 16);
            o.y = (unsigned)f2bf(v[j].z * rstd * gg.z + bb.z) | ((unsigned)f2bf(v[j].w * rstd * gg.w + bb.w) << 16);
            ((uint2*)(H + (size_t)row * DM))[lane + 64 * j] = o;
        }
    }
}

__global__ void __launch_bounds__(256) k_route(const float* __restrict__ LOGITS, const float* __restrict__ rbias, int* cnt, int* TOKL, float* GATEL, int* ASG) {
    __shared__ float sc[256 * 65];
    __shared__ float rb[64];
    if (threadIdx.x < 64) rb[threadIdx.x] = rbias[threadIdx.x];
    const int tok0 = blockIdx.x * 256;
    for (int i = threadIdx.x; i < 256 * 64; i += 256) { const int t = i >> 6, e = i & 63; const float x = LOGITS[(size_t)(tok0 + t) * 64 + e]; sc[t * 65 + e] = 1.f / (1.f + expf(-x)); }
    __syncthreads();
    const int tok = tok0 + threadIdx.x;
    const float* my = sc + threadIdx.x * 65;
    float gs[8];
#pragma unroll
    for (int g = 0; g < 8; ++g) {
        float m1 = -3e38f, m2 = -3e38f;
#pragma unroll
        for (int j = 0; j < 8; ++j) { const float v = my[g * 8 + j] + rb[g * 8 + j]; if (v > m1) { m2 = m1; m1 = v; } else if (v > m2) m2 = v; }
        gs[g] = m1 + m2;
    }
    unsigned gmask = 0;
#pragma unroll
    for (int r = 0; r < 4; ++r) {
        float best = -3e38f; int bi = 0;
#pragma unroll
        for (int g = 0; g < 8; ++g) { const bool take = !((gmask >> g) & 1u) && gs[g] > best; if (take) { best = gs[g]; bi = g; } }
        gmask |= 1u << bi;
    }
    unsigned long long chosen = 0ull; int sel[6]; float gv[6]; float gsum = 0.f;
#pragma unroll
    for (int r = 0; r < 6; ++r) {
        float best = -3e38f; int bi = 0;
        for (int e = 0; e < 64; ++e) { if (((gmask >> (e >> 3)) & 1u) && !((chosen >> e) & 1ull)) { const float v = my[e] + rb[e]; if (v > best) { best = v; bi = e; } } }
        chosen |= 1ull << bi; sel[r] = bi; gv[r] = my[bi]; gsum += gv[r];
    }
    const float scale = ROUTED_SCALE / gsum;
#pragma unroll
    for (int r = 0; r < 6; ++r) {
        const int e = sel[r]; const int rank = atomicAdd(&cnt[e], 1);
        TOKL[(size_t)e * CAP + rank] = tok; GATEL[(size_t)e * CAP + rank] = gv[r] * scale; ASG[(size_t)tok * 6 + r] = (e << 16) | rank;
    }
}

__global__ void __launch_bounds__(256) k_exp_up_naive(const bf16_t* __restrict__ H1, const float* __restrict__ we_gate, const float* __restrict__ we_up, const float* __restrict__ ws_gate, const float* __restrict__ ws_up,
                                                     const int* __restrict__ cnt, const int* __restrict__ TOKL, bf16_t* HID) {
    __shared__ float As[16][65];
    __shared__ float Bg[16][65];
    __shared__ float Bu[16][65];
    __shared__ int toks[64];
    __shared__ int hs_sh;
    const int e = blockIdx.z, n_e = e < 64 ? cnt[e] : NX, r0 = blockIdx.y * 64;
    if (r0 >= n_e) return;
    if (threadIdx.x == 0) { int hs = 0; for (int j = 0; j < e; ++j) hs += (cnt[j] + 255) & ~255; hs_sh = hs; }
    if (threadIdx.x < 64) { const int r = r0 + threadIdx.x; toks[threadIdx.x] = r < n_e ? (e < 64 ? TOKL[(size_t)e * CAP + r] : r) : -1; }
    __syncthreads();
    const float* Wg = e < 64 ? we_gate + (size_t)e * DM * EFF : ws_gate;
    const float* Wu = e < 64 ? we_up + (size_t)e * DM * EFF : ws_up;
    const int tx = threadIdx.x & 15, ty = threadIdx.x >> 4, n0 = blockIdx.x * 64;
    float ag[4][4], au[4][4];
#pragma unroll
    for (int i = 0; i < 4; ++i)
#pragma unroll
        for (int j = 0; j < 4; ++j) { ag[i][j] = 0.f; au[i][j] = 0.f; }
    for (int k0 = 0; k0 < DM; k0 += 16) {
        for (int i = threadIdx.x; i < 1024; i += 256) { const int m = i >> 4, k = i & 15; const int t = toks[m]; As[k][m] = t >= 0 ? bf2f(H1[(size_t)t * DM + k0 + k]) : 0.f; }
        for (int i = threadIdx.x; i < 1024; i += 256) { const int k = i >> 6, n = i & 63; Bg[k][n] = Wg[(size_t)(k0 + k) * EFF + n0 + n]; Bu[k][n] = Wu[(size_t)(k0 + k) * EFF + n0 + n]; }
        __syncthreads();
#pragma unroll
        for (int k = 0; k < 16; ++k) {
            float a[4], bg[4], bu[4];
#pragma unroll
            for (int i = 0; i < 4; ++i) { a[i] = As[k][ty * 4 + i]; bg[i] = Bg[k][tx * 4 + i]; bu[i] = Bu[k][tx * 4 + i]; }
#pragma unroll
            for (int i = 0; i < 4; ++i)
#pragma unroll
                for (int j = 0; j < 4; ++j) { ag[i][j] += a[i] * bg[j]; au[i][j] += a[i] * bu[j]; }
        }
        __syncthreads();
    }
    const int hs = hs_sh;
#pragma unroll
    for (int i = 0; i < 4; ++i)
#pragma unroll
        for (int j = 0; j < 4; ++j) { const int r = r0 + ty * 4 + i; if (r < n_e) { const float gq = ag[i][j]; HID[(size_t)(hs + r) * EFF + n0 + tx * 4 + j] = f2bf(gq / (1.f + __expf(-gq)) * au[i][j]); } }
}

__global__ void __launch_bounds__(256) k_exp_down_naive(const bf16_t* __restrict__ HID, const float* __restrict__ we_down, const float* __restrict__ ws_down, const int* __restrict__ cnt, const float* __restrict__ GATEL,
                                                       bf16_t* Y, bf16_t* H1) {
    __shared__ float As[16][65];
    __shared__ float Bs[16][65];
    __shared__ int hs_sh, ys_sh;
    const int e = blockIdx.z, n_e = e < 64 ? cnt[e] : NX, r0 = blockIdx.y * 64;
    if (r0 >= n_e) return;
    if (threadIdx.x == 0) { int hs = 0, ys = 0; for (int j = 0; j < e; ++j) { hs += (cnt[j] + 255) & ~255; ys += cnt[j]; } hs_sh = hs; ys_sh = ys; }
    __syncthreads();
    const int hs = hs_sh, ys = ys_sh;
    const float* Wd = e < 64 ? we_down + (size_t)e * EFF * DM : ws_down;
    const int tx = threadIdx.x & 15, ty = threadIdx.x >> 4, n0 = blockIdx.x * 64;
    float acc[4][4];
#pragma unroll
    for (int i = 0; i < 4; ++i)
#pragma unroll
        for (int j = 0; j < 4; ++j) acc[i][j] = 0.f;
    for (int k0 = 0; k0 < EFF; k0 += 16) {
        for (int i = threadIdx.x; i < 1024; i += 256) { const int m = i >> 4, k = i & 15; As[k][m] = (r0 + m < n_e) ? bf2f(HID[(size_t)(hs + r0 + m) * EFF + k0 + k]) : 0.f; }
        for (int i = threadIdx.x; i < 1024; i += 256) { const int k = i >> 6, n = i & 63; Bs[k][n] = Wd[(size_t)(k0 + k) * DM + n0 + n]; }
        __syncthreads();
#pragma unroll
        for (int k = 0; k < 16; ++k) {
            float a[4], b[4];
#pragma unroll
            for (int i = 0; i < 4; ++i) { a[i] = As[k][ty * 4 + i]; b[i] = Bs[k][tx * 4 + i]; }
#pragma unroll
            for (int i = 0; i < 4; ++i)
#pragma unroll
                for (int j = 0; j < 4; ++j) acc[i][j] += a[i] * b[j];
        }
        __syncthreads();
    }
#pragma unroll
    for (int i = 0; i < 4; ++i) {
        const int r = r0 + ty * 4 + i; if (r >= n_e) continue;
        if (e < 64) { const float gt = GATEL[(size_t)e * CAP + r];
#pragma unroll
            for (int j = 0; j < 4; ++j) Y[(size_t)(ys + r) * DM + n0 + tx * 4 + j] = f2bf(acc[i][j] * gt); }
        else {
#pragma unroll
            for (int j = 0; j < 4; ++j) { const size_t o = (size_t)r * DM + n0 + tx * 4 + j; H1[o] = f2bf(ALPHA * bf2f(H1[o]) + acc[i][j]); } }
    }
}

__global__ void __launch_bounds__(256) k_final(const bf16_t* __restrict__ BASE, const bf16_t* __restrict__ Y, const int* __restrict__ ASG, const int* __restrict__ cnt, const float* __restrict__ g, const float* __restrict__ bta, float* out) {
    __shared__ int ys[64];
    if (threadIdx.x == 0) { int a = 0; for (int j = 0; j < 64; ++j) { ys[j] = a; a += cnt[j]; } }
    __syncthreads();
    const int lane = threadIdx.x & 63, wave = threadIdx.x >> 6;
    const int gw = blockIdx.x * 4 + wave, ngw = gridDim.x * 4;
    for (int tok = gw; tok < NX; tok += ngw) {
        float v[16];
        { const bf16_t* src = BASE + (size_t)tok * DM;
#pragma unroll
          for (int j = 0; j < 2; ++j) unpack8(((const uint4*)src)[lane + 64 * j], v + 8 * j); }
#pragma unroll
        for (int r = 0; r < 6; ++r) {
            const int a = ASG[(size_t)tok * 6 + r]; const int e = a >> 16, rank = a & 0xffff;
            const bf16_t* src = Y + (size_t)(ys[e] + rank) * DM; float t[8];
#pragma unroll
            for (int j = 0; j < 2; ++j) { unpack8(((const uint4*)src)[lane + 64 * j], t);
#pragma unroll
                for (int q = 0; q < 8; ++q) v[8 * j + q] += t[q]; }
        }
        float s = 0.f;
#pragma unroll
        for (int q = 0; q < 16; ++q) s += v[q];
        const float mean = wave_sum(s) * (1.f / DM);
        float s2 = 0.f;
#pragma unroll
        for (int q = 0; q < 16; ++q) { v[q] -= mean; s2 += v[q] * v[q]; }
        const float rstd = 1.f / sqrtf(wave_sum(s2) * (1.f / DM) + LN_EPS);
#pragma unroll
        for (int j = 0; j < 2; ++j) {
            const int c0 = (lane + 64 * j) * 8;
            const float4 g0 = *(const float4*)(g + c0), g1 = *(const float4*)(g + c0 + 4), b0 = *(const float4*)(bta + c0), b1 = *(const float4*)(bta + c0 + 4);
            float4 o0, o1;
            o0.x = v[8 * j + 0] * rstd * g0.x + b0.x; o0.y = v[8 * j + 1] * rstd * g0.y + b0.y; o0.z = v[8 * j + 2] * rstd * g0.z + b0.z; o0.w = v[8 * j + 3] * rstd * g0.w + b0.w;
            o1.x = v[8 * j + 4] * rstd * g1.x + b1.x; o1.y = v[8 * j + 5] * rstd * g1.y + b1.y; o1.z = v[8 * j + 6] * rstd * g1.z + b1.z; o1.w = v[8 * j + 7] * rstd * g1.w + b1.w;
            *(float4*)(out + (size_t)tok * DM + c0) = o0; *(float4*)(out + (size_t)tok * DM + c0 + 4) = o1;
        }
    }
}

extern "C" void kernel_launch(void* const* d_in, const int* in_sizes, int n_in, void* d_out, int out_size, void* d_ws, size_t ws_size, hipStream_t stream) {
    if (n_in != 19 || ws_size < WS_END || out_size != NX * DM) { fprintf(stderr, "kernel_launch: unexpected sizes n_in=%d ws=%zu out=%d\n", n_in, ws_size, out_size); return; }
    const float* x = (const float*)d_in[0]; const float* meta = (const float*)d_in[1]; const float* ln0_g = (const float*)d_in[2]; const float* ln0_b = (const float*)d_in[3];
    const float* w_in = (const float*)d_in[4]; const float* b_forget = (const float*)d_in[5]; const float* w_out = (const float*)d_in[6];
    const float* ln1_g = (const float*)d_in[7]; const float* ln1_b = (const float*)d_in[8]; const float* w_router = (const float*)d_in[9]; const float* router_bias = (const float*)d_in[10];
    const float* we_gate = (const float*)d_in[11]; const float* we_up = (const float*)d_in[12]; const float* we_down = (const float*)d_in[13];
    const float* ws_gate = (const float*)d_in[14]; const float* ws_up = (const float*)d_in[15]; const float* ws_down = (const float*)d_in[16];
    const float* ln2_g = (const float*)d_in[17]; const float* ln2_b = (const float*)d_in[18];
    unsigned char* ws = (unsigned char*)d_ws; float* out = (float*)d_out;
    int* cnt = (int*)(ws + WS_CTL) + CW_CNT;
    float* LOGF = (float*)(ws + WS_LOGF); float* BIAS = (float*)(ws + WS_BIAS); int* ASG = (int*)(ws + WS_ASG); int* TOKL = (int*)(ws + WS_TOKL); float* GATEL = (float*)(ws + WS_GATEL);
    float* LOGITS = (float*)(ws + WS_LOGITS); bf16_t* XN = (bf16_t*)(ws + WS_XN); bf16_t* H1 = XN;
    bf16_t* RQ = (bf16_t*)(ws + WS_RQ); bf16_t* RK = RQ + BUFE; bf16_t* RV = RQ + 2 * BUFE; bf16_t* RG = RQ + 3 * BUFE; bf16_t* FQ = RQ + 4 * BUFE; bf16_t* FK = RQ + 5 * BUFE; bf16_t* FV = RQ + 6 * BUFE;
    bf16_t* MIXED = (bf16_t*)(ws + WS_MIXED); bf16_t* Y = (bf16_t*)(ws + WS_Y);
    float* yb = out;
    bf16_t* HID = (bf16_t*)d_out;

    (void)hipMemsetAsync(ws + WS_CTL, 0, 1 * MiB, stream);
    k_ln0<<<1024, 256, 0, stream>>>(x, meta, ln0_g, ln0_b, w_in, b_forget, XN, LOGF);
    k_bias<<<64, 64, 0, stream>>>(LOGF, BIAS);
    naive_gemm<<<dim3(3584 / 64, (NX + NMETA + 63) / 64), 256, 0, stream>>>(NX + NMETA, 3584, DM, 0, AF_bf16{XN, DM, 0}, BF_f32{w_in, INC, 0}, EF_inproj{RQ});
    k_rotary<<<(NB * (NMETA + SEQ) * 256 + 255) / 256, 256, 0, stream>>>(RQ, RK);
    k_ret_naive<<<NB * 4 * 64, 64, 0, stream>>>(RQ, RK, RV, RG, MIXED);
    k_fox_naive<<<NB * 8 * 64, 64, 0, stream>>>(FQ, FK, FV, BIAS, MIXED);
    naive_gemm<<<dim3(DM / 64, NX / 64), 256, 0, stream>>>(NX, DM, DM, 0, AF_bf16{MIXED, DM, 0}, BF_f32{w_out, DM, 0}, EF_outproj{yb, XN});
    k_ln_rows<<<1024, 256, 0, stream>>>(yb, ln1_g, ln1_b, H1);
    naive_gemm<<<dim3(1, NX / 64), 256, 0, stream>>>(NX, 64, DM, 0, AF_bf16{H1, DM, 0}, BF_f32{w_router, 64, 0}, EF_store{LOGITS, 64, 0});
    k_route<<<NX / 256, 256, 0, stream>>>(LOGITS, router_bias, cnt, TOKL, GATEL, ASG);
    k_exp_up_naive<<<dim3(EFF / 64, NX / 64, 65), 256, 0, stream>>>(H1, we_gate, we_up, ws_gate, ws_up, cnt, TOKL, HID);
    k_exp_down_naive<<<dim3(DM / 64, NX / 64, 65), 256, 0, stream>>>(HID, we_down, ws_down, cnt, GATEL, Y, H1);
    k_final<<<1024, 256, 0, stream>>>(H1, Y, ASG, cnt, ln2_g, ln2_b, out);
}
```

```cpp
#include <hip/hip_runtime.h>
#include <stdint.h>
#include <cstdio>

typedef unsigned short bf16_t;

constexpr int NB = 8, SEQ = 4096, DM = 1024, NMETA = 16, NX = NB * SEQ;
constexpr int LT = 4352;
constexpr int XPOS0 = 256;
constexpr int RMETA0 = 240;
constexpr int FMETA0 = 128;
constexpr int INC = 3592, NEXP = 64, TOPK = 6, EFF = 256;
constexpr int CAP = 32768;
constexpr float LN_EPS = 1e-5f;
constexpr float ALPHA = 1.189207115002721f;
constexpr float LOG2E = 1.4426950408889634f;
constexpr float C2 = 0.125f * LOG2E;
constexpr float RK_SCALE = 0.08838834764831845f;
constexpr float ROUTED_SCALE = 2.5f;

constexpr size_t MiB = 1u << 20;
constexpr size_t WS_CTL = 0;
constexpr size_t WS_LOGF = 1 * MiB;
constexpr size_t WS_BIAS = 3 * MiB;
constexpr size_t WS_ASG = 5 * MiB;
constexpr size_t WS_TOKL = 6 * MiB;
constexpr size_t WS_GATEL = 14 * MiB;
constexpr size_t WS_LOGITS = 22 * MiB;
constexpr size_t WS_XN = 30 * MiB;
constexpr size_t WS_A = 96 * MiB;
constexpr size_t BUFE = (size_t)NB * LT * 512;
constexpr size_t WS_RQ = WS_A;
constexpr size_t WS_MIXED = WS_A + 7 * BUFE * 2;
constexpr size_t WS_Y = WS_A;
constexpr size_t WS_WIN_T = 398 * MiB;
constexpr size_t WS_WOUT_T = 405 * MiB;
constexpr size_t WS_WGU_T = 407 * MiB;
constexpr size_t WS_WSD_T = 94 * MiB + 512 * 1024;
constexpr size_t WS_WR_T = 95 * MiB;
constexpr size_t WS_TAB = 95 * MiB + 512 * 1024;
constexpr size_t WS_WD_T = 480 * MiB;
constexpr size_t WS_END = 512 * MiB;
constexpr size_t HID_S_ROW0 = 212992;
constexpr int CW_CNT = 1024;
constexpr int CW_Q2 = 2048;

__device__ __forceinline__ float bf2f(bf16_t v) { return __uint_as_float(((unsigned)v) << 16); }
__device__ __forceinline__ unsigned f2bf(float f) { unsigned u = __float_as_uint(f); return (u + 0x7fffu + ((u >> 16) & 1u)) >> 16; }
__device__ __forceinline__ float wave_sum(float v) {
#pragma unroll
    for (int o = 1; o < 64; o <<= 1) v += __shfl_xor(v, o);
    return v;
}

__global__ void __launch_bounds__(256) k_ln0(const float* __restrict__ x, const float* __restrict__ meta, const float* __restrict__ g, const float* __restrict__ bta,
                                            const float* __restrict__ w_in, const float* __restrict__ b_forget, bf16_t* XN, float* LOGF) {
    __shared__ float wf[1024 * 8];
    for (int i = threadIdx.x; i < 1024 * 8; i += 256) { int k = i >> 3, h = i & 7; wf[i] = w_in[(size_t)k * INC + 3584 + h]; }
    __syncthreads();
    const int lane = threadIdx.x & 63, wave = threadIdx.x >> 6;
    const int gw = blockIdx.x * 4 + wave, ngw = gridDim.x * 4;
    for (int row = gw; row < NX + NMETA; row += ngw) {
        const float* src = row < NX ? x + (size_t)row * DM : meta + (size_t)(row - NX) * DM;
        float4 v[4]; float s = 0.f;
#pragma unroll
        for (int j = 0; j < 4; ++j) { v[j] = ((const float4*)src)[lane + 64 * j]; s += (v[j].x + v[j].y) + (v[j].z + v[j].w); }
        const float mean = wave_sum(s) * (1.f / DM);
        float s2 = 0.f;
#pragma unroll
        for (int j = 0; j < 4; ++j) { v[j].x -= mean; v[j].y -= mean; v[j].z -= mean; v[j].w -= mean; s2 += (v[j].x * v[j].x + v[j].y * v[j].y) + (v[j].z * v[j].z + v[j].w * v[j].w); }
        const float rstd = 1.f / sqrtf(wave_sum(s2) * (1.f / DM) + LN_EPS);
        float f[8];
#pragma unroll
        for (int h = 0; h < 8; ++h) f[h] = 0.f;
#pragma unroll
        for (int j = 0; j < 4; ++j) {
            const float4 gg = ((const float4*)g)[lane + 64 * j], bb = ((const float4*)bta)[lane + 64 * j];
            float y0 = v[j].x * rstd * gg.x + bb.x, y1 = v[j].y * rstd * gg.y + bb.y, y2 = v[j].z * rstd * gg.z + bb.z, y3 = v[j].w * rstd * gg.w + bb.w;
            uint2 o; o.x = (unsigned)f2bf(y0) | ((unsigned)f2bf(y1) << 16); o.y = (unsigned)f2bf(y2) | ((unsigned)f2bf(y3) << 16);
            ((uint2*)(XN + (size_t)row * DM))[lane + 64 * j] = o;
            const int k0 = 4 * (lane + 64 * j);
#pragma unroll
            for (int h = 0; h < 8; ++h) f[h] += y0 * wf[(k0 + 0) * 8 + h] + y1 * wf[(k0 + 1) * 8 + h] + y2 * wf[(k0 + 2) * 8 + h] + y3 * wf[(k0 + 3) * 8 + h];
        }
        float z = 0.f;
#pragma unroll
        for (int h = 0; h < 8; ++h) { const float t = wave_sum(f[h]); if (lane == h) z = t; }
        if (lane < 8) { z += b_forget[lane]; LOGF[(size_t)row * 8 + lane] = fminf(z, 0.f) - log1pf(expf(-fabsf(z))); }
    }
}

__global__ void __launch_bounds__(64) k_bias(const float* __restrict__ LOGF, float* BIAS) {
    const int bh = blockIdx.x, b = bh >> 3, h = bh & 7, lane = threadIdx.x;
    float* out = BIAS + (size_t)bh * LT;
    for (int p = lane; p < XPOS0; p += 64) if (p < FMETA0 || p >= FMETA0 + NMETA) out[p] = -1e30f;
    float carry = 0.f;
    for (int t0 = 0; t0 < NMETA + SEQ; t0 += 64) {
        const int t = t0 + lane; float v = 0.f;
        if (t < NMETA + SEQ) { const int row = t < NMETA ? NX + t : b * SEQ + t - NMETA; v = LOGF[(size_t)row * 8 + h]; }
#pragma unroll
        for (int o = 1; o < 64; o <<= 1) { const float u = __shfl_up(v, o); if (lane >= o) v += u; }
        v += carry;
        if (t < NMETA + SEQ) { const int pos = t < NMETA ? FMETA0 + t : XPOS0 + t - NMETA; out[pos] = -v * LOG2E; }
        carry = __shfl(v, 63);
    }
}

template <class AF, class BF, class EF>
__global__ void __launch_bounds__(256) naive_gemm(int M, int N, int K, int padarg, AF af, BF bf, EF ef) {
    __shared__ float As[16][65];
    __shared__ float Bs[16][65];
    const int tx = threadIdx.x & 15, ty = threadIdx.x >> 4;
    const int m0 = blockIdx.y * 64, n0 = blockIdx.x * 64;
    float acc[4][4];
#pragma unroll
    for (int i = 0; i < 4; ++i)
#pragma unroll
        for (int j = 0; j < 4; ++j) acc[i][j] = 0.f;
    for (int k0 = 0; k0 < K; k0 += 16) {
        for (int i = threadIdx.x; i < 1024; i += 256) { const int m = i >> 4, k = i & 15; As[k][m] = (m0 + m < M) ? af(m0 + m, k0 + k) : 0.f; }
        for (int i = threadIdx.x; i < 1024; i += 256) { const int k = i >> 6, n = i & 63; Bs[k][n] = (n0 + n < N) ? bf(k0 + k, n0 + n) : 0.f; }
        __syncthreads();
#pragma unroll
        for (int k = 0; k < 16; ++k) {
            float a[4], b[4];
#pragma unroll
            for (int i = 0; i < 4; ++i) { a[i] = As[k][ty * 4 + i]; b[i] = Bs[k][tx * 4 + i]; }
#pragma unroll
            for (int i = 0; i < 4; ++i)
#pragma unroll
                for (int j = 0; j < 4; ++j) acc[i][j] += a[i] * b[j];
        }
        __syncthreads();
    }
#pragma unroll
    for (int i = 0; i < 4; ++i)
#pragma unroll
        for (int j = 0; j < 4; ++j) { const int m = m0 + ty * 4 + i, n = n0 + tx * 4 + j; if (m < M && n < N) ef(m, n, acc[i][j]); }
}
struct AF_bf16 { const bf16_t* p; int ld; int pad; __device__ float operator()(int m, int k) const { return bf2f(p[(size_t)m * ld + k]); } };
struct BF_f32 { const float* p; int ld; int pad; __device__ float operator()(int k, int n) const { return p[(size_t)k * ld + n]; } };
struct EF_inproj {
    bf16_t* bufs;
    __device__ void operator()(int row, int col, float v) const {
        const int g = col >> 9, cc = col & 511;
        if (g == 1) v *= RK_SCALE; else if (g == 3) v = v / (1.f + __expf(-v)); else if (g == 4) v *= C2;
        const bf16_t o = f2bf(v);
        bf16_t* base = bufs + (size_t)g * BUFE;
        if (row < NX) { const int b = row >> 12, i = row & 4095; base[((size_t)b * LT + XPOS0 + i) * 512 + cc] = o; }
        else { const int pos = (g < 4 ? RMETA0 : FMETA0) + (row - NX); for (int b = 0; b < NB; ++b) base[((size_t)b * LT + pos) * 512 + cc] = o; }
    }
};
struct EF_outproj { float* y; const bf16_t* XN; __device__ void operator()(int row, int col, float v) const { const size_t o = (size_t)row * DM + col; y[o] = v + ALPHA * bf2f(XN[o]); } };
struct EF_store { float* p; int ld; int pad; __device__ void operator()(int row, int col, float v) const { p[(size_t)row * ld + col] = v; } };

__global__ void __launch_bounds__(256) k_rotary(bf16_t* RQ, bf16_t* RK) {
    const size_t idx = (size_t)blockIdx.x * 256 + threadIdx.x;
    if (idx >= (size_t)NB * (NMETA + SEQ) * 256) return;
    const int j = (int)(idx & 63), h = (int)((idx >> 6) & 3); const size_t r = idx >> 8; const int t = (int)(r % (NMETA + SEQ)), b = (int)(r / (NMETA + SEQ));
    const int pos = RMETA0 + t;
    const double inv = exp2(-(double)j * (13.287712379549449 / 64.0));
    double rv = (double)t * inv * 0.15915494309189535; rv -= floor(rv);
    const float fr = (float)rv, s = __builtin_amdgcn_sinf(fr), c = __builtin_amdgcn_cosf(fr);
    bf16_t* p = RQ + ((size_t)b * LT + pos) * 512 + h * 128 + j;
    float x1 = bf2f(p[0]), x2 = bf2f(p[64]); p[0] = f2bf(x1 * c - x2 * s); p[64] = f2bf(x2 * c + x1 * s);
    p = RK + ((size_t)b * LT + pos) * 512 + h * 128 + j;
    x1 = bf2f(p[0]); x2 = bf2f(p[64]); p[0] = f2bf(x1 * c - x2 * s); p[64] = f2bf(x2 * c + x1 * s);
}

__device__ __forceinline__ void unpack8(const uint4 u, float* d) {
    d[0] = __uint_as_float(u.x << 16); d[1] = __uint_as_float(u.x & 0xffff0000u); d[2] = __uint_as_float(u.y << 16); d[3] = __uint_as_float(u.y & 0xffff0000u);
    d[4] = __uint_as_float(u.z << 16); d[5] = __uint_as_float(u.z & 0xffff0000u); d[6] = __uint_as_float(u.w << 16); d[7] = __uint_as_float(u.w & 0xffff0000u);
}

__global__ void __launch_bounds__(64) k_ret_naive(const bf16_t* __restrict__ RQ, const bf16_t* __restrict__ RK, const bf16_t* __restrict__ RV, const bf16_t* __restrict__ RG, bf16_t* MIXED) {
    __shared__ float Ks[64 * 128];
    __shared__ float Vs[64 * 128];
    const int blk = blockIdx.x, qt = blk & 63, h = (blk >> 6) & 3, b = blk >> 8, lane = threadIdx.x;
    const int i = qt * 64 + lane, qpos = XPOS0 + i;
    const float lg2g = log2f(1.f - exp2f(-5.f - (float)h));
    float q[128], o[128];
    const bf16_t* qp = RQ + ((size_t)b * LT + qpos) * 512 + h * 128;
#pragma unroll
    for (int d = 0; d < 128; d += 8) unpack8(*(const uint4*)(qp + d), q + d);
#pragma unroll
    for (int e = 0; e < 128; ++e) o[e] = 0.f;
    const int last_pos = XPOS0 + qt * 64 + 63;
    for (int kp0 = 192; kp0 <= last_pos; kp0 += 64) {
        __syncthreads();
        for (int c = lane; c < 1024; c += 64) {
            const int key = c >> 4, d8 = (c & 15) * 8; const size_t off = ((size_t)b * LT + kp0 + key) * 512 + h * 128 + d8;
            unpack8(*(const uint4*)(RK + off), Ks + key * 128 + d8); unpack8(*(const uint4*)(RV + off), Vs + key * 128 + d8);
        }
        __syncthreads();
        for (int s = 0; s < 64; ++s) {
            const int kpos = kp0 + s;
            if (kpos < RMETA0) continue;
            float sc = 0.f;
#pragma unroll
            for (int d = 0; d < 128; d += 4) { const float4 kk = *(const float4*)(Ks + s * 128 + d); sc += q[d] * kk.x + q[d + 1] * kk.y + q[d + 2] * kk.z + q[d + 3] * kk.w; }
            const float w = (kpos <= qpos) ? sc * exp2f((float)(qpos - kpos) * lg2g) : 0.f;
#pragma unroll
            for (int e = 0; e < 128; e += 4) { const float4 vv = *(const float4*)(Vs + s * 128 + e); o[e] += w * vv.x; o[e + 1] += w * vv.y; o[e + 2] += w * vv.z; o[e + 3] += w * vv.w; }
        }
    }
    float mean = 0.f;
#pragma unroll
    for (int e = 0; e < 128; ++e) mean += o[e];
    mean *= (1.f / 128.f);
    float var = 0.f;
#pragma unroll
    for (int e = 0; e < 128; ++e) { o[e] -= mean; var += o[e] * o[e]; }
    const float rstd = 1.f / sqrtf(var * (1.f / 128.f) + LN_EPS);
    const bf16_t* gp = RG + ((size_t)b * LT + qpos) * 512 + h * 128;
    bf16_t* op = MIXED + ((size_t)b * SEQ + i) * DM + h * 128;
#pragma unroll
    for (int e = 0; e < 128; e += 8) {
        float gg[8]; unpack8(*(const uint4*)(gp + e), gg);
        uint4 w;
        w.x = (unsigned)f2bf(o[e] * rstd * gg[0]) | ((unsigned)f2bf(o[e + 1] * rstd * gg[1]) << 16);
        w.y = (unsigned)f2bf(o[e + 2] * rstd * gg[2]) | ((unsigned)f2bf(o[e + 3] * rstd * gg[3]) << 16);
        w.z = (unsigned)f2bf(o[e + 4] * rstd * gg[4]) | ((unsigned)f2bf(o[e + 5] * rstd * gg[5]) << 16);
        w.w = (unsigned)f2bf(o[e + 6] * rstd * gg[6]) | ((unsigned)f2bf(o[e + 7] * rstd * gg[7]) << 16);
        *(uint4*)(op + e) = w;
    }
}

__global__ void __launch_bounds__(64) k_fox_naive(const bf16_t* __restrict__ FQ, const bf16_t* __restrict__ FK, const bf16_t* __restrict__ FV, const float* __restrict__ BIAS, bf16_t* MIXED) {
    __shared__ float Ks[64 * 64];
    __shared__ float Vs[64 * 64];
    __shared__ float Bsh[64];
    const int blk = blockIdx.x, qt = blk & 63, h = (blk >> 6) & 7, b = blk >> 9, lane = threadIdx.x;
    const int i = qt * 64 + lane, qpos = XPOS0 + i;
    float q[64], o[64];
    const bf16_t* qp = FQ + ((size_t)b * LT + qpos) * 512 + h * 64;
#pragma unroll
    for (int d = 0; d < 64; d += 8) unpack8(*(const uint4*)(qp + d), q + d);
#pragma unroll
    for (int e = 0; e < 64; ++e) o[e] = 0.f;
    float m = -1e30f, l = 0.f;
    const int last_pos = XPOS0 + qt * 64 + 63;
    for (int kp0 = FMETA0; kp0 <= last_pos; kp0 += 64) {
        __syncthreads();
        for (int c = lane; c < 512; c += 64) {
            const int key = c >> 3, d8 = (c & 7) * 8; const size_t off = ((size_t)b * LT + kp0 + key) * 512 + h * 64 + d8;
            unpack8(*(const uint4*)(FK + off), Ks + key * 64 + d8); unpack8(*(const uint4*)(FV + off), Vs + key * 64 + d8);
        }
        Bsh[lane] = BIAS[(size_t)(b * 8 + h) * LT + kp0 + lane];
        __syncthreads();
        for (int s = 0; s < 64; ++s) {
            float sc = Bsh[s];
#pragma unroll
            for (int d = 0; d < 64; d += 4) { const float4 kk = *(const float4*)(Ks + s * 64 + d); sc += q[d] * kk.x + q[d + 1] * kk.y + q[d + 2] * kk.z + q[d + 3] * kk.w; }
            if (kp0 + s > qpos) sc = -1e30f;
            const float mn = fmaxf(m, sc), f = exp2f(m - mn), p = exp2f(sc - mn);
            m = mn; l = l * f + p;
#pragma unroll
            for (int e = 0; e < 64; e += 4) { const float4 vv = *(const float4*)(Vs + s * 64 + e); o[e] = o[e] * f + p * vv.x; o[e + 1] = o[e + 1] * f + p * vv.y; o[e + 2] = o[e + 2] * f + p * vv.z; o[e + 3] = o[e + 3] * f + p * vv.w; }
        }
    }
    const float rl = 1.f / l;
    bf16_t* op = MIXED + ((size_t)b * SEQ + i) * DM + 512 + h * 64;
#pragma unroll
    for (int e = 0; e < 64; e += 8) {
        uint4 w;
        w.x = (unsigned)f2bf(o[e] * rl) | ((unsigned)f2bf(o[e + 1] * rl) << 16); w.y = (unsigned)f2bf(o[e + 2] * rl) | ((unsigned)f2bf(o[e + 3] * rl) << 16);
        w.z = (unsigned)f2bf(o[e + 4] * rl) | ((unsigned)f2bf(o[e + 5] * rl) << 16); w.w = (unsigned)f2bf(o[e + 6] * rl) | ((unsigned)f2bf(o[e + 7] * rl) << 16);
        *(uint4*)(op + e) = w;
    }
}

__global__ void __launch_bounds__(256) k_ln_rows(const float* __restrict__ y, const float* __restrict__ g, const float* __restrict__ bta, bf16_t* H) {
    const int lane = threadIdx.x & 63, wave = threadIdx.x >> 6;
    const int gw = blockIdx.x * 4 + wave, ngw = gridDim.x * 4;
    for (int row = gw; row < NX; row += ngw) {
        const float* src = y + (size_t)row * DM;
        float4 v[4]; float s = 0.f;
#pragma unroll
        for (int j = 0; j < 4; ++j) { v[j] = ((const float4*)src)[lane + 64 * j]; s += (v[j].x + v[j].y) + (v[j].z + v[j].w); }
        const float mean = wave_sum(s) * (1.f / DM);
        float s2 = 0.f;
#pragma unroll
        for (int j = 0; j < 4; ++j) { v[j].x -= mean; v[j].y -= mean; v[j].z -= mean; v[j].w -= mean; s2 += (v[j].x * v[j].x + v[j].y * v[j].y) + (v[j].z * v[j].z + v[j].w * v[j].w); }
        const float rstd = 1.f / sqrtf(wave_sum(s2) * (1.f / DM) + LN_EPS);
#pragma unroll
        for (int j = 0; j < 4; ++j) {
            const float4 gg = ((const float4*)g)[lane + 64 * j], bb = ((const float4*)bta)[lane + 64 * j];
            uint2 o; o.x = (unsigned)f2bf(v[j].x * rstd * gg.x + bb.x) | ((unsigned)f2bf(v[j].y * rstd * gg.y + bb.y) << 16);
            o.y = (unsigned)f2bf(v[j].z * rstd * gg.z + bb.z) | ((unsigned)f2bf(v[j].w * rstd * gg.w + bb.w) << 16);
            ((uint2*)(H + (size_t)row * DM))[lane + 64 * j] = o;
        }
    }
}

__global__ void __launch_bounds__(256) k_route(const float* __restrict__ LOGITS, const float* __restrict__ rbias, int* cnt, int* TOKL, float* GATEL, int* ASG) {
    __shared__ float sc[256 * 65];
    __shared__ float rb[64];
    if (threadIdx.x < 64) rb[threadIdx.x] = rbias[threadIdx.x];
    const int tok0 = blockIdx.x * 256;
    for (int i = threadIdx.x; i < 256 * 64; i += 256) { const int t = i >> 6, e = i & 63; const float x = LOGITS[(size_t)(tok0 + t) * 64 + e]; sc[t * 65 + e] = 1.f / (1.f + expf(-x)); }
    __syncthreads();
    const int tok = tok0 + threadIdx.x;
    const float* my = sc + threadIdx.x * 65;
    float gs[8];
#pragma unroll
    for (int g = 0; g < 8; ++g) {
        float m1 = -3e38f, m2 = -3e38f;
#pragma unroll
        for (int j = 0; j < 8; ++j) { const float v = my[g * 8 + j] + rb[g * 8 + j]; if (v > m1) { m2 = m1; m1 = v; } else if (v > m2) m2 = v; }
        gs[g] = m1 + m2;
    }
    unsigned gmask = 0;
#pragma unroll
    for (int r = 0; r < 4; ++r) {
        float best = -3e38f; int bi = 0;
#pragma unroll
        for (int g = 0; g < 8; ++g) { const bool take = !((gmask >> g) & 1u) && gs[g] > best; if (take) { best = gs[g]; bi = g; } }
        gmask |= 1u << bi;
    }
    unsigned long long chosen = 0ull; int sel[6]; float gv[6]; float gsum = 0.f;
#pragma unroll
    for (int r = 0; r < 6; ++r) {
        float best = -3e38f; int bi = 0;
        for (int e = 0; e < 64; ++e) { if (((gmask >> (e >> 3)) & 1u) && !((chosen >> e) & 1ull)) { const float v = my[e] + rb[e]; if (v > best) { best = v; bi = e; } } }
        chosen |= 1ull << bi; sel[r] = bi; gv[r] = my[bi]; gsum += gv[r];
    }
    const float scale = ROUTED_SCALE / gsum;
#pragma unroll
    for (int r = 0; r < 6; ++r) {
        const int e = sel[r]; const int rank = atomicAdd(&cnt[e], 1);
        TOKL[(size_t)e * CAP + rank] = tok; GATEL[(size_t)e * CAP + rank] = gv[r] * scale; ASG[(size_t)tok * 6 + r] = (e << 16) | rank;
    }
}

__global__ void __launch_bounds__(256) k_exp_up_naive(const bf16_t* __restrict__ H1, const float* __restrict__ we_gate, const float* __restrict__ we_up, const float* __restrict__ ws_gate, const float* __restrict__ ws_up,
                                                     const int* __restrict__ cnt, const int* __restrict__ TOKL, bf16_t* HID) {
    __shared__ float As[16][65];
    __shared__ float Bg[16][65];
    __shared__ float Bu[16][65];
    __shared__ int toks[64];
    __shared__ int hs_sh;
    const int e = blockIdx.z, n_e = e < 64 ? cnt[e] : NX, r0 = blockIdx.y * 64;
    if (r0 >= n_e) return;
    if (threadIdx.x == 0) { int hs = 0; for (int j = 0; j < e; ++j) hs += (cnt[j] + 255) & ~255; hs_sh = hs; }
    if (threadIdx.x < 64) { const int r = r0 + threadIdx.x; toks[threadIdx.x] = r < n_e ? (e < 64 ? TOKL[(size_t)e * CAP + r] : r) : -1; }
    __syncthreads();
    const float* Wg = e < 64 ? we_gate + (size_t)e * DM * EFF : ws_gate;
    const float* Wu = e < 64 ? we_up + (size_t)e * DM * EFF : ws_up;
    const int tx = threadIdx.x & 15, ty = threadIdx.x >> 4, n0 = blockIdx.x * 64;
    float ag[4][4], au[4][4];
#pragma unroll
    for (int i = 0; i < 4; ++i)
#pragma unroll
        for (int j = 0; j < 4; ++j) { ag[i][j] = 0.f; au[i][j] = 0.f; }
    for (int k0 = 0; k0 < DM; k0 += 16) {
        for (int i = threadIdx.x; i < 1024; i += 256) { const int m = i >> 4, k = i & 15; const int t = toks[m]; As[k][m] = t >= 0 ? bf2f(H1[(size_t)t * DM + k0 + k]) : 0.f; }
        for (int i = threadIdx.x; i < 1024; i += 256) { const int k = i >> 6, n = i & 63; Bg[k][n] = Wg[(size_t)(k0 + k) * EFF + n0 + n]; Bu[k][n] = Wu[(size_t)(k0 + k) * EFF + n0 + n]; }
        __syncthreads();
#pragma unroll
        for (int k = 0; k < 16; ++k) {
            float a[4], bg[4], bu[4];
#pragma unroll
            for (int i = 0; i < 4; ++i) { a[i] = As[k][ty * 4 + i]; bg[i] = Bg[k][tx * 4 + i]; bu[i] = Bu[k][tx * 4 + i]; }
#pragma unroll
            for (int i = 0; i < 4; ++i)
#pragma unroll
                for (int j = 0; j < 4; ++j) { ag[i][j] += a[i] * bg[j]; au[i][j] += a[i] * bu[j]; }
        }
        __syncthreads();
    }
    const int hs = hs_sh;
#pragma unroll
    for (int i = 0; i < 4; ++i)
#pragma unroll
        for (int j = 0; j < 4; ++j) { const int r = r0 + ty * 4 + i; if (r < n_e) { const float gq = ag[i][j]; HID[(size_t)(hs + r) * EFF + n0 + tx * 4 + j] = f2bf(gq / (1.f + __expf(-gq)) * au[i][j]); } }
}

__global__ void __launch_bounds__(256) k_exp_down_naive(const bf16_t* __restrict__ HID, const float* __restrict__ we_down, const float* __restrict__ ws_down, const int* __restrict__ cnt, const float* __restrict__ GATEL,
                                                       bf16_t* Y, bf16_t* H1) {
    __shared__ float As[16][65];
    __shared__ float Bs[16][65];
    __shared__ int hs_sh, ys_sh;
    const int e = blockIdx.z, n_e = e < 64 ? cnt[e] : NX, r0 = blockIdx.y * 64;
    if (r0 >= n_e) return;
    if (threadIdx.x == 0) { int hs = 0, ys = 0; for (int j = 0; j < e; ++j) { hs += (cnt[j] + 255) & ~255; ys += cnt[j]; } hs_sh = hs; ys_sh = ys; }
    __syncthreads();
    const int hs = hs_sh, ys = ys_sh;
    const float* Wd = e < 64 ? we_down + (size_t)e * EFF * DM : ws_down;
    const int tx = threadIdx.x & 15, ty = threadIdx.x >> 4, n0 = blockIdx.x * 64;
    float acc[4][4];
#pragma unroll
    for (int i = 0; i < 4; ++i)
#pragma unroll
        for (int j = 0; j < 4; ++j) acc[i][j] = 0.f;
    for (int k0 = 0; k0 < EFF; k0 += 16) {
        for (int i = threadIdx.x; i < 1024; i += 256) { const int m = i >> 4, k = i & 15; As[k][m] = (r0 + m < n_e) ? bf2f(HID[(size_t)(hs + r0 + m) * EFF + k0 + k]) : 0.f; }
        for (int i = threadIdx.x; i < 1024; i += 256) { const int k = i >> 6, n = i & 63; Bs[k][n] = Wd[(size_t)(k0 + k) * DM + n0 + n]; }
        __syncthreads();
#pragma unroll
        for (int k = 0; k < 16; ++k) {
            float a[4], b[4];
#pragma unroll
            for (int i = 0; i < 4; ++i) { a[i] = As[k][ty * 4 + i]; b[i] = Bs[k][tx * 4 + i]; }
#pragma unroll
            for (int i = 0; i < 4; ++i)
#pragma unroll
                for (int j = 0; j < 4; ++j) acc[i][j] += a[i] * b[j];
        }
        __syncthreads();
    }
#pragma unroll
    for (int i = 0; i < 4; ++i) {
        const int r = r0 + ty * 4 + i; if (r >= n_e) continue;
        if (e < 64) { const float gt = GATEL[(size_t)e * CAP + r];
#pragma unroll
            for (int j = 0; j < 4; ++j) Y[(size_t)(ys + r) * DM + n0 + tx * 4 + j] = f2bf(acc[i][j] * gt); }
        else {
#pragma unroll
            for (int j = 0; j < 4; ++j) { const size_t o = (size_t)r * DM + n0 + tx * 4 + j; H1[o] = f2bf(ALPHA * bf2f(H1[o]) + acc[i][j]); } }
    }
}

__global__ void __launch_bounds__(256) k_final(const bf16_t* __restrict__ BASE, const bf16_t* __restrict__ Y, const int* __restrict__ ASG, const int* __restrict__ cnt, const float* __restrict__ g, const float* __restrict__ bta, float* out) {
    __shared__ int ys[64];
    if (threadIdx.x == 0) { int a = 0; for (int j = 0; j < 64; ++j) { ys[j] = a; a += cnt[j]; } }
    __syncthreads();
    const int lane = threadIdx.x & 63, wave = threadIdx.x >> 6;
    const int gw = blockIdx.x * 4 + wave, ngw = gridDim.x * 4;
    for (int tok = gw; tok < NX; tok += ngw) {
        float v[16];
        { const bf16_t* src = BASE + (size_t)tok * DM;
#pragma unroll
          for (int j = 0; j < 2; ++j) unpack8(((const uint4*)src)[lane + 64 * j], v + 8 * j); }
#pragma unroll
        for (int r = 0; r < 6; ++r) {
            const int a = ASG[(size_t)tok * 6 + r]; const int e = a >> 16, rank = a & 0xffff;
            const bf16_t* src = Y + (size_t)(ys[e] + rank) * DM; float t[8];
#pragma unroll
            for (int j = 0; j < 2; ++j) { unpack8(((const uint4*)src)[lane + 64 * j], t);
#pragma unroll
                for (int q = 0; q < 8; ++q) v[8 * j + q] += t[q]; }
        }
        float s = 0.f;
#pragma unroll
        for (int q = 0; q < 16; ++q) s += v[q];
        const float mean = wave_sum(s) * (1.f / DM);
        float s2 = 0.f;
#pragma unroll
        for (int q = 0; q < 16; ++q) { v[q] -= mean; s2 += v[q] * v[q]; }
        const float rstd = 1.f / sqrtf(wave_sum(s2) * (1.f / DM) + LN_EPS);
#pragma unroll
        for (int j = 0; j < 2; ++j) {
            const int c0 = (lane + 64 * j) * 8;
            const float4 g0 = *(const float4*)(g + c0), g1 = *(const float4*)(g + c0 + 4), b0 = *(const float4*)(bta + c0), b1 = *(const float4*)(bta + c0 + 4);
            float4 o0, o1;
            o0.x = v[8 * j + 0] * rstd * g0.x + b0.x; o0.y = v[8 * j + 1] * rstd * g0.y + b0.y; o0.z = v[8 * j + 2] * rstd * g0.z + b0.z; o0.w = v[8 * j + 3] * rstd * g0.w + b0.w;
            o1.x = v[8 * j + 4] * rstd * g1.x + b1.x; o1.y = v[8 * j + 5] * rstd * g1.y + b1.y; o1.z = v[8 * j + 6] * rstd * g1.z + b1.z; o1.w = v[8 * j + 7] * rstd * g1.w + b1.w;
            *(float4*)(out + (size_t)tok * DM + c0) = o0; *(float4*)(out + (size_t)tok * DM + c0 + 4) = o1;
        }
    }
}


namespace pg8 {
#define PG8_LAS __attribute__((address_space(3)))
typedef unsigned short bf16_t;
typedef short bf16x8 __attribute__((ext_vector_type(8)));
typedef float f32x4 __attribute__((ext_vector_type(4)));
typedef unsigned u32x4 __attribute__((ext_vector_type(4)));
constexpr int BM = 256, BK = 64, HALF = 128, HTB = HALF * BK * 2  , STAGE_BYTES = 8 * HTB, NXCD = 8, WGM = 8;

__host__ __device__ __forceinline__ int lds_byte(int r, int c) { const int st = (r >> 4) * 2 + (c >> 5), rr = r & 15, cc = c & 31, ob = rr * 64 + cc * 2; return st * 1024 + (ob ^ (((ob >> 9) & 1) << 5)); }
__host__ __device__ __forceinline__ void stage_rc(int b, int& R, int& C) { const int st = b / 1024, sb = b % 1024, swz = sb ^ (((sb >> 9) & 1) << 5); R = (st >> 1) * 16 + swz / 64; C = (st & 1) * 32 + (swz % 64) / 2; }
__host__ __device__ __forceinline__ int perm32(int rho) { const int n = rho >> 4, i = rho & 15; return 8 * (i >> 2) + 4 * n + (i & 3); }

struct Unit { int pm, pn, idx; };
struct Gemm { const bf16_t* A; const bf16_t* Bt; int M, N, K; };

struct StaticOrder {
    int nM, nN, nwg, G, c;
    __host__ __device__ void init(int M, int N, int G_, int c_) { nM = M / BM; nN = N / BM; nwg = nM * nN; G = G_; c = c_; }
    __host__ __device__ bool next(int i, Unit& u) const {
        const long L = (long)i * G + c; if (L >= nwg) return false;
        int wgid = (int)L; { const int q = nwg / NXCD, r = nwg % NXCD, xcd = wgid % NXCD, off = wgid / NXCD; wgid = (xcd < r ? xcd * (q + 1) : r * (q + 1) + (xcd - r) * q) + off; }
        const int nig = WGM * nN, gid = wgid / nig, fm = gid * WGM, gsz = (nM - fm) < WGM ? (nM - fm) : WGM;
        u.pm = fm + ((wgid % nig) % gsz); u.pn = (wgid % nig) / gsz; return true;
    }
    __device__ __forceinline__ void a_ready(const Unit&) const {}
    __device__ __forceinline__ void done(const Unit&) const {}
    __device__ __forceinline__ const char* a_base(const Gemm& g, const Unit& u) const { return (const char*)g.A + (size_t)u.pm * ((size_t)BM * g.K * 2); }
    __device__ __forceinline__ const char* b_base(const Gemm& g, const Unit& u) const { return (const char*)g.Bt + (size_t)u.pn * ((size_t)BM * g.K * 2); }
    __device__ __forceinline__ void a_offs(const Gemm& g, const Unit& u, int tid, unsigned (&VO)[2][2]) const {
#pragma unroll
        for (int i = 0; i < 2; ++i) { int R, C; stage_rc(tid * 16 + i * 8192, R, C);
#pragma unroll
            for (int h = 0; h < 2; ++h) VO[h][i] = (unsigned)((u.pm * BM + h * HALF + R) * g.K + C) * 2u; } }
};

__device__ __forceinline__ unsigned cvt_pk_bf16(float lo, float hi) { unsigned r; asm volatile("v_cvt_pk_bf16_f32 %0, %1, %2" : "=v"(r) : "v"(lo), "v"(hi)); return r; }

struct EpiOutproj {
    static constexpr bool PERM = true, AFTER_DRAIN = false;
    float* y; const bf16_t* XN;
    __device__ __forceinline__ void operator()(const f32x4 (&acc)[2][2][4][2], const Unit& u, int wr, int wc, int fr, int fq) const {
#pragma unroll
        for (int ai = 0; ai < 2; ++ai)
#pragma unroll
            for (int m = 0; m < 4; ++m) {
                const size_t ro = (size_t)(u.pm * BM + ai * HALF + wr * 64 + m * 16 + fr) * DM + u.pn * BM + wc * 32 + 8 * fq;
#pragma unroll
                for (int bj = 0; bj < 2; ++bj) {
                    const u32x4 xn = *(const u32x4*)(XN + ro + bj * HALF);
                    f32x4 v0 = acc[ai][bj][m][0], v1 = acc[ai][bj][m][1];
                    v0[0] += ALPHA * __uint_as_float(xn.x << 16); v0[1] += ALPHA * __uint_as_float(xn.x & 0xffff0000u); v0[2] += ALPHA * __uint_as_float(xn.y << 16); v0[3] += ALPHA * __uint_as_float(xn.y & 0xffff0000u);
                    v1[0] += ALPHA * __uint_as_float(xn.z << 16); v1[1] += ALPHA * __uint_as_float(xn.z & 0xffff0000u); v1[2] += ALPHA * __uint_as_float(xn.w << 16); v1[3] += ALPHA * __uint_as_float(xn.w & 0xffff0000u);
                    *(f32x4*)(y + ro + bj * HALF) = v0; *(f32x4*)(y + ro + bj * HALF + 4) = v1;
                }
            }
    }
};
struct SingleUnit {
    int pm, pn, have;
    __device__ __forceinline__ bool next(int i, Unit& u) const { if (i > 0 || !have) return false; u.pm = pm; u.pn = pn; u.idx = 0; return true; }
    __device__ __forceinline__ void a_ready(const Unit&) const {}
    __device__ __forceinline__ void done(const Unit&) const {}
    __device__ __forceinline__ const char* b_base(const Gemm& g, const Unit& u) const { return (const char*)g.Bt + (size_t)u.pn * ((size_t)BM * g.K * 2); }
    __device__ __forceinline__ void a_offs(const Gemm& g, const Unit& u, int tid, unsigned (&VO)[2][2]) const {
#pragma unroll
        for (int i = 0; i < 2; ++i) { int R, C; stage_rc(tid * 16 + i * 8192, R, C);
#pragma unroll
            for (int h = 0; h < 2; ++h) VO[h][i] = (unsigned)((u.pm * BM + h * HALF + R) * g.K + C) * 2u; } }
};
template <bool GATHER> struct GroupOrder {
    const PG8_LAS int* ul; int n; const int* tokl; int b_rows;
    __device__ __forceinline__ bool next(int i, Unit& u) const { if (i >= n) return false; const PG8_LAS int* p = ul + 6 * i; u.pm = p[1]; u.pn = p[2]; u.idx = i; return true; }
    __device__ __forceinline__ void a_ready(const Unit&) const {}
    __device__ __forceinline__ void done(const Unit&) const {}
    __device__ __forceinline__ const char* b_base(const Gemm& g, const Unit& u) const { return (const char*)g.Bt + ((size_t)ul[6 * u.idx] * b_rows + (size_t)u.pn * BM) * ((size_t)g.K * 2); }
    __device__ __forceinline__ void a_offs(const Gemm& g, const Unit& u, int tid, unsigned (&VO)[2][2]) const {
        const PG8_LAS int* p = ul + 6 * u.idx; const int e = p[0], aux = p[3], nv = p[5];
#pragma unroll
        for (int i = 0; i < 2; ++i) { int R, C; stage_rc(tid * 16 + i * 8192, R, C);
#pragma unroll
            for (int h = 0; h < 2; ++h) {
                const int rl = h * HALF + R; int row;
                if (GATHER) { row = 0; if (rl < nv) row = tokl[(size_t)e * CAP + u.pm * BM + rl]; }
                else row = aux + rl;
                VO[h][i] = (unsigned)(row * g.K + C) * 2u; } }
    }
};
__device__ __forceinline__ float silu_f(float v) { return v / (1.f + __expf(-v)); }
template <bool LIST> struct EpiGU {
    static constexpr bool PERM = true, AFTER_DRAIN = false;
    bf16_t* HID; const PG8_LAS int* ul;
    __device__ __forceinline__ void operator()(const f32x4 (&acc)[2][2][4][2], const Unit& u, int wr, int wc, int fr, int fq) const {
        const int aux = LIST ? ul[6 * u.idx + 3] : u.pm * BM;
#pragma unroll
        for (int ai = 0; ai < 2; ++ai)
#pragma unroll
            for (int m = 0; m < 4; ++m) {
                bf16_t* rowp = HID + (size_t)(aux + ai * HALF + wr * 64 + m * 16 + fr) * EFF + u.pn * 128 + wc * 16 + fq * 4;
#pragma unroll
                for (int bj = 0; bj < 2; ++bj) {
                    const f32x4 v0 = acc[ai][bj][m][0], v1 = acc[ai][bj][m][1];
                    unsigned w0 = cvt_pk_bf16(silu_f(v0[0]) * v0[1], silu_f(v0[2]) * v0[3]), w1 = cvt_pk_bf16(silu_f(v1[0]) * v1[1], silu_f(v1[2]) * v1[3]);
                    typedef unsigned u32x2 __attribute__((ext_vector_type(2)));
                    *(u32x2*)(rowp + bj * 64) = (u32x2){w0, w1};
                }
            }
    }
};
struct EpiBase {
    static constexpr bool PERM = true, AFTER_DRAIN = false;
    bf16_t* H1;
    __device__ __forceinline__ void operator()(const f32x4 (&acc)[2][2][4][2], const Unit& u, int wr, int wc, int fr, int fq) const {
#pragma unroll
        for (int ai = 0; ai < 2; ++ai)
#pragma unroll
            for (int m = 0; m < 4; ++m) {
                bf16_t* rowp = H1 + (size_t)(u.pm * BM + ai * HALF + wr * 64 + m * 16 + fr) * DM + u.pn * BM + wc * 32 + 8 * fq;
#pragma unroll
                for (int bj = 0; bj < 2; ++bj) {
                    const u32x4 xn = *(const u32x4*)(rowp + bj * HALF);
                    const f32x4 v0 = acc[ai][bj][m][0], v1 = acc[ai][bj][m][1];
                    u32x4 w;
                    w.x = cvt_pk_bf16(v0[0] + ALPHA * __uint_as_float(xn.x << 16), v0[1] + ALPHA * __uint_as_float(xn.x & 0xffff0000u)); w.y = cvt_pk_bf16(v0[2] + ALPHA * __uint_as_float(xn.y << 16), v0[3] + ALPHA * __uint_as_float(xn.y & 0xffff0000u));
                    w.z = cvt_pk_bf16(v1[0] + ALPHA * __uint_as_float(xn.z << 16), v1[1] + ALPHA * __uint_as_float(xn.z & 0xffff0000u)); w.w = cvt_pk_bf16(v1[2] + ALPHA * __uint_as_float(xn.w << 16), v1[3] + ALPHA * __uint_as_float(xn.w & 0xffff0000u));
                    *(u32x4*)(rowp + bj * HALF) = w;
                }
            }
    }
};
struct EpiY {
    static constexpr bool PERM = true, AFTER_DRAIN = false;
    bf16_t* Y; const float* GATEL; const PG8_LAS int* ul;
    __device__ __forceinline__ void operator()(const f32x4 (&acc)[2][2][4][2], const Unit& u, int wr, int wc, int fr, int fq) const {
        const PG8_LAS int* p = ul + 6 * u.idx; const int e = p[0], aux2 = p[4], nv = p[5];
#pragma unroll
        for (int ai = 0; ai < 2; ++ai)
#pragma unroll
            for (int m = 0; m < 4; ++m) {
                const int rl = ai * HALF + wr * 64 + m * 16 + fr;
                if (rl < nv) {
                    const float gt = GATEL[(size_t)e * CAP + u.pm * BM + rl];
                    bf16_t* rowp = Y + (size_t)(aux2 + rl) * DM + u.pn * BM + wc * 32 + 8 * fq;
#pragma unroll
                    for (int bj = 0; bj < 2; ++bj) {
                        const f32x4 v0 = acc[ai][bj][m][0] * gt, v1 = acc[ai][bj][m][1] * gt;
                        u32x4 w; w.x = cvt_pk_bf16(v0[0], v0[1]); w.y = cvt_pk_bf16(v0[2], v0[3]); w.z = cvt_pk_bf16(v1[0], v1[1]); w.w = cvt_pk_bf16(v1[2], v1[3]);
                        *(u32x4*)(rowp + bj * HALF) = w;
                    }
                }
            }
    }
};
struct EpiRouter {
    static constexpr bool PERM = true, AFTER_DRAIN = true;
    const float* rbias; int* cnt; int* TOKL; float* GATEL; int* ASG;
    __device__ __forceinline__ void fused(f32x4 (&acc)[2][2][4][2], const Unit& u, int wr, int wc, int fr, int fq, PG8_LAS unsigned char* lds, int wid, int lane) const {
        PG8_LAS float* L = (PG8_LAS float*)lds;
        PG8_LAS float* rb = L + 256 * 65; PG8_LAS int* lcnt = (PG8_LAS int*)(rb + 64); PG8_LAS int* base = lcnt + 64;
        const int tid = wid * 64 + lane;
        if (tid < 64) { rb[tid] = rbias[tid]; lcnt[tid] = 0; }
        if (wc < 2) {
#pragma unroll
            for (int ai = 0; ai < 2; ++ai)
#pragma unroll
                for (int m = 0; m < 4; ++m)
#pragma unroll
                    for (int n = 0; n < 2; ++n) { const int rl = ai * HALF + wr * 64 + m * 16 + fr, e0 = wc * 32 + fq * 8 + n * 4; const f32x4 v = acc[ai][0][m][n];
#pragma unroll
                        for (int q = 0; q < 4; ++q) L[rl * 65 + e0 + q] = 1.f / (1.f + expf(-v[q])); }
        }
        __syncthreads();
        int sel[6]; int lr[6]; float gv[6]; float scale = 0.f;
        if (tid < 256) {
            const PG8_LAS float* my = L + tid * 65;
            float gs[8];
#pragma unroll
            for (int g = 0; g < 8; ++g) {
                float m1 = -3e38f, m2 = -3e38f;
#pragma unroll
                for (int j = 0; j < 8; ++j) { const float v = my[g * 8 + j] + rb[g * 8 + j]; if (v > m1) { m2 = m1; m1 = v; } else if (v > m2) m2 = v; }
                gs[g] = m1 + m2;
            }
            unsigned gmask = 0;
#pragma unroll
            for (int r = 0; r < 4; ++r) {
                float best = -3e38f; int bi = 0;
#pragma unroll
                for (int g = 0; g < 8; ++g) { const bool take = !((gmask >> g) & 1u) && gs[g] > best; if (take) { best = gs[g]; bi = g; } }
                gmask |= 1u << bi;
            }
            unsigned long long chosen = 0ull; float gsum = 0.f;
#pragma unroll
            for (int r = 0; r < 6; ++r) {
                float best = -3e38f; int bi = 0;
                for (int e = 0; e < 64; ++e) { if (((gmask >> (e >> 3)) & 1u) && !((chosen >> e) & 1ull)) { const float v = my[e] + rb[e]; if (v > best) { best = v; bi = e; } } }
                chosen |= 1ull << bi; sel[r] = bi; gv[r] = my[bi]; gsum += gv[r];
                lr[r] = __hip_atomic_fetch_add(lcnt + bi, 1, __ATOMIC_RELAXED, __HIP_MEMORY_SCOPE_WORKGROUP);
            }
            scale = ROUTED_SCALE / gsum;
        }
        __syncthreads();
        if (tid < 64) base[tid] = atomicAdd(cnt + tid, lcnt[tid]);
        __syncthreads();
        if (tid < 256) {
            const int tok = u.pm * BM + tid;
#pragma unroll
            for (int r = 0; r < 6; ++r) { const int e = sel[r], rank = base[e] + lr[r]; TOKL[(size_t)e * CAP + rank] = tok; GATEL[(size_t)e * CAP + rank] = gv[r] * scale; ASG[(size_t)tok * 6 + r] = (e << 16) | rank; }
        }
        __syncthreads();
    }
};
struct EpiInproj {
    static constexpr bool PERM = true, AFTER_DRAIN = false;
    bf16_t* bufs; const float* tab;
    __device__ __forceinline__ void operator()(const f32x4 (&acc)[2][2][4][2], const Unit& u, int wr, int wc, int fr, int fq) const {
        const int g = u.pn >> 1;
        bf16_t* base = bufs + (size_t)g * BUFE;
        const int ccb = (u.pn & 1) * 256 + wc * 32 + 8 * fq;
        float ihi[4], ilo[4];
#pragma unroll
        for (int jj = 0; jj < 4; ++jj) { ihi[jj] = 0.f; ilo[jj] = 0.f; }
        if (g < 2) {
#pragma unroll
            for (int jj = 0; jj < 4; ++jj) { const int j = 16 * wc + 4 * fq + jj; ihi[jj] = tab[2 * j]; ilo[jj] = tab[2 * j + 1]; }
        }
#pragma unroll
        for (int ai = 0; ai < 2; ++ai)
#pragma unroll
            for (int m = 0; m < 4; ++m) {
                const int row = u.pm * BM + ai * HALF + wr * 64 + m * 16 + fr; const int b = row >> 12, i = row & 4095;
                bf16_t* rowp = base + ((size_t)b * LT + XPOS0 + i) * 512 + ccb;
                float cs[4], sn[4];
                if (g < 2) {
                    const float t = (float)(NMETA + i);
#pragma unroll
                    for (int jj = 0; jj < 4; ++jj) { const float p = t * ihi[jj]; const float e = __builtin_fmaf(t, ihi[jj], -p) + t * ilo[jj]; const float f = (p - __builtin_floorf(p)) + e;
                        sn[jj] = __builtin_amdgcn_sinf(f); cs[jj] = __builtin_amdgcn_cosf(f); }
                }
#pragma unroll
                for (int bj = 0; bj < 2; ++bj) {
                    f32x4 v0 = acc[ai][bj][m][0], v1 = acc[ai][bj][m][1];
                    if (g < 2) {
                        f32x4 r0, r1;
                        r0[0] = v0[0] * cs[0] - v0[1] * sn[0]; r0[1] = v0[1] * cs[0] + v0[0] * sn[0]; r0[2] = v0[2] * cs[1] - v0[3] * sn[1]; r0[3] = v0[3] * cs[1] + v0[2] * sn[1];
                        r1[0] = v1[0] * cs[2] - v1[1] * sn[2]; r1[1] = v1[1] * cs[2] + v1[0] * sn[2]; r1[2] = v1[2] * cs[3] - v1[3] * sn[3]; r1[3] = v1[3] * cs[3] + v1[2] * sn[3];
                        const float sc = (g == 1) ? RK_SCALE : 1.f; v0 = r0 * sc; v1 = r1 * sc;
                    } else if (g == 3) {
#pragma unroll
                        for (int q = 0; q < 4; ++q) { v0[q] = v0[q] / (1.f + __expf(-v0[q])); v1[q] = v1[q] / (1.f + __expf(-v1[q])); }
                    } else if (g == 4) { v0 = v0 * C2; v1 = v1 * C2; }
                    u32x4 w; w.x = cvt_pk_bf16(v0[0], v0[1]); w.y = cvt_pk_bf16(v0[2], v0[3]); w.z = cvt_pk_bf16(v1[0], v1[1]); w.w = cvt_pk_bf16(v1[2], v1[3]);
                    *(u32x4*)(rowp + bj * HALF) = w;
                }
            }
    }
};
template <class Epi, class Sched, bool ALIGN_EPI = false, bool SP2 = false>
__device__ __forceinline__ void gemm_phase(PG8_LAS unsigned char* lds, const Gemm g, const Sched& S, const Epi& E) {
    const int tid = threadIdx.x, wid = __builtin_amdgcn_readfirstlane(tid >> 6), lane = tid & 63, wr = wid >> 2, wc = wid & 3, fr = lane & 15, fq = lane >> 4;
    const int K = g.K, nt = K / BK;
    unsigned voffB[2];
#pragma unroll
    for (int i = 0; i < 2; ++i) { int R, C; stage_rc(tid * 16 + i * 8192, R, C); const int Rb = Epi::PERM ? ((R & ~31) + perm32(R & 31)) : R;
        voffB[i] = (unsigned)(Rb * K + C) * 2u; }
    const size_t kstep = (size_t)(BK * 2);
    const size_t hstep = (size_t)HALF * K * 2;
    const unsigned ldsw = (unsigned)wid * 1024u;
    const int aoff = lds_byte(wr * 64 + fr, fq * 8), boff = lds_byte(wc * 32 + fr, fq * 8);
#define PG8_SA(b, h) (((b) * 2 + (h)) * HTB)
#define PG8_SB(b, h) ((4 + (b) * 2 + (h)) * HTB)
#define PG8_STAGE(bufoff, gbase, voff) do { _Pragma("unroll") for (int _i = 0; _i < 2; ++_i) \
        __builtin_amdgcn_global_load_lds((const unsigned*)((const char*)(gbase) + (voff)[_i]), (PG8_LAS unsigned*)(lds + (bufoff) + ldsw + _i * 8192), 16, 0, 0); } while (0)
#define PG8_STAGEA(bufoff, VO, h, kofs) do { _Pragma("unroll") for (int _i = 0; _i < 2; ++_i) \
        __builtin_amdgcn_global_load_lds((const unsigned*)(Ab + (size_t)(VO)[h][_i] + (size_t)(kofs)), (PG8_LAS unsigned*)(lds + (bufoff) + ldsw + _i * 8192), 16, 0, 0); } while (0)
#define PG8_LDA(dst, b, h) do { _Pragma("unroll") for (int m = 0; m < 4; ++m) _Pragma("unroll") for (int k = 0; k < 2; ++k) dst[m][k] = *(const PG8_LAS bf16x8*)(lds + PG8_SA(b, h) + aoff + m * 2048 + k * 1024); } while (0)
#define PG8_LDB(dst, b, h) do { _Pragma("unroll") for (int n = 0; n < 2; ++n) _Pragma("unroll") for (int k = 0; k < 2; ++k) dst[n][k] = *(const PG8_LAS bf16x8*)(lds + PG8_SB(b, h) + boff + n * 2048 + k * 1024); } while (0)
#define PG8_MMA(ai, bj, At, Bt) do { __builtin_amdgcn_s_setprio(1); _Pragma("unroll") for (int m = 0; m < 4; ++m) _Pragma("unroll") for (int n = 0; n < 2; ++n) _Pragma("unroll") for (int k = 0; k < 2; ++k) \
        acc[ai][bj][m][n] = __builtin_amdgcn_mfma_f32_16x16x32_bf16(Bt[n][k], At[m][k], acc[ai][bj][m][n], 0, 0, 0); __builtin_amdgcn_s_setprio(0); } while (0)
#define PG8_WAIT_V(n) asm volatile("s_waitcnt vmcnt(" #n ")" ::: "memory")
#define PG8_WAIT_L(n) asm volatile("s_waitcnt lgkmcnt(" #n ")" ::: "memory")
#define PG8_BAR __builtin_amdgcn_s_barrier()
#define PG8_SCHED __builtin_amdgcn_sched_barrier(0)
    Unit cur, nxt; int ui = 0;
    if (!S.next(0, cur)) return;
    f32x4 acc[2][2][4][2];
#pragma unroll
    for (int a = 0; a < 2; ++a)
#pragma unroll
        for (int b = 0; b < 2; ++b)
#pragma unroll
            for (int m = 0; m < 4; ++m)
#pragma unroll
                for (int n = 0; n < 2; ++n) acc[a][b][m][n] = (f32x4){0.f, 0.f, 0.f, 0.f};
    bf16x8 At[4][2], B0[2][2], B1[2][2];
    const char* Ab = (const char*)g.A; const char* cB = S.b_base(g, cur);
    unsigned VA[2][2], VN[2][2];
    S.a_offs(g, cur, tid, VA);
    S.a_ready(cur);
    if constexpr (SP2) {
        PG8_STAGE(PG8_SB(0, 0), cB, voffB); PG8_STAGE(PG8_SB(0, 1), cB + hstep, voffB); PG8_STAGEA(PG8_SA(0, 0), VA, 0, 0); PG8_STAGEA(PG8_SA(0, 1), VA, 1, 0);
        if (wr == 1) PG8_BAR;
        PG8_WAIT_V(2); PG8_BAR;
        PG8_STAGE(PG8_SB(1, 0), cB + kstep, voffB); PG8_STAGEA(PG8_SA(1, 0), VA, 0, kstep); PG8_STAGE(PG8_SB(1, 1), cB + hstep + kstep, voffB);
        PG8_WAIT_V(6); PG8_BAR;
    } else { static_assert(SP2, "only the SP2 loop is kept in this file"); }
    for (;;) {
        const bool has_next = S.next(ui + 1, nxt);
        const char* nB = has_next ? S.b_base(g, nxt) : cB;
        if (has_next) S.a_offs(g, nxt, tid, VN);
        else {
#pragma unroll
            for (int h = 0; h < 2; ++h)
#pragma unroll
                for (int i = 0; i < 2; ++i) VN[h][i] = VA[h][i]; }
#pragma unroll 1
        for (int t = 0; t < nt; t += 2) {
            const bool last = (t == nt - 2);
            const size_t k1 = (size_t)(t + 1) * kstep, k2 = last ? (size_t)0 : (size_t)(t + 2) * kstep;
            const char* b2 = last ? nB : cB + (size_t)(t + 2) * kstep; const char* b3 = b2 + kstep;
            if (last && has_next) S.a_ready(nxt);
            if constexpr (SP2) {
            PG8_LDB(B0, 0, 0); PG8_LDB(B1, 0, 1); PG8_SCHED; PG8_LDA(At, 0, 0); PG8_STAGEA(PG8_SA(1, 1), VA, 1, k1);
            if (last) {
#pragma unroll
                for (int h = 0; h < 2; ++h)
#pragma unroll
                    for (int i = 0; i < 2; ++i) VA[h][i] = VN[h][i]; }
            PG8_WAIT_V(8); PG8_WAIT_L(0); PG8_BAR; PG8_MMA(0, 0, At, B0); PG8_MMA(0, 1, At, B1); PG8_BAR; PG8_SCHED;
            PG8_LDA(At, 0, 1); PG8_STAGE(PG8_SB(0, 0), b2, voffB); PG8_STAGE(PG8_SB(0, 1), b2 + hstep, voffB); PG8_STAGEA(PG8_SA(0, 0), VA, 0, k2);
            PG8_WAIT_V(8); PG8_WAIT_L(0); PG8_BAR; PG8_MMA(1, 0, At, B0); PG8_MMA(1, 1, At, B1); PG8_BAR; PG8_SCHED;
            PG8_LDB(B0, 1, 0); PG8_LDB(B1, 1, 1); PG8_SCHED; PG8_LDA(At, 1, 0); PG8_STAGEA(PG8_SA(0, 1), VA, 1, k2);
            PG8_WAIT_V(8); PG8_WAIT_L(0); PG8_BAR; PG8_MMA(0, 0, At, B0); PG8_MMA(0, 1, At, B1); PG8_BAR; PG8_SCHED;
            PG8_LDA(At, 1, 1); PG8_STAGE(PG8_SB(1, 0), b3, voffB); PG8_STAGE(PG8_SB(1, 1), b3 + hstep, voffB); PG8_STAGEA(PG8_SA(1, 0), VA, 0, k2 + kstep);
            PG8_WAIT_V(8); PG8_WAIT_L(0); PG8_BAR; PG8_MMA(1, 0, At, B0); PG8_MMA(1, 1, At, B1); PG8_BAR; PG8_SCHED;
            }
        }
        if constexpr (ALIGN_EPI) { if (wr == 0) PG8_BAR; }
        if constexpr (!Epi::AFTER_DRAIN) { E(acc, cur, wr, wc, fr, fq); S.done(cur); }
        if (!has_next) break;
#pragma unroll
        for (int a = 0; a < 2; ++a)
#pragma unroll
            for (int b = 0; b < 2; ++b)
#pragma unroll
                for (int m = 0; m < 4; ++m)
#pragma unroll
                    for (int n = 0; n < 2; ++n) acc[a][b][m][n] = (f32x4){0.f, 0.f, 0.f, 0.f};
        cur = nxt; cB = nB; ++ui;
        if constexpr (ALIGN_EPI) { if (wr == 1) PG8_BAR; }
    }
    PG8_WAIT_V(0);
    if constexpr (!ALIGN_EPI) { if (wr == 0) PG8_BAR; }
    PG8_BAR;
    if constexpr (Epi::AFTER_DRAIN) { E.fused(acc, cur, wr, wc, fr, fq, lds, wid, lane); S.done(cur); }
#undef PG8_SA
#undef PG8_SB
#undef PG8_STAGE
#undef PG8_STAGEA
#undef PG8_LDA
#undef PG8_LDB
#undef PG8_MMA
#undef PG8_WAIT_V
#undef PG8_WAIT_L
#undef PG8_BAR
#undef PG8_SCHED
}
}

#include <hip/hip_bf16.h>
namespace attn_body {
using bf16=__hip_bfloat16;
using bf16x8=__attribute__((ext_vector_type(8)))short;
using s16x4=__attribute__((ext_vector_type(4)))short;
using f32x16=__attribute__((ext_vector_type(16)))float;
using u32x4=__attribute__((ext_vector_type(4)))unsigned;
constexpr int BATCH=8,NHEAD=8,SEQ=4352,D=64,DM=512,OPITCH=1024,OCOL0=512,T0=2,XROWS=4096;
constexpr int NW=8,QBLK=32,QB=QBLK*NW,KVBLK=64,NQB=SEQ/QB;
constexpr int ATTN_PITCH=DM, ATTN_UNIT_ROWS=QB;
__device__ __forceinline__ int crow(int r,int hi){return (r&3)+8*(r>>2)+4*hi;}
#define SBAR() __builtin_amdgcn_sched_barrier(0)
__device__ __forceinline__ void cmask(f32x16&p0,f32x16&p1,int jb,int qrel,int hi){
  const float NEG=-INFINITY; int kb=64*jb+4*hi;
  #pragma unroll
  for(int r=0;r<16;++r){int kv=kb+(r&3)+8*(r>>2); if(kv>qrel)p0[r]=NEG; if(kv+32>qrel)p1[r]=NEG;}
}

constexpr int NSLOT=3, SLOTB=8192;
constexpr int LDS_K=0, LDS_V=NSLOT*SLOTB, LDS_WS=2*NSLOT*SLOTB, LDS_OST=LDS_WS+NW*64*4, LDS_BIAS=LDS_OST+NW*4096, LDS_BYTES=LDS_BIAS+SEQ*4;
constexpr float C2=0.125f*1.4426950408889634f;
__device__ __forceinline__ void glds16(const void*gsrc,unsigned lds_dst){unsigned keep;
  asm volatile("s_mov_b32 %0, m0\n\ts_mov_b32 m0, %2\n\ts_nop 0\n\tglobal_load_lds_dwordx4 %1, off\n\ts_mov_b32 m0, %0":"=&s"(keep):"v"(gsrc),"s"(lds_dst):"memory");}
__device__ __forceinline__ float max3f(float a,float b,float c){float r;asm("v_max3_f32 %0, %1, %2, %3":"=v"(r):"v"(a),"v"(b),"v"(c));return r;}
__device__ __forceinline__ float max2f(float a,float b){float r;asm("v_max_f32_e32 %0, %1, %2":"=v"(r):"v"(a),"v"(b));return r;}
__device__ __forceinline__ float fadd_s(float a,float b){float r;asm("v_add_f32_e32 %0, %1, %2":"=v"(r):"v"(a),"v"(b));return r;}
__device__ __forceinline__ float fsub_s(float a,float b){float r;asm("v_sub_f32_e32 %0, %1, %2":"=v"(r):"v"(a),"v"(b));return r;}
typedef float f32x2_t __attribute__((ext_vector_type(2))); typedef __bf16 bf16x2_t __attribute__((ext_vector_type(2)));
__device__ __forceinline__ unsigned cvtpk_s(float lo,float hi){f32x2_t v={lo,hi};bf16x2_t b=__builtin_convertvector(v,bf16x2_t);return __builtin_bit_cast(unsigned,b);}
#define WAIT_BAR(N) asm volatile("s_waitcnt vmcnt(" #N ") lgkmcnt(0)\n\ts_barrier":::"memory")

__device__ __forceinline__ void qkt(f32x16&p0,f32x16&p1,const char*Kslot,const bf16x8*qr,const f32x16 c0in,const f32x16 c1in,int r32,int hi){
  const char*kb=Kslot+hi*1024+r32*16;
  #pragma unroll
  for(int d0=0;d0<4;++d0){
    const bf16x8 b0=*reinterpret_cast<const bf16x8*>(kb+d0*2048);
    const bf16x8 b1=*reinterpret_cast<const bf16x8*>(kb+d0*2048+512);
    if(d0==0){p0=__builtin_amdgcn_mfma_f32_32x32x16_bf16(b0,qr[0],c0in,0,0,0);p1=__builtin_amdgcn_mfma_f32_32x32x16_bf16(b1,qr[0],c1in,0,0,0);}
    else{p0=__builtin_amdgcn_mfma_f32_32x32x16_bf16(b0,qr[d0],p0,0,0,0);p1=__builtin_amdgcn_mfma_f32_32x32x16_bf16(b1,qr[d0],p1,0,0,0);}}
}
typedef __attribute__((address_space(3))) const char* lds_cptr;
typedef short v4i16_t __attribute__((ext_vector_type(4)));
__device__ __forceinline__ void kload8(bf16x8*kf,lds_cptr kp){
  kf[0]=*(const __attribute__((address_space(3))) bf16x8*)(kp);      kf[1]=*(const __attribute__((address_space(3))) bf16x8*)(kp+512);
  kf[2]=*(const __attribute__((address_space(3))) bf16x8*)(kp+2048); kf[3]=*(const __attribute__((address_space(3))) bf16x8*)(kp+2560);
  kf[4]=*(const __attribute__((address_space(3))) bf16x8*)(kp+4096); kf[5]=*(const __attribute__((address_space(3))) bf16x8*)(kp+4608);
  kf[6]=*(const __attribute__((address_space(3))) bf16x8*)(kp+6144); kf[7]=*(const __attribute__((address_space(3))) bf16x8*)(kp+6656);
}
__device__ __forceinline__ void kload2(bf16x8*kf,lds_cptr kp,int j){ kf[2*j]=*(const __attribute__((address_space(3))) bf16x8*)(kp+j*2048); kf[2*j+1]=*(const __attribute__((address_space(3))) bf16x8*)(kp+j*2048+512); }
__device__ __forceinline__ s16x4 vtr(lds_cptr p){ return __builtin_bit_cast(s16x4,__builtin_amdgcn_ds_read_tr16_b64_v4i16((__attribute__((address_space(3))) v4i16_t*)p)); }
__device__ __forceinline__ float rowmax(const f32x16&p0,const f32x16&p1){
  float a=max3f(p0[0],p0[1],p1[0]),b=max3f(p0[2],p0[3],p1[1]);a=max3f(a,p1[2],p1[3]);
  #pragma unroll
  for(int r=4;r<16;r+=4){a=max3f(a,p0[r],p0[r+1]);b=max3f(b,p0[r+2],p0[r+3]);a=max3f(a,p1[r],p1[r+1]);b=max3f(b,p1[r+2],p1[r+3]);}
  const float m=max2f(a,b);
  auto rr=__builtin_amdgcn_permlane32_swap(__float_as_uint(m),__float_as_uint(m),false,false);
  return max2f(__uint_as_float(rr[0]),__uint_as_float(rr[1]));
}
__device__ __forceinline__ void pv(f32x16*o,int vb,bf16x8 pa0,bf16x8 pa1,bf16x8 pa2,bf16x8 pa3){
  #pragma unroll
  for(int d0=0;d0<2;++d0){s16x4 lo[4],hi[4];
    #pragma unroll
    for(int ks=0;ks<4;++ks){
      asm volatile("ds_read_b64_tr_b16 %0,%1 offset:%c2":"=&v"(lo[ks]):"v"(vb),"i"(d0*4096+ks*1024):"memory");
      asm volatile("ds_read_b64_tr_b16 %0,%1 offset:%c2":"=&v"(hi[ks]):"v"(vb),"i"(d0*4096+ks*1024+512):"memory");}
    asm volatile("s_waitcnt lgkmcnt(0)":::"memory");SBAR();
    #define PK(k) (bf16x8){lo[k][0],lo[k][1],lo[k][2],lo[k][3],hi[k][0],hi[k][1],hi[k][2],hi[k][3]}
    o[d0]=__builtin_amdgcn_mfma_f32_32x32x16_bf16(pa0,PK(0),o[d0],0,0,0);
    o[d0]=__builtin_amdgcn_mfma_f32_32x32x16_bf16(pa1,PK(1),o[d0],0,0,0);
    o[d0]=__builtin_amdgcn_mfma_f32_32x32x16_bf16(pa2,PK(2),o[d0],0,0,0);
    o[d0]=__builtin_amdgcn_mfma_f32_32x32x16_bf16(pa3,PK(3),o[d0],0,0,0);
    #undef PK
  }
}

#ifndef ATTN_STORE16
#define ATTN_STORE16(p,v) (*(u32x4*)(p)=(v))
#endif
typedef float f32x4v __attribute__((ext_vector_type(4)));
template<int THRL> __device__ __forceinline__ void attn_unit(int b,int h,int qb,unsigned char*ws,char*shm,int tid_in){
  const bf16*Q=(const bf16*)(ws+WS_RQ)+4*BUFE; const bf16*__restrict__ K=Q+BUFE; const bf16*__restrict__ V=Q+2*BUFE; const float*__restrict__ BIAS=(const float*)(ws+WS_BIAS); bf16*O=(bf16*)(ws+WS_MIXED);
  const int tid=tid_in,lane=tid&63,r32=lane&31,hi=lane>>5; const int wid=__builtin_amdgcn_readfirstlane(tid>>6);
  const long rowbase=(long)b*SEQ; const int q0=(qb+1)*QB;
  const bf16*Qw=Q+(rowbase+q0+wid*QBLK)*DM+h*D;
  const bf16*Kh=K+(rowbase+T0*KVBLK)*DM+h*D,*Vh=V+(rowbase+T0*KVBLK)*DM+h*D;
  const unsigned lds0=(unsigned)(uintptr_t)shm;
  float*wsf=(float*)(shm+LDS_WS)+wid*64;
  const bf16*ksrc=Kh+(long)lane*DM+wid*8;
  const bf16*vsrc=Vh+(long)(16*(wid&3)+(lane>>2))*DM+(wid>>2)*32+(lane&3)*8;
  const unsigned kdst=lds0+LDS_K+wid*1024, vdst=lds0+LDS_V+wid*1024;
  #define DMA_K(t,slot) glds16(ksrc+(long)(t)*KVBLK*DM,(unsigned)__builtin_amdgcn_readfirstlane(kdst+(slot)))
  #define DMA_V(t,slot) glds16(vsrc+(long)(t)*KVBLK*DM,(unsigned)__builtin_amdgcn_readfirstlane(vdst+(slot)))
  const int vb0=(int)(lds0+LDS_V)+((lane>>4)&1)*32+(lane&3)*8+(4*hi+((lane&15)>>2))*64;
  const char*Kbase=shm+LDS_K; bf16x8 kf[8];
  const lds_cptr shm3=(lds_cptr)shm; const lds_cptr kp0=shm3+LDS_K+hi*1024+r32*16; const lds_cptr vp0=shm3+LDS_V+((lane>>4)&1)*32+(lane&3)*8+(4*hi+((lane&15)>>2))*64;
  const int NT=(q0+QB)/KVBLK-T0;
  { const float*bsrc=BIAS+(long)(b*NHEAD+h)*SEQ+T0*KVBLK; float*bl=(float*)(shm+LDS_BIAS); const int nb=NT*KVBLK; for(int p=tid;p<nb;p+=NW*64)bl[p]=bsrc[p]; }
  const __attribute__((address_space(3))) float* bl3=(const __attribute__((address_space(3))) float*)((lds_cptr)shm+LDS_BIAS);
  #define BIASLD(C0,C1,t) do{ const __attribute__((address_space(3))) f32x4v* bp_=(const __attribute__((address_space(3))) f32x4v*)(bl3+(t)*KVBLK+4*hi); \
    _Pragma("unroll") for(int g_=0;g_<4;++g_){ const f32x4v x0_=bp_[2*g_],x1_=bp_[8+2*g_]; \
      C0[4*g_]=x0_[0]-mhat;C0[4*g_+1]=x0_[1]-mhat;C0[4*g_+2]=x0_[2]-mhat;C0[4*g_+3]=x0_[3]-mhat; C1[4*g_]=x1_[0]-mhat;C1[4*g_+1]=x1_[1]-mhat;C1[4*g_+2]=x1_[2]-mhat;C1[4*g_+3]=x1_[3]-mhat; } }while(0)
  DMA_K(0,0);DMA_V(0,0);DMA_K(1,SLOTB);
  bf16x8 qr[4];
  #pragma unroll
  for(int d0=0;d0<4;++d0)qr[d0]=*reinterpret_cast<const bf16x8*>(&Qw[(long)r32*DM+d0*16+hi*8]);
  float mhat=0.f,l_reg=0.f;f32x16 o[2];o[0]=f32x16{};o[1]=f32x16{};
  const int qrel=wid*QBLK+r32;
  #define CMASK(P0,P1,t) do{int jb_=(t)-(NT-4); if(jb_>=0)cmask(P0,P1,jb_,qrel,hi);}while(0)
  bool resc=false;
  #define START(P0,P1) do{ const float rm=rowmax(P0,P1); resc=false; \
    { const float dl=rm; mhat=fadd_s(mhat,dl); \
      _Pragma("unroll") for(int r=0;r<16;++r){P0[r]=fsub_s(P0[r],dl);P1[r]=fsub_s(P1[r],dl);} } \
    _Pragma("unroll") for(int r=0;r<16;++r)P0[r]=__builtin_amdgcn_exp2f(P0[r]); }while(0)
  #define RESC() do{ if(resc){ asm volatile("s_waitcnt lgkmcnt(0)":::"memory"); \
      _Pragma("unroll") for(int d_=0;d_<2;++d_) _Pragma("unroll") for(int r=0;r<16;++r)o[d_][r]*=wsf[crow(r,hi)]; } }while(0)
  f32x16 pA0,pA1,pB0,pB1;
  int sl_prev=0,sl_cur=0,sl_next=SLOTB;
  #define ROT() do{sl_prev=sl_cur;sl_cur=sl_next;sl_next=(sl_next==(NSLOT-1)*SLOTB)?0:sl_next+SLOTB;}while(0)
  DMA_K(2,2*SLOTB);
  WAIT_BAR(3);
  BIASLD(pA0,pA1,0);qkt(pA0,pA1,Kbase,qr,pA0,pA1,r32,hi);asm volatile("s_nop 15\n\ts_nop 7":"+v"(pA0),"+v"(pA1));CMASK(pA0,pA1,0);
  START(pA0,pA1);
  _Pragma("unroll") for(int r=0;r<16;++r)pA1[r]=__builtin_amdgcn_exp2f(pA1[r]);
  WAIT_BAR(0);
  DMA_K(3,0);DMA_V(1,SLOTB);
  ROT();
  kload8(kf,kp0+sl_cur);
  WAIT_BAR(2);
  s16x4 vlo[8],vhi[8]; u32x4 pw0,pw1,pw2,pw3;
  #define PKW(P,B) cvtpk_s(P[B],P[B+1])
  #define PAF(k) __builtin_bit_cast(bf16x8,pw##k)
  #define VFR(i) (bf16x8){vlo[i][0],vlo[i][1],vlo[i][2],vlo[i][3],vhi[i][0],vhi[i][1],vhi[i][2],vhi[i][3]}
  #define PIN(x) asm volatile("":"+v"(x))
  #define MX3(a,b,c) __builtin_fmaxf(__builtin_fmaxf((a),(b)),(c))
  #define GAPA(MF,A0,A1,A2,A3,W0,W1,PW) do{ MF; sacc+=A0; sacc+=A1; sacc+=A2; sacc+=A3; PIN(sacc); W0; W1; PIN(PW); SBAR(); }while(0)
  #define EX(v) __builtin_amdgcn_exp2f(v)
  #define GAPB(MF,X,B) do{ MF; X[B]=EX(X[B]); X[B+1]=EX(X[B+1]); X[B+2]=EX(X[B+2]); X[B+3]=EX(X[B+3]); PIN(X); SBAR(); }while(0)
  #define VRD(i) do{ vlo[i]=vtr(vp_+(((i)>>2)*4096+((i)&3)*1024)); vhi[i]=vtr(vp_+(((i)>>2)*4096+((i)&3)*1024+512)); }while(0)
  #define KRD(G,j) do{ if(G){ kload2(kf,kp0+sl_next,j); SBAR(); } }while(0)
  #define STEP(C0,C1,P0,P1,t,GK,GV,GL) do{ BIASLD(C0,C1,t); SBAR(); \
    const lds_cptr vp_=vp0+sl_prev; \
    VRD(0); SBAR(); float sacc=(P0[0]+P0[1]); \
    GAPA(C0=__builtin_amdgcn_mfma_f32_32x32x16_bf16(kf[0],qr[0],C0,0,0,0), P0[2],P0[3],P0[4],P0[5],     pw0[0]=PKW(P0,0), pw0[1]=PKW(P0,2), pw0); \
    VRD(4); SBAR(); GAPA(C1=__builtin_amdgcn_mfma_f32_32x32x16_bf16(kf[1],qr[0],C1,0,0,0), P0[6],P0[7],P0[8],P0[9],     pw0[2]=PKW(P0,4), pw0[3]=PKW(P0,6), pw0); \
    VRD(1); SBAR(); GAPA(C0=__builtin_amdgcn_mfma_f32_32x32x16_bf16(kf[2],qr[1],C0,0,0,0),   P0[10],P0[11],P0[12],P0[13], pw1[0]=PKW(P0,8), pw1[1]=PKW(P0,10), pw1); \
    VRD(5); SBAR(); GAPA(C1=__builtin_amdgcn_mfma_f32_32x32x16_bf16(kf[3],qr[1],C1,0,0,0),   P0[14],P0[15],P1[0],P1[1],   pw1[2]=PKW(P0,12),pw1[3]=PKW(P0,14), pw1); \
    VRD(2); SBAR(); GAPA(C0=__builtin_amdgcn_mfma_f32_32x32x16_bf16(kf[4],qr[2],C0,0,0,0),   P1[2],P1[3],P1[4],P1[5],     pw2[0]=PKW(P1,0), pw2[1]=PKW(P1,2), pw2); \
    VRD(6); SBAR(); GAPA(C1=__builtin_amdgcn_mfma_f32_32x32x16_bf16(kf[5],qr[2],C1,0,0,0),   P1[6],P1[7],P1[8],P1[9],     pw2[2]=PKW(P1,4), pw2[3]=PKW(P1,6), pw2); \
    VRD(3); SBAR(); GAPA(C0=__builtin_amdgcn_mfma_f32_32x32x16_bf16(kf[6],qr[3],C0,0,0,0),   P1[10],P1[11],P1[12],P1[13], pw3[0]=PKW(P1,8), pw3[1]=PKW(P1,10), pw3); \
    VRD(7); SBAR(); GAPA(C1=__builtin_amdgcn_mfma_f32_32x32x16_bf16(kf[7],qr[3],C1,0,0,0),   P1[14],P1[15],0.f,0.f,       pw3[2]=PKW(P1,12),pw3[3]=PKW(P1,14), pw3); \
    l_reg+=sacc; \
    if(GK){DMA_K((t)+3,sl_cur);} if(GV){DMA_V((t)+1,sl_next);} \
    CMASK(C0,C1,t); \
    { float a=MX3(C0[0],C0[1],C1[0]),b=MX3(C0[2],C0[3],C1[1]); a=MX3(a,C1[2],C1[3]); \
      _Pragma("unroll") for(int r=4;r<16;r+=4){a=MX3(a,C0[r],C0[r+1]);b=MX3(b,C0[r+2],C0[r+3]);a=MX3(a,C1[r],C1[r+1]);b=MX3(b,C1[r+2],C1[r+3]);} \
      float rm=__builtin_fmaxf(a,b); { auto rr=__builtin_amdgcn_permlane32_swap(__float_as_uint(rm),__float_as_uint(rm),false,false); rm=__builtin_fmaxf(__uint_as_float(rr[0]),__uint_as_float(rr[1])); } \
      resc=false; \
      if(__builtin_expect(__any(rm>(float)THRL),0)){ const float dl=__builtin_fmaxf(rm,0.f); mhat+=dl; \
        _Pragma("unroll") for(int r=0;r<16;++r){C0[r]-=dl;C1[r]-=dl;} \
        const float f=__builtin_amdgcn_exp2f(-dl); l_reg*=f; if(hi==0)wsf[r32]=f; resc=true; } } \
    SBAR(); \
    GAPB(o[0]=__builtin_amdgcn_mfma_f32_32x32x16_bf16(PAF(0),VFR(0),o[0],0,0,0), C0,0); \
    GAPB(o[1]=__builtin_amdgcn_mfma_f32_32x32x16_bf16(PAF(0),VFR(4),o[1],0,0,0), C0,4); \
    KRD(GL,0); GAPB(o[0]=__builtin_amdgcn_mfma_f32_32x32x16_bf16(PAF(1),VFR(1),o[0],0,0,0), C0,8); \
    KRD(GL,1); GAPB(o[1]=__builtin_amdgcn_mfma_f32_32x32x16_bf16(PAF(1),VFR(5),o[1],0,0,0), C0,12); \
    KRD(GL,2); GAPB(o[0]=__builtin_amdgcn_mfma_f32_32x32x16_bf16(PAF(2),VFR(2),o[0],0,0,0), C1,0); \
    KRD(GL,3); GAPB(o[1]=__builtin_amdgcn_mfma_f32_32x32x16_bf16(PAF(2),VFR(6),o[1],0,0,0), C1,4); \
    GAPB(o[0]=__builtin_amdgcn_mfma_f32_32x32x16_bf16(PAF(3),VFR(3),o[0],0,0,0), C1,8); \
    GAPB(o[1]=__builtin_amdgcn_mfma_f32_32x32x16_bf16(PAF(3),VFR(7),o[1],0,0,0), C1,12); \
    }while(0)
  int t=1;
  #undef CMASK
  #define CMASK(P0,P1,t) do{}while(0)
  for(;t+5<NT;t+=2){
    STEP(pB0,pB1,pA0,pA1,t,true,true,true);     WAIT_BAR(2); RESC(); ROT();
    STEP(pA0,pA1,pB0,pB1,t+1,true,true,true);   WAIT_BAR(2); RESC(); ROT();
  }
  #undef CMASK
  #define CMASK(P0,P1,t) do{int jb_=(t)-(NT-4); if(jb_>=0)cmask(P0,P1,jb_,qrel,hi);}while(0)
  #define ENDW(tt) do{ if((tt)+3<NT){WAIT_BAR(2);} else if((tt)+2<NT){WAIT_BAR(1);} else {WAIT_BAR(0);} }while(0)
  for(;t+1<NT;t+=2){
    STEP(pB0,pB1,pA0,pA1,t,(t+3<NT),(t+1<NT),(t+1<NT));       ENDW(t);   RESC(); ROT();
    STEP(pA0,pA1,pB0,pB1,t+1,(t+4<NT),(t+2<NT),(t+2<NT));     ENDW(t+1); RESC(); ROT();
  }
  STEP(pB0,pB1,pA0,pA1,NT-1,false,false,false); RESC();
  { float sacc=pB0[0]+pB0[1]; _Pragma("unroll") for(int r=2;r<16;++r)sacc+=pB0[r]; _Pragma("unroll") for(int r=0;r<16;++r)sacc+=pB1[r]; l_reg+=sacc;
    pw0=(u32x4){PKW(pB0,0),PKW(pB0,2),PKW(pB0,4),PKW(pB0,6)};pw1=(u32x4){PKW(pB0,8),PKW(pB0,10),PKW(pB0,12),PKW(pB0,14)};pw2=(u32x4){PKW(pB1,0),PKW(pB1,2),PKW(pB1,4),PKW(pB1,6)};pw3=(u32x4){PKW(pB1,8),PKW(pB1,10),PKW(pB1,12),PKW(pB1,14)};
    SBAR(); pv(o,vb0+sl_cur,PAF(0),PAF(1),PAF(2),PAF(3)); }
  #undef PKW
  #undef PAF
  #undef VFR
  #undef PIN
  #undef MX3
  #undef GAPA
  #undef GAPB
  #undef EX
  #undef VRD
  #undef KRD
  #undef STEP
  #undef ENDW
  {auto rr=__builtin_amdgcn_permlane32_swap(__float_as_uint(l_reg),__float_as_uint(l_reg),false,false);l_reg=__uint_as_float(rr[0])+__uint_as_float(rr[1]);}
  if(hi==0)wsf[32+r32]=l_reg;asm volatile("s_waitcnt lgkmcnt(0)":::"memory");
  float rli[16];
  #pragma unroll
  for(int r=0;r<16;++r)rli[r]=__builtin_amdgcn_rcpf(wsf[32+crow(r,hi)]);
  bf16*Ow=O+((long)b*XROWS+qb*QB+wid*QBLK)*OPITCH+OCOL0+h*D;
  { bf16*stg=(bf16*)(shm+LDS_OST)+wid*2048;
    #pragma unroll
    for(int r=0;r<16;++r){const int orow=crow(r,hi);
      #pragma unroll
      for(int d0=0;d0<2;++d0)stg[orow*64+d0*32+r32]=__float2bfloat16(o[d0][r]*rli[r]);}
    asm volatile("s_waitcnt lgkmcnt(0)":::"memory");
    #pragma unroll
    for(int i=0;i<4;++i){const int row=i*8+(lane>>3),ch=lane&7; const u32x4 v=*(const u32x4*)(stg+row*64+ch*8); ATTN_STORE16(Ow+(long)row*OPITCH+ch*8,v);} }
  asm volatile("s_waitcnt lgkmcnt(0)\n\ts_barrier":::"memory");
  #undef DMA_K
  #undef DMA_V
  #undef CMASK
  #undef BIASLD
  #undef START
  #undef RESC
  #undef ROT
}
constexpr int ATTN_LDS_BYTES=LDS_BYTES;
struct AttnTensors { const bf16* Q; const bf16* K; const bf16* V; const float* BIAS; bf16* O; };
struct AttnUnit { int bh; int qb; };
struct StaticOrder {
  int vcu, grid;
  __device__ __forceinline__ explicit StaticOrder(int grid_,int block):vcu((grid_%8==0)?(block%8)*(grid_/8)+block/8:block),grid(grid_){}
  __device__ __forceinline__ bool next(int i,AttnUnit&u)const{
    if(grid==256){ if(i>=4)return false; const int s=vcu&3; u.bh=vcu>>2; u.qb=(i==0)?15-s:(i==1)?8+s:(i==2)?7-s:s; return true; }
    const int L=i*grid+vcu; if(L>=BATCH*NHEAD*16)return false; u.bh=L>>4; u.qb=15-(L&15); return true; }
  __device__ __forceinline__ void a_ready(const AttnUnit&)const{}
  __device__ __forceinline__ void done(const AttnUnit&)const{}
};
template<class Sched,int THRL=8> __device__ __forceinline__ void attn_phase(char*lds,const AttnTensors&T,const Sched&S){
  AttnUnit u;
  for(int i=0;S.next(i,u);++i){ S.a_ready(u); attn_unit<THRL>(u.bh/NHEAD,u.bh%NHEAD,u.qb,(unsigned char*)T.O,lds,(int)threadIdx.x);    S.done(u); }
}
#undef SBAR
#undef WAIT_BAR
}


namespace ret_body {
typedef __attribute__((address_space(3))) const char* lds_cptr;
using bf16x8 = __attribute__((ext_vector_type(8))) short;
using s16x4 = __attribute__((ext_vector_type(4))) short;
using f32x16 = __attribute__((ext_vector_type(16))) float;
using u32x4 = __attribute__((ext_vector_type(4))) unsigned;
using u32x2 = __attribute__((ext_vector_type(2))) unsigned;
typedef short v4i16_t __attribute__((ext_vector_type(4)));
#define RLAS __attribute__((address_space(3)))
constexpr int TQ = 0, TK = 32768, TV = 65536, TS = 98304;
__device__ __forceinline__ unsigned off_b(unsigned row, unsigned ch) { return 256u * row + 16u * (ch ^ (((row & 3u) << 2) | ((row >> 2) & 3u))); }
__device__ __forceinline__ int crow(int r, int hi) { return (r & 3) + 8 * (r >> 2) + 4 * hi; }
__device__ __forceinline__ bf16x8 ldrow(lds_cptr tile, unsigned row, unsigned ch) { return *(const RLAS bf16x8*)(tile + off_b(row, ch)); }
__device__ __forceinline__ s16x4 ldtr(lds_cptr p) { return __builtin_bit_cast(s16x4, __builtin_amdgcn_ds_read_tr16_b64_v4i16((RLAS v4i16_t*)p)); }
__device__ __forceinline__ bf16x8 trfrag_nat(lds_cptr tile, unsigned lane, unsigned c, unsigned row0) {
    const unsigned h = lane >> 5, blk = (lane >> 4) & 1, q = (lane & 15) >> 2, p = lane & 3, ch = 4 * c + 2 * blk + (p >> 1), ob = 8 * (p & 1);
    const s16x4 lo = ldtr(tile + off_b(row0 + 8 * h + q, ch) + ob), hi = ldtr(tile + off_b(row0 + 8 * h + 4 + q, ch) + ob);
    return (bf16x8){lo[0], lo[1], lo[2], lo[3], hi[0], hi[1], hi[2], hi[3]};
}
__device__ __forceinline__ bf16x8 trfrag_acc(lds_cptr tile, unsigned lane, unsigned c, unsigned row0) {
    const unsigned h = lane >> 5, blk = (lane >> 4) & 1, q = (lane & 15) >> 2, p = lane & 3, ch = 4 * c + 2 * blk + (p >> 1), ob = 8 * (p & 1);
    const s16x4 lo = ldtr(tile + off_b(row0 + 4 * h + q, ch) + ob), hi = ldtr(tile + off_b(row0 + 8 + 4 * h + q, ch) + ob);
    return (bf16x8){lo[0], lo[1], lo[2], lo[3], hi[0], hi[1], hi[2], hi[3]};
}
typedef float f32x2_t __attribute__((ext_vector_type(2))); typedef __bf16 bf16x2_t __attribute__((ext_vector_type(2)));
__device__ __forceinline__ unsigned cvtpk(float lo, float hi) { f32x2_t v = {lo, hi}; bf16x2_t b = __builtin_convertvector(v, bf16x2_t); return __builtin_bit_cast(unsigned, b); }
__device__ __forceinline__ float bflo(unsigned u) { return __uint_as_float(u << 16); }
__device__ __forceinline__ float bfhi(unsigned u) { return __uint_as_float(u & 0xffff0000u); }
#define RMFMA(a, b, c) __builtin_amdgcn_mfma_f32_32x32x16_bf16(a, b, c, 0, 0, 0)

__device__ __forceinline__ void ret_unit(int b, int h, unsigned char* ws, char* shm, int tid_in) {
    const unsigned short* __restrict__ RQ = (const unsigned short*)(ws + WS_RQ); const unsigned short* __restrict__ RK = RQ + BUFE; const unsigned short* __restrict__ RV = RQ + 2 * BUFE; const unsigned short* __restrict__ RG = RQ + 3 * BUFE;
    unsigned short* MIXED = (unsigned short*)(ws + WS_MIXED); float* xch = (float*)(shm + 131072 + 1024);
    int tid = tid_in; const int wid = __builtin_amdgcn_readfirstlane(tid >> 6); const int ib = wid >> 1, ep = wid & 1;
    const lds_cptr s3 = (lds_cptr)shm; const lds_cptr Qt = s3 + TQ, Kt = s3 + TK, Vt = s3 + TV, St = s3 + TS;
    RLAS char* w3 = (RLAS char*)shm;
    const float lg = log2f(1.f - exp2f(-5.f - (float)h));
    const float g128 = exp2f(128.f * lg);
    f32x16 st0 = {}, st1 = {};
    const size_t rowbase = (size_t)b * LT;
    for (int i = tid; i < 2048; i += 512) *(RLAS u32x4*)(w3 + TS + 16 * i) = (u32x4){0u, 0u, 0u, 0u};
    for (int c = 1; c <= 33; ++c) {
        asm volatile("" : "+v"(tid));
        const int lane = tid & 63, r32 = lane & 31, hi = lane >> 5;
        const float xi = __builtin_amdgcn_exp2f((float)(32 * ib + r32 + 1) * lg);
#pragma unroll
        for (int i = 0; i < 4; ++i) {
            const int n = tid + 512 * i, row = n >> 4, ch = n & 15; const size_t go = (rowbase + 128 * c + row) * 512 + h * 128 + 8 * ch;
            u32x4 q = *(const u32x4*)(RQ + go), k = *(const u32x4*)(RK + go), v = *(const u32x4*)(RV + go);
            if (c == 1 && row < 112) { k = (u32x4){0u, 0u, 0u, 0u}; v = k; q = k; }
            const unsigned o = off_b(row, ch);
            *(RLAS u32x4*)(w3 + TQ + o) = q; *(RLAS u32x4*)(w3 + TK + o) = k; *(RLAS u32x4*)(w3 + TV + o) = v;
        }
        __syncthreads();
        bf16x8 qf[8];
#pragma unroll
        for (int s = 0; s < 8; ++s) qf[s] = ldrow(Qt, 32 * ib + r32, 2 * s + hi);
        f32x16 o0 = {}, o1 = {};
        if (c > 1) {
#pragma unroll
            for (int s = 0; s < 8; ++s) { const bf16x8 a0 = ldrow(St, 64 * ep + r32, 2 * s + hi), a1 = ldrow(St, 64 * ep + 32 + r32, 2 * s + hi); o0 = RMFMA(a0, qf[s], o0); o1 = RMFMA(a1, qf[s], o1); if (s & 1) __builtin_amdgcn_sched_barrier(0); }
        }
        for (int jb = 0; jb <= ib; ++jb) {
            f32x16 S = {};
#pragma unroll
            for (int s = 0; s < 8; ++s) { const bf16x8 kf = ldrow(Kt, 32 * jb + r32, 2 * s + hi); S = RMFMA(kf, qf[s], S); if ((s & 3) == 3) __builtin_amdgcn_sched_barrier(0); }
#pragma unroll
            for (int r = 0; r < 16; ++r) { float pv = S[r] * __builtin_amdgcn_exp2f(-(float)(32 * jb + crow(r, hi) + 1) * lg); if (jb == ib && crow(r, hi) > r32) pv = 0.f; S[r] = pv; }
            const u32x4 w0 = {cvtpk(S[0], S[1]), cvtpk(S[2], S[3]), cvtpk(S[4], S[5]), cvtpk(S[6], S[7])}, w1 = {cvtpk(S[8], S[9]), cvtpk(S[10], S[11]), cvtpk(S[12], S[13]), cvtpk(S[14], S[15])};
            const bf16x8 p0 = __builtin_bit_cast(bf16x8, w0), p1 = __builtin_bit_cast(bf16x8, w1);
            __builtin_amdgcn_sched_barrier(0);
            { const bf16x8 a0 = trfrag_acc(Vt, lane, 2 * ep, 32 * jb), a1 = trfrag_acc(Vt, lane, 2 * ep, 32 * jb + 16); o0 = RMFMA(a0, p0, o0); o0 = RMFMA(a1, p1, o0); }
            { const bf16x8 a0 = trfrag_acc(Vt, lane, 2 * ep + 1, 32 * jb), a1 = trfrag_acc(Vt, lane, 2 * ep + 1, 32 * jb + 16); o1 = RMFMA(a0, p0, o1); o1 = RMFMA(a1, p1, o1); }
            __builtin_amdgcn_sched_barrier(0);
        }
        float s1 = 0.f, s2 = 0.f;
#pragma unroll
        for (int r = 0; r < 16; ++r) { o0[r] *= xi; o1[r] *= xi; s1 += o0[r] + o1[r]; s2 += o0[r] * o0[r] + o1[r] * o1[r]; }
        s1 += __shfl_xor(s1, 32); s2 += __shfl_xor(s2, 32);
        if (hi == 0) { xch[(wid * 32 + r32) * 2] = s1; xch[(wid * 32 + r32) * 2 + 1] = s2; }
#pragma unroll
        for (int r = 0; r < 16; ++r) { st0[r] *= g128; st1[r] *= g128; }
#pragma unroll
        for (int ks = 0; ks < 8; ++ks) {
            const bf16x8 kr = trfrag_nat(Kt, lane, ib, 16 * ks);
            const float zx = (float)(127 - 16 * ks - 8 * hi) * lg;
#define ZF(j) __builtin_amdgcn_exp2f(zx - (float)(j) * lg)
            const u32x4 ku = __builtin_bit_cast(u32x4, kr);
            const u32x4 kz = {cvtpk(bflo(ku[0]) * ZF(0), bfhi(ku[0]) * ZF(1)), cvtpk(bflo(ku[1]) * ZF(2), bfhi(ku[1]) * ZF(3)),
                              cvtpk(bflo(ku[2]) * ZF(4), bfhi(ku[2]) * ZF(5)), cvtpk(bflo(ku[3]) * ZF(6), bfhi(ku[3]) * ZF(7))};
#undef ZF
            const bf16x8 ka = __builtin_bit_cast(bf16x8, kz);
            const bf16x8 v0 = trfrag_nat(Vt, lane, 2 * ep, 16 * ks), v1 = trfrag_nat(Vt, lane, 2 * ep + 1, 16 * ks);
            st0 = RMFMA(ka, v0, st0); st1 = RMFMA(ka, v1, st1);
            __builtin_amdgcn_sched_barrier(0);
        }
        __syncthreads();
        { const float* xp = xch + ((wid ^ 1) * 32 + r32) * 2; s1 += xp[0]; s2 += xp[1]; }
        const float mean = s1 * (1.f / 128.f), var = fmaxf(s2 * (1.f / 128.f) - mean * mean, 0.f), rstd = 1.f / sqrtf(var + LN_EPS);
        if (c >= 2) {
            const size_t grow = (rowbase + 128 * c + 32 * ib + r32) * 512 + h * 128, orow = ((size_t)b * SEQ + 128 * (c - 2) + 32 * ib + r32) * DM + h * 128;
#pragma unroll
            for (int g = 0; g < 4; ++g) {
                { const int e0 = 64 * ep + 8 * g + 4 * hi; const u32x2 gg = *(const u32x2*)(RG + grow + e0);
                  u32x2 w; w[0] = cvtpk((o0[4 * g] - mean) * rstd * bflo(gg[0]), (o0[4 * g + 1] - mean) * rstd * bfhi(gg[0])); w[1] = cvtpk((o0[4 * g + 2] - mean) * rstd * bflo(gg[1]), (o0[4 * g + 3] - mean) * rstd * bfhi(gg[1]));
                  *(u32x2*)(MIXED + orow + e0) = w; }
                { const int e0 = 64 * ep + 32 + 8 * g + 4 * hi; const u32x2 gg = *(const u32x2*)(RG + grow + e0);
                  u32x2 w; w[0] = cvtpk((o1[4 * g] - mean) * rstd * bflo(gg[0]), (o1[4 * g + 1] - mean) * rstd * bfhi(gg[0])); w[1] = cvtpk((o1[4 * g + 2] - mean) * rstd * bflo(gg[1]), (o1[4 * g + 3] - mean) * rstd * bfhi(gg[1]));
                  *(u32x2*)(MIXED + orow + e0) = w; }
            }
        }
#pragma unroll
        for (int g = 0; g < 4; ++g) {
            *(RLAS u32x2*)(w3 + TS + off_b(64 * ep + r32, 4 * ib + g) + 8 * hi) = (u32x2){cvtpk(st0[4 * g], st0[4 * g + 1]), cvtpk(st0[4 * g + 2], st0[4 * g + 3])};
            *(RLAS u32x2*)(w3 + TS + off_b(64 * ep + 32 + r32, 4 * ib + g) + 8 * hi) = (u32x2){cvtpk(st1[4 * g], st1[4 * g + 1]), cvtpk(st1[4 * g + 2], st1[4 * g + 3])};
        }
    }
    __syncthreads();
}
#undef RLAS
#undef RMFMA
}

constexpr int NWAVES = 8;
constexpr int RING_OFF = 0, RING_BYTES = 131072;
constexpr int LDSCTL_OFF = RING_BYTES, MISC_OFF = LDSCTL_OFF + 320;
constexpr int LDS_BYTES = 147456;
constexpr int CW_BAR = 4096;
#define GAS __attribute__((address_space(1)))
#define LAS __attribute__((address_space(3)))
typedef unsigned short bf16;
typedef unsigned v4u __attribute__((ext_vector_type(4)));
typedef float f32x4 __attribute__((ext_vector_type(4)));
typedef short bf16x8 __attribute__((ext_vector_type(8)));
typedef GAS unsigned gu32;
typedef GAS unsigned long long gu64;
#define RLX_AGENT __ATOMIC_RELAXED, __HIP_MEMORY_SCOPE_AGENT
#define LDS_WAIT() asm volatile("s_waitcnt lgkmcnt(0)" ::: "memory")
#define VM_WAIT() asm volatile("s_waitcnt vmcnt(0)" ::: "memory")
__device__ __forceinline__ unsigned long long rt() { return __builtin_amdgcn_s_memrealtime(); }
__device__ __forceinline__ unsigned pk2(float lo, float hi) { return f2bf(lo) | (f2bf(hi) << 16); }

#define XB_TMO      128
#define XB_XCNT(j)  (256  + 64 * (j))
#define XB_XSUB(j)  (1280 + 64 * (j))
#define XB_XGEN(j)  (2304 + 64 * (j))
#define XB_TOP      3328
#define XB_TOPGEN   3392
#define XCD_BAR_WORDS 3456
#define XB_SPIN_CAP (1u << 18)

__device__ __forceinline__ unsigned xb_ld(unsigned* p)              { return __hip_atomic_load(p, __ATOMIC_RELAXED, __HIP_MEMORY_SCOPE_AGENT); }
__device__ __forceinline__ unsigned xb_add(unsigned* p, unsigned v) { return __hip_atomic_fetch_add(p, v, __ATOMIC_RELAXED, __HIP_MEMORY_SCOPE_AGENT); }
__device__ __forceinline__ unsigned xb_xcc_id() { return (unsigned)__builtin_amdgcn_s_getreg((3 << 11) | 20) & 0xFu; }
#define XB_SPIN(cond, bar) do { unsigned _sp = 0; while (cond) { __builtin_amdgcn_s_sleep(1); \
    if ((++_sp & 255u) == 0u) { if (xb_ld(&(bar)[XB_TMO])) break; if (_sp > XB_SPIN_CAP) { atomicAdd(&(bar)[XB_TMO], 1u); break; } } } } while (0)

struct XcdBarrier {
    unsigned* bar; unsigned x;
    volatile LAS unsigned* st;
};

__device__ __forceinline__ XcdBarrier xcd_barrier_post(unsigned* bar, volatile LAS unsigned* st) {
    XcdBarrier b; b.bar = bar; b.x = xb_xcc_id(); b.st = st;
    if (threadIdx.x == 0) (void)xb_add(&bar[XB_XCNT(b.x)], 1u);
    return b;
}
__device__ __forceinline__ void xcd_barrier_complete(unsigned* bar, unsigned x, unsigned& nloc, unsigned& nx) {
    const unsigned G = gridDim.x * gridDim.y * gridDim.z;
    unsigned sum, cnt, mine, sp = 0u;
    for (;;) {
        sum = 0u; cnt = 0u; mine = 0u;
#pragma unroll
        for (unsigned j = 0; j < 16; ++j) { const unsigned c = xb_ld(&bar[XB_XCNT(j)]); sum += c; cnt += (c > 0u) ? 1u : 0u; mine = (j == x) ? c : mine; }
        if (sum == G) break;
        __builtin_amdgcn_s_sleep(1);
        if ((++sp & 255u) == 0u) { if (xb_ld(&bar[XB_TMO])) break; if (sp > XB_SPIN_CAP) { atomicAdd(&bar[XB_TMO], 1u); break; } }
    }
    nloc = mine > 0u ? mine : 1u; nx = cnt > 0u ? cnt : 1u;
}

__device__ __forceinline__ void xcd_barrier(const XcdBarrier& b) {
    asm volatile("s_waitcnt vmcnt(0)" ::: "memory");
    __syncthreads();
    if (threadIdx.x == 0) {
        unsigned* bar = b.bar;
        __builtin_amdgcn_s_waitcnt(0);
        unsigned nloc = b.st[0], nx = b.st[1];
        if (nloc == 0u) { xcd_barrier_complete(bar, b.x, nloc, nx); b.st[0] = nloc; b.st[1] = nx; }
        const unsigned old = xb_add(&bar[XB_XSUB(b.x)], 1u);
        const unsigned gen = old / nloc;
        if (old + 1u == (gen + 1u) * nloc) {
            __builtin_amdgcn_fence(__ATOMIC_RELEASE, "agent");
            asm volatile("s_waitcnt vmcnt(0)" ::: "memory");
            const unsigned og = xb_add(&bar[XB_TOP], 1u);
            const unsigned tg = og / nx;
            if (og + 1u == (tg + 1u) * nx) xb_add(&bar[XB_TOPGEN], 1u);
            else XB_SPIN(xb_ld(&bar[XB_TOPGEN]) == tg, bar);
            __builtin_amdgcn_fence(__ATOMIC_ACQUIRE, "agent");
            xb_add(&bar[XB_XGEN(b.x)], 1u);
            asm volatile("s_waitcnt vmcnt(0)" ::: "memory");
        } else {
            XB_SPIN(xb_ld(&bar[XB_XGEN(b.x)]) == gen, bar);
            __builtin_amdgcn_fence(__ATOMIC_ACQUIRE, "agent");
            asm volatile("s_waitcnt vmcnt(0)" ::: "memory");
        }
    }
    __syncthreads();
}

template <class SrcF>
__device__ __forceinline__ void transpose_item(const SrcF& src, int K, bf16* WT, LAS float* scr, int kb, int nb, int lane) {
    const int k0 = 64 * kb, n0 = 32 * nb;
#pragma unroll 8
    for (int i = 0; i < 32; ++i) { const int kk = 2 * i + (lane >> 5); scr[kk * 33 + (lane & 31)] = src(k0 + kk, n0 + (lane & 31)); }
    LDS_WAIT(); asm volatile("" ::: "memory");
    const int c = lane & 7;
#pragma unroll
    for (int j = 0; j < 4; ++j) { const int n = (lane >> 3) + 8 * j; const LAS float* s = scr + (8 * c) * 33 + n;
        v4u o; o.x = pk2(s[0 * 33], s[1 * 33]); o.y = pk2(s[2 * 33], s[3 * 33]); o.z = pk2(s[4 * 33], s[5 * 33]); o.w = pk2(s[6 * 33], s[7 * 33]);
        *(GAS v4u*)(WT + (size_t)(n0 + n) * K + k0 + 8 * c) = o; }
    LDS_WAIT(); asm volatile("" ::: "memory");
}
struct SrcWin { const float* w; __device__ __forceinline__ float operator()(int k, int n) const { int col = n; if (n < 1024) { const int cp = n & 127; col = (n & ~127) + (cp & 1) * 64 + (cp >> 1); } return w[(size_t)k * INC + col]; } };
struct SrcPlain { const float* w; int ld; __device__ __forceinline__ float operator()(int k, int n) const { return w[(size_t)k * ld + n]; } };
struct SrcGU { const float* wg; const float* wu; __device__ __forceinline__ float operator()(int k, int n) const { const long long d = (long long)(wu - wg); return wg[(long long)(n & 1) * d + (long long)k * EFF + (n >> 1)]; } };

struct Args {
    const float* in[19]; float* out; unsigned char* ws; int ph_lo, ph_hi;
};

__device__ __forceinline__ void ln0_row(const float* src, const float* g, const float* bta, const LAS float* wf, const float* b_forget, bf16* xn_row, float* logf_row, int lane) {
    float4 v[4]; float s = 0.f;
#pragma unroll
    for (int j = 0; j < 4; ++j) { v[j] = ((const float4*)src)[lane + 64 * j]; s += (v[j].x + v[j].y) + (v[j].z + v[j].w); }
    const float mean = wave_sum(s) * (1.f / DM);
    float s2 = 0.f;
#pragma unroll
    for (int j = 0; j < 4; ++j) { v[j].x -= mean; v[j].y -= mean; v[j].z -= mean; v[j].w -= mean; s2 += (v[j].x * v[j].x + v[j].y * v[j].y) + (v[j].z * v[j].z + v[j].w * v[j].w); }
    const float rstd = 1.f / sqrtf(wave_sum(s2) * (1.f / DM) + LN_EPS);
    float f[8];
#pragma unroll
    for (int h = 0; h < 8; ++h) f[h] = 0.f;
#pragma unroll
    for (int j = 0; j < 4; ++j) {
        const float4 gg = ((const float4*)g)[lane + 64 * j], bb = ((const float4*)bta)[lane + 64 * j];
        const float y0 = v[j].x * rstd * gg.x + bb.x, y1 = v[j].y * rstd * gg.y + bb.y, y2 = v[j].z * rstd * gg.z + bb.z, y3 = v[j].w * rstd * gg.w + bb.w;
        uint2 o; o.x = pk2(y0, y1); o.y = pk2(y2, y3);
        ((uint2*)xn_row)[lane + 64 * j] = o;
        const LAS float* wp = wf + 32 * (lane + 64 * j);
#pragma unroll
        for (int h = 0; h < 8; ++h) f[h] += y0 * wp[h] + y1 * wp[8 + h] + y2 * wp[16 + h] + y3 * wp[24 + h];
    }
    float z = 0.f;
#pragma unroll
    for (int h = 0; h < 8; ++h) { const float t = wave_sum(f[h]); if (lane == h) z = t; }
    if (lane < 8) { z += b_forget[lane]; logf_row[lane] = fminf(z, 0.f) - log1pf(expf(-fabsf(z))); }
}

__device__ __forceinline__ void metaproj_item(const Args& a, LAS unsigned char* lds, int g, int tid, int lane, int wave) {
    LAS float* xm = (LAS float*)lds;
    LAS float* T = (LAS float*)(lds + 65536);
    const float* meta = a.in[1]; const float* g0 = a.in[2]; const float* b0 = a.in[3]; const float* w_in = a.in[4];
#pragma unroll
    for (int rr = 0; rr < 2; ++rr) {
        const int m = wave * 2 + rr; const float* src = meta + (size_t)m * DM;
        float4 v[4]; float s = 0.f;
#pragma unroll
        for (int j = 0; j < 4; ++j) { v[j] = ((const float4*)src)[lane + 64 * j]; s += (v[j].x + v[j].y) + (v[j].z + v[j].w); }
        const float mean = wave_sum(s) * (1.f / DM);
        float s2 = 0.f;
#pragma unroll
        for (int j = 0; j < 4; ++j) { v[j].x -= mean; v[j].y -= mean; v[j].z -= mean; v[j].w -= mean; s2 += (v[j].x * v[j].x + v[j].y * v[j].y) + (v[j].z * v[j].z + v[j].w * v[j].w); }
        const float rstd = 1.f / sqrtf(wave_sum(s2) * (1.f / DM) + LN_EPS);
#pragma unroll
        for (int j = 0; j < 4; ++j) {
            const float4 gg = ((const float4*)g0)[lane + 64 * j], bb = ((const float4*)b0)[lane + 64 * j]; const int k0 = 4 * (lane + 64 * j);
            xm[(k0 + 0) * 16 + m] = __uint_as_float(f2bf(v[j].x * rstd * gg.x + bb.x) << 16); xm[(k0 + 1) * 16 + m] = __uint_as_float(f2bf(v[j].y * rstd * gg.y + bb.y) << 16);
            xm[(k0 + 2) * 16 + m] = __uint_as_float(f2bf(v[j].z * rstd * gg.z + bb.z) << 16); xm[(k0 + 3) * 16 + m] = __uint_as_float(f2bf(v[j].w * rstd * gg.w + bb.w) << 16);
        }
    }
    __syncthreads();
    float acc[16];
#pragma unroll
    for (int m = 0; m < 16; ++m) acc[m] = 0.f;
    const float* wc = w_in + g * 512 + tid;
#pragma unroll 4
    for (int k = 0; k < DM; ++k) {
        const float w = wc[(size_t)k * INC];
        const f32x4 x0 = *(const LAS f32x4*)(xm + k * 16), x1 = *(const LAS f32x4*)(xm + k * 16 + 4), x2 = *(const LAS f32x4*)(xm + k * 16 + 8), x3 = *(const LAS f32x4*)(xm + k * 16 + 12);
        acc[0] += w * x0[0]; acc[1] += w * x0[1]; acc[2] += w * x0[2]; acc[3] += w * x0[3]; acc[4] += w * x1[0]; acc[5] += w * x1[1]; acc[6] += w * x1[2]; acc[7] += w * x1[3];
        acc[8] += w * x2[0]; acc[9] += w * x2[1]; acc[10] += w * x2[2]; acc[11] += w * x2[3]; acc[12] += w * x3[0]; acc[13] += w * x3[1]; acc[14] += w * x3[2]; acc[15] += w * x3[3];
    }
#pragma unroll
    for (int m = 0; m < 16; ++m) T[m * 512 + tid] = acc[m];
    __syncthreads();
    bf16* base = (bf16*)(a.ws + WS_RQ) + (size_t)g * BUFE;
    if (g < 2) {
        if (tid < 256) {
            const int head = tid >> 6, j = tid & 63;
            const double rr = exp2(-(double)j * (13.287712379549449 / 64.0)) * 0.15915494309189535;
            const float sc = (g == 1) ? RK_SCALE : 1.f;
            for (int m = 0; m < 16; ++m) {
                double rv = (double)m * rr; rv -= floor(rv); const float fr = (float)rv, sn = __builtin_amdgcn_sinf(fr), cs = __builtin_amdgcn_cosf(fr);
                const float x1 = T[m * 512 + head * 128 + j], x2 = T[m * 512 + head * 128 + 64 + j];
                const unsigned o = pk2((x1 * cs - x2 * sn) * sc, (x2 * cs + x1 * sn) * sc);
                for (int b = 0; b < NB; ++b) *(unsigned*)(base + ((size_t)b * LT + RMETA0 + m) * 512 + head * 128 + 2 * j) = o;
            }
        }
    } else {
        const int pos0 = (g < 4) ? RMETA0 : FMETA0;
        for (int m = 0; m < 16; ++m) {
            float v = T[m * 512 + tid];
            if (g == 3) v = v / (1.f + __expf(-v)); else if (g == 4) v *= C2;
            const bf16 o = (bf16)f2bf(v);
            for (int b = 0; b < NB; ++b) base[((size_t)b * LT + pos0 + m) * 512 + tid] = o;
        }
    }
    __syncthreads();
}

__device__ __forceinline__ void bias_scan(const float* LOGF, float* BIAS, int bh, int lane) {
    const int b = bh >> 3, h = bh & 7;
    float* out = BIAS + (size_t)bh * LT;
    for (int p = lane; p < XPOS0; p += 64) if (p < FMETA0 || p >= FMETA0 + NMETA) out[p] = -1e30f;
    float carry = 0.f;
    for (int t0 = 0; t0 < NMETA + SEQ; t0 += 64) {
        const int t = t0 + lane; float v = 0.f;
        if (t < NMETA + SEQ) { const int row = t < NMETA ? NX + t : b * SEQ + t - NMETA; v = LOGF[(size_t)row * 8 + h]; }
#pragma unroll
        for (int o = 1; o < 64; o <<= 1) { const float u = __shfl_up(v, o); if (lane >= o) v += u; }
        v += carry;
        if (t < NMETA + SEQ) { const int pos = t < NMETA ? FMETA0 + t : XPOS0 + t - NMETA; out[pos] = -v * LOG2E; }
        carry = __shfl(v, 63);
    }
}
__device__ __forceinline__ void ln_row_f32_to_bf16(const float* src, const float* g, const float* bta, bf16* dst, int lane) {
    float4 v[4]; float s = 0.f;
#pragma unroll
    for (int j = 0; j < 4; ++j) { v[j] = ((const float4*)src)[lane + 64 * j]; s += (v[j].x + v[j].y) + (v[j].z + v[j].w); }
    const float mean = wave_sum(s) * (1.f / DM);
    float s2 = 0.f;
#pragma unroll
    for (int j = 0; j < 4; ++j) { v[j].x -= mean; v[j].y -= mean; v[j].z -= mean; v[j].w -= mean; s2 += (v[j].x * v[j].x + v[j].y * v[j].y) + (v[j].z * v[j].z + v[j].w * v[j].w); }
    const float rstd = 1.f / sqrtf(wave_sum(s2) * (1.f / DM) + LN_EPS);
#pragma unroll
    for (int j = 0; j < 4; ++j) {
        const float4 gg = ((const float4*)g)[lane + 64 * j], bb = ((const float4*)bta)[lane + 64 * j];
        uint2 o; o.x = pk2(v[j].x * rstd * gg.x + bb.x, v[j].y * rstd * gg.y + bb.y); o.y = pk2(v[j].z * rstd * gg.z + bb.z, v[j].w * rstd * gg.w + bb.w);
        ((uint2*)dst)[lane + 64 * j] = o;
    }
}
__device__ __forceinline__ void unpack8f(const uint4 u, float* d) {
    d[0] = __uint_as_float(u.x << 16); d[1] = __uint_as_float(u.x & 0xffff0000u); d[2] = __uint_as_float(u.y << 16); d[3] = __uint_as_float(u.y & 0xffff0000u);
    d[4] = __uint_as_float(u.z << 16); d[5] = __uint_as_float(u.z & 0xffff0000u); d[6] = __uint_as_float(u.w << 16); d[7] = __uint_as_float(u.w & 0xffff0000u);
}
__device__ __forceinline__ void final_row(const bf16* BASE, const bf16* Y, const int* ASG, const LAS int* ys, const float* g, const float* bta, float* out, int tok, int lane) {
    float v[16];
    { const bf16* src = BASE + (size_t)tok * DM;
#pragma unroll
      for (int j = 0; j < 2; ++j) unpack8f(((const uint4*)src)[lane + 64 * j], v + 8 * j); }
#pragma unroll
    for (int r = 0; r < 6; ++r) {
        const int a = ASG[(size_t)tok * 6 + r]; const int e = a >> 16, rank = a & 0xffff;
        const bf16* src = Y + (size_t)(ys[e] + rank) * DM; float t[8];
#pragma unroll
        for (int j = 0; j < 2; ++j) { unpack8f(((const uint4*)src)[lane + 64 * j], t);
#pragma unroll
            for (int q = 0; q < 8; ++q) v[8 * j + q] += t[q]; }
    }
    float s = 0.f;
#pragma unroll
    for (int q = 0; q < 16; ++q) s += v[q];
    const float mean = wave_sum(s) * (1.f / DM);
    float s2 = 0.f;
#pragma unroll
    for (int q = 0; q < 16; ++q) { v[q] -= mean; s2 += v[q] * v[q]; }
    const float rstd = 1.f / sqrtf(wave_sum(s2) * (1.f / DM) + LN_EPS);
#pragma unroll
    for (int j = 0; j < 2; ++j) {
        const int c0 = (lane + 64 * j) * 8;
        const float4 g0 = *(const float4*)(g + c0), g1 = *(const float4*)(g + c0 + 4), b0 = *(const float4*)(bta + c0), b1 = *(const float4*)(bta + c0 + 4);
        float4 o0, o1;
        o0.x = v[8 * j + 0] * rstd * g0.x + b0.x; o0.y = v[8 * j + 1] * rstd * g0.y + b0.y; o0.z = v[8 * j + 2] * rstd * g0.z + b0.z; o0.w = v[8 * j + 3] * rstd * g0.w + b0.w;
        o1.x = v[8 * j + 4] * rstd * g1.x + b1.x; o1.y = v[8 * j + 5] * rstd * g1.y + b1.y; o1.z = v[8 * j + 6] * rstd * g1.z + b1.z; o1.w = v[8 * j + 7] * rstd * g1.w + b1.w;
        *(float4*)(out + (size_t)tok * DM + c0) = o0; *(float4*)(out + (size_t)tok * DM + c0 + 4) = o1;
    }
}
__global__ void __launch_bounds__(NWAVES * 64, 2) mega(Args args) {
    extern __shared__ __attribute__((aligned(16))) unsigned char lds_raw[];
    LAS unsigned char* lds = (LAS unsigned char*)lds_raw;
    volatile LAS unsigned* MISC = (volatile LAS unsigned*)(lds + MISC_OFF);
    const int tid = threadIdx.x, lane = tid & 63, wave = __builtin_amdgcn_readfirstlane(tid >> 6);
    const int G = gridDim.x; const int bx = blockIdx.x; const int vcu = (G % 8 == 0) ? (bx % 8) * (G / 8) + bx / 8 : bx;
    unsigned char* ws = args.ws;
    gu32* ctl = (gu32*)(ws + WS_CTL);
    for (int u = tid; u < (LDS_BYTES - LDSCTL_OFF) / 4; u += NWAVES * 64) ((LAS unsigned*)(lds + LDSCTL_OFF))[u] = 0u;
    __syncthreads();
    XcdBarrier bar = xcd_barrier_post((unsigned*)(ctl + CW_BAR), MISC + 8);
    const int lo = args.ph_lo, hi = args.ph_hi;
#define IN(k) (lo <= (k) && (k) < hi)
#define BOTH(k) (IN(k) && IN((k) + 1))
    bf16* XN = (bf16*)(ws + WS_XN); float* LOGF = (float*)(ws + WS_LOGF); float* TAB = (float*)(ws + WS_TAB);
    bf16* WIN_T = (bf16*)(ws + WS_WIN_T); bf16* WOUT_T = (bf16*)(ws + WS_WOUT_T); bf16* WGU_T = (bf16*)(ws + WS_WGU_T); bf16* WSD_T = (bf16*)(ws + WS_WSD_T); bf16* WR_T = (bf16*)(ws + WS_WR_T); bf16* WD_T = (bf16*)(ws + WS_WD_T);

    if (IN(0)) {
        constexpr int NMP = 7;
        if (vcu < NMP && G > 2 * NMP) metaproj_item(args, lds, vcu, tid, lane, wave);
        else {
            const int nwg = (G > 2 * NMP) ? G - NMP : G, wg = (G > 2 * NMP) ? vcu - NMP : vcu;
            if (G <= 2 * NMP) { for (int g = vcu; g < 7; g += G) metaproj_item(args, lds, g, tid, lane, wave); }
            const int gw = wg * NWAVES + wave, NGW = nwg * NWAVES;
            LAS float* scr = (LAS float*)(lds + wave * 8704);
            LAS float* wf = (LAS float*)(lds + 98304);
            const float* w_in = args.in[4];
            for (int i = tid; i < 1024 * 8; i += NWAVES * 64) { const int k = i >> 3, h = i & 7; wf[i] = w_in[(size_t)k * INC + 3584 + h]; }
            __syncthreads();
            if (gw == 0) { const double rr = exp2(-(double)lane * (13.287712379549449 / 64.0)) * 0.15915494309189535; const float h = (float)rr; TAB[2 * lane] = h; TAB[2 * lane + 1] = (float)(rr - (double)h); }
            for (int row = gw; row < NX + NMETA; row += NGW) {
                const float* src = row < NX ? args.in[0] + (size_t)row * DM : args.in[1] + (size_t)(row - NX) * DM;
                ln0_row(src, args.in[2], args.in[3], wf, args.in[5], XN + (size_t)row * DM, LOGF + (size_t)row * 8, lane);
            }
            constexpr int I0 = 16 * 112, I1 = 16 * 32, I2 = 16 * 2, I3 = 16 * 16, I4 = 4 * 32, I5 = 64 * 256, I6 = 64 * 128, ITOT = I0 + I1 + I2 + I3 + I4 + I5 + I6;
            for (int it = gw; it < ITOT; it += NGW) {
                int r = it;
                if (r < I0) { transpose_item(SrcWin{w_in}, DM, WIN_T, scr, r / 112, r % 112, lane); continue; } r -= I0;
                if (r < I1) { transpose_item(SrcPlain{args.in[6], DM}, DM, WOUT_T, scr, r / 32, r % 32, lane); continue; } r -= I1;
                if (r < I2) { transpose_item(SrcPlain{args.in[9], NEXP}, DM, WR_T, scr, r / 2, r % 2, lane); continue; } r -= I2;
                if (r < I3) { transpose_item(SrcGU{args.in[14], args.in[15]}, DM, WGU_T + (size_t)64 * 512 * DM, scr, r / 16, r % 16, lane); continue; } r -= I3;
                if (r < I4) { transpose_item(SrcPlain{args.in[16], DM}, EFF, WSD_T, scr, r / 32, r % 32, lane); continue; } r -= I4;
                if (r < I5) { const int e = r >> 8, q = r & 255; transpose_item(SrcGU{args.in[11] + (size_t)e * DM * EFF, args.in[12] + (size_t)e * DM * EFF}, DM, WGU_T + (size_t)e * 512 * DM, scr, q / 16, q % 16, lane); continue; } r -= I5;
                { const int e = r >> 7, q = r & 127; transpose_item(SrcPlain{args.in[13] + (size_t)e * EFF * DM, DM}, EFF, WD_T + (size_t)e * DM * EFF, scr, q / 32, q % 32, lane); }
            }
        }
        if (BOTH(0)) xcd_barrier(bar);
    }
    if (IN(1)) {
        if (vcu < 64 && wave == 0) bias_scan(LOGF, (float*)(ws + WS_BIAS), vcu, lane);
        pg8::Gemm g{(const pg8::bf16_t*)XN, (const pg8::bf16_t*)WIN_T, NX, 3584, DM}; pg8::StaticOrder S; S.init(NX, 3584, G, (int)blockIdx.x);
        pg8::EpiInproj E{(pg8::bf16_t*)(ws + WS_RQ), TAB};
        pg8::gemm_phase<pg8::EpiInproj, pg8::StaticOrder, true, true>(lds + RING_OFF, g, S, E);
        if (BOTH(1)) xcd_barrier(bar);
    }
    if (IN(2)) {
        static_assert(attn_body::ATTN_LDS_BYTES <= RING_BYTES, "attention LDS");
        const int qid = bx & 7;
        for (int dq = 0; dq < 8; ++dq) {
            const int q = (qid + dq) & 7;
            for (;;) {
                if (tid == 0) MISC[0] = __hip_atomic_fetch_add(ctl + CW_Q2 + 64 * q, 1u, RLX_AGENT);
                __syncthreads();
                const int it = (int)MISC[0];
                __syncthreads();
                if (it >= 132) break;
                int tid_o = tid; asm volatile("" : "+v"(tid_o));
                if (it < 4) { const int bh = q * 4 + it; ret_body::ret_unit(bh >> 2, bh & 3, ws, (char*)lds_raw + RING_OFF, tid_o); }
                else { const int a = it - 4, qb = 15 - (a >> 3), bh = 8 * q + (a & 7);
                    attn_body::attn_unit<8>(bh >> 3, bh & 7, qb, ws, (char*)lds_raw + RING_OFF, tid_o); }
            }
        }
        if (BOTH(2)) xcd_barrier(bar);
    }
    if (IN(3)) {
        pg8::Gemm g{(const pg8::bf16_t*)(ws + WS_MIXED), (const pg8::bf16_t*)WOUT_T, NX, DM, DM}; pg8::StaticOrder S; S.init(NX, DM, G, (int)blockIdx.x);
        pg8::EpiOutproj E{args.out, (const pg8::bf16_t*)XN};
        pg8::gemm_phase<pg8::EpiOutproj, pg8::StaticOrder, true, true>(lds + RING_OFF, g, S, E);
        if (BOTH(3)) xcd_barrier(bar);
    }
    if (IN(4)) {
        const int gw = vcu * NWAVES + wave, NGW = G * NWAVES;
        for (int row = gw; row < NX; row += NGW) ln_row_f32_to_bf16(args.out + (size_t)row * DM, args.in[7], args.in[8], XN + (size_t)row * DM, lane);
        if (BOTH(4)) xcd_barrier(bar);
    }
    int* cnt = (int*)(ws + WS_CTL) + CW_CNT; int* TOKL = (int*)(ws + WS_TOKL); float* GATEL = (float*)(ws + WS_GATEL); int* ASG = (int*)(ws + WS_ASG);
    bf16* HID = (bf16*)args.out;
    if (IN(5)) {
        for (int pm = vcu; pm < 128; pm += G) {
            pg8::Gemm g{(const pg8::bf16_t*)XN, (const pg8::bf16_t*)WR_T, NX, 256, DM}; pg8::SingleUnit S{pm, 0, 1};
            pg8::EpiRouter E{args.in[10], cnt, TOKL, GATEL, ASG};
            pg8::gemm_phase<pg8::EpiRouter, pg8::SingleUnit, false, true>(lds + RING_OFF, g, S, E);
        }
        { pg8::Gemm g{(const pg8::bf16_t*)XN, (const pg8::bf16_t*)(WGU_T + (size_t)64 * 512 * DM), NX, 512, DM}; pg8::StaticOrder S; S.init(NX, 512, G, (int)blockIdx.x);
          pg8::EpiGU<false> E{(pg8::bf16_t*)(HID + (size_t)HID_S_ROW0 * EFF), nullptr};
          pg8::gemm_phase<pg8::EpiGU<false>, pg8::StaticOrder, true, true>(lds + RING_OFF, g, S, E); }
        if (BOTH(5)) xcd_barrier(bar);
    }
    LAS int* tabs = (LAS int*)(lds + LDSCTL_OFF + 4096);
    LAS int* ulist = (LAS int*)(lds + LDSCTL_OFF + 8192);
#define BUILD_UNITS(NPN, nunits_out) do { \
        __syncthreads(); \
        if (tid < 64) tabs[3 * 65 + tid] = cnt[tid]; \
        __syncthreads(); \
        if (tid == 0) { int us = 0, hs = 0, ys = 0; for (int e = 0; e < 64; ++e) { const int c = tabs[3 * 65 + e], nt = (c + 255) >> 8; tabs[e] = us; tabs[65 + e] = hs; tabs[130 + e] = ys; us += nt * (NPN); hs += nt << 8; ys += c; } tabs[64] = us; tabs[129] = hs; tabs[194] = ys; } \
        __syncthreads(); \
        if (tid < 32) { const int Lu = tid * G + vcu; int e = -1; if (Lu < tabs[64]) { int lo_ = 0, hi_ = 63; while (lo_ < hi_) { const int mid = (lo_ + hi_ + 1) >> 1; if (tabs[mid] <= Lu) lo_ = mid; else hi_ = mid - 1; } e = lo_; } \
            LAS int* q_ = ulist + 6 * tid; if (e >= 0) { const int loc = Lu - tabs[e], rt = loc / (NPN), pn = loc % (NPN); q_[0] = e; q_[1] = rt; q_[2] = pn; q_[3] = tabs[65 + e] + (rt << 8); q_[4] = tabs[130 + e] + (rt << 8); q_[5] = tabs[3 * 65 + e] - (rt << 8); } else q_[0] = -1; } \
        __syncthreads(); \
        { const int tot_ = tabs[64]; nunits_out = (tot_ > vcu) ? (tot_ - vcu + G - 1) / G : 0; if (nunits_out > 32) nunits_out = 32; } \
    } while (0)
    if (IN(6)) {
        int nun; BUILD_UNITS(2, nun);
        pg8::Gemm g{(const pg8::bf16_t*)XN, (const pg8::bf16_t*)WGU_T, NX, 512, DM}; pg8::GroupOrder<true> S{(const LAS int*)ulist, nun, TOKL, 512};
        pg8::EpiGU<true> E{(pg8::bf16_t*)HID, (const LAS int*)ulist};
        pg8::gemm_phase<pg8::EpiGU<true>, pg8::GroupOrder<true>, true, true>(lds + RING_OFF, g, S, E);
        if (BOTH(6)) xcd_barrier(bar);
    }
    if (IN(7)) {
        int nun; BUILD_UNITS(4, nun);
        { pg8::Gemm g{(const pg8::bf16_t*)HID, (const pg8::bf16_t*)WD_T, NX, DM, EFF}; pg8::GroupOrder<false> S{(const LAS int*)ulist, nun, TOKL, DM};
          pg8::EpiY E{(pg8::bf16_t*)(ws + WS_Y), GATEL, (const LAS int*)ulist};
          pg8::gemm_phase<pg8::EpiY, pg8::GroupOrder<false>, true, true>(lds + RING_OFF, g, S, E); }
        { pg8::Gemm g{(const pg8::bf16_t*)(HID + (size_t)HID_S_ROW0 * EFF), (const pg8::bf16_t*)WSD_T, NX, DM, EFF}; pg8::StaticOrder S; S.init(NX, DM, G, (int)blockIdx.x);
          pg8::EpiBase E{(pg8::bf16_t*)XN};
          pg8::gemm_phase<pg8::EpiBase, pg8::StaticOrder, true, true>(lds + RING_OFF, g, S, E); }
        if (BOTH(7)) xcd_barrier(bar);
    }
    if (IN(8)) {
        __syncthreads();
        if (tid == 0) { int a = 0; for (int e = 0; e < 64; ++e) { tabs[e] = a; a += cnt[e]; } }
        __syncthreads();
        const int gw = vcu * NWAVES + wave, NGW = G * NWAVES;
        for (int tok = gw; tok < NX; tok += NGW) final_row(XN, (const bf16*)(ws + WS_Y), ASG, (const LAS int*)tabs, args.in[17], args.in[18], args.out, tok, lane);
    }
#undef BUILD_UNITS
#undef IN
#undef BOTH
}

extern "C" void kernel_launch(void* const* d_in, const int* in_sizes, int n_in, void* d_out, int out_size, void* d_ws, size_t ws_size, hipStream_t stream) {
    if (n_in != 19 || ws_size < WS_END || out_size != NX * DM) { fprintf(stderr, "kernel_launch: unexpected sizes n_in=%d ws=%zu out=%d\n", n_in, ws_size, out_size); return; }
    static int grid = 0;
    if (grid == 0) {
        int dev = 0, cus = 0, per_cu = 0;
        if (hipGetDevice(&dev) != hipSuccess || hipDeviceGetAttribute(&cus, hipDeviceAttributeMultiprocessorCount, dev) != hipSuccess) { fprintf(stderr, "kernel_launch: device query failed\n"); grid = -1; return; }
        if (hipFuncSetAttribute((const void*)mega, hipFuncAttributeMaxDynamicSharedMemorySize, LDS_BYTES) != hipSuccess) { fprintf(stderr, "kernel_launch: hipFuncSetAttribute failed\n"); grid = -1; return; }
        if (hipOccupancyMaxActiveBlocksPerMultiprocessor(&per_cu, (const void*)mega, NWAVES * 64, LDS_BYTES) != hipSuccess || per_cu < 1) { fprintf(stderr, "kernel_launch: occupancy query says %d blocks per CU\n", per_cu); grid = -1; return; }
        (void)hipGetLastError();
        grid = cus;
    }
    if (grid < 0) return;
    const float* x = (const float*)d_in[0];
    const float* w_out = (const float*)d_in[6];
    const float* ln1_g = (const float*)d_in[7]; const float* ln1_b = (const float*)d_in[8]; const float* w_router = (const float*)d_in[9]; const float* router_bias = (const float*)d_in[10];
    const float* we_gate = (const float*)d_in[11]; const float* we_up = (const float*)d_in[12]; const float* we_down = (const float*)d_in[13];
    const float* ws_gate = (const float*)d_in[14]; const float* ws_up = (const float*)d_in[15]; const float* ws_down = (const float*)d_in[16];
    const float* ln2_g = (const float*)d_in[17]; const float* ln2_b = (const float*)d_in[18];
    (void)x;
    unsigned char* ws = (unsigned char*)d_ws; float* out = (float*)d_out;
    int* cnt = (int*)(ws + WS_CTL) + CW_CNT;
    float* LOGF = (float*)(ws + WS_LOGF); float* BIAS = (float*)(ws + WS_BIAS); int* ASG = (int*)(ws + WS_ASG); int* TOKL = (int*)(ws + WS_TOKL); float* GATEL = (float*)(ws + WS_GATEL);
    float* LOGITS = (float*)(ws + WS_LOGITS); bf16_t* XN = (bf16_t*)(ws + WS_XN); bf16_t* H1 = XN;
    bf16_t* RQ = (bf16_t*)(ws + WS_RQ); bf16_t* RK = RQ + BUFE; bf16_t* RV = RQ + 2 * BUFE; bf16_t* RG = RQ + 3 * BUFE; bf16_t* FQ = RQ + 4 * BUFE; bf16_t* FK = RQ + 5 * BUFE; bf16_t* FV = RQ + 6 * BUFE;
    bf16_t* MIXED = (bf16_t*)(ws + WS_MIXED); bf16_t* Y = (bf16_t*)(ws + WS_Y);
    float* yb = out;
    bf16_t* HID = (bf16_t*)d_out;

    (void)hipMemsetAsync(ws + WS_CTL, 0, 1 * MiB, stream);
    Args a{};
    for (int i = 0; i < 19; ++i) a.in[i] = (const float*)d_in[i];
    a.out = out; a.ws = ws; a.ph_lo = 0; a.ph_hi = 9;
    { void* kargs[] = {&a}; hipError_t e = hipLaunchCooperativeKernel((const void*)mega, dim3(grid), dim3(NWAVES * 64), kargs, LDS_BYTES, stream);
      if (e != hipSuccess) fprintf(stderr, "kernel_launch: cooperative launch failed: %s\n", hipGetErrorString(e)); }
}
```

```cpp
#include <hip/hip_runtime.h>
#include <stdint.h>
#include <cstdio>

typedef unsigned short bf16_t;

constexpr int NB = 8, SEQ = 4096, DM = 1024, NMETA = 16, NX = NB * SEQ;
constexpr int LT = 4352;
constexpr int XPOS0 = 256;
constexpr int RMETA0 = 240;
constexpr int FMETA0 = 128;
constexpr int INC = 3592, NEXP = 64, TOPK = 6, EFF = 256;
constexpr int CAP = 32768;
constexpr float LN_EPS = 1e-5f;
constexpr float ALPHA = 1.189207115002721f;
constexpr float LOG2E = 1.4426950408889634f;
constexpr float C2 = 0.125f * LOG2E;
constexpr float RK_SCALE = 0.08838834764831845f;
constexpr float ROUTED_SCALE = 2.5f;

constexpr size_t MiB = 1u << 20;
constexpr size_t WS_CTL = 0;
constexpr size_t WS_LOGF = 1 * MiB;
constexpr size_t WS_BIAS = 3 * MiB;
constexpr size_t WS_ASG = 5 * MiB;
constexpr size_t WS_TOKL = 6 * MiB;
constexpr size_t WS_GATEL = 14 * MiB;
constexpr size_t WS_LOGITS = 22 * MiB;
constexpr size_t WS_XN = 30 * MiB;
constexpr size_t WS_A = 96 * MiB;
constexpr size_t BUFE = (size_t)NB * LT * 512;
constexpr size_t WS_RQ = WS_A;
constexpr size_t WS_MIXED = WS_A + 7 * BUFE * 2;
constexpr size_t WS_Y = WS_A;
constexpr size_t WS_WIN_T = 398 * MiB;
constexpr size_t WS_WOUT_T = 405 * MiB;
constexpr size_t WS_WGU_T = 407 * MiB;
constexpr size_t WS_WSD_T = 94 * MiB + 512 * 1024;
constexpr size_t WS_WR_T = 95 * MiB;
constexpr size_t WS_TAB = 95 * MiB + 512 * 1024;
constexpr size_t WS_WD_T = 480 * MiB;
constexpr size_t WS_END = 512 * MiB;
constexpr size_t HID_S_ROW0 = 212992;
constexpr int CW_CNT = 1024;
constexpr int CW_Q2 = 2048;
constexpr int CW_QK2 = 3584;

__device__ __forceinline__ float bf2f(bf16_t v) { return __uint_as_float(((unsigned)v) << 16); }
__device__ __forceinline__ unsigned f2bf(float f) { unsigned u = __float_as_uint(f); return (u + 0x7fffu + ((u >> 16) & 1u)) >> 16; }
__device__ __forceinline__ float wave_sum(float v) {
#pragma unroll
    for (int o = 1; o < 64; o <<= 1) v += __shfl_xor(v, o);
    return v;
}

__global__ void __launch_bounds__(256) k_ln0(const float* __restrict__ x, const float* __restrict__ meta, const float* __restrict__ g, const float* __restrict__ bta,
                                            const float* __restrict__ w_in, const float* __restrict__ b_forget, bf16_t* XN, float* LOGF) {
    __shared__ float wf[1024 * 8];
    for (int i = threadIdx.x; i < 1024 * 8; i += 256) { int k = i >> 3, h = i & 7; wf[i] = w_in[(size_t)k * INC + 3584 + h]; }
    __syncthreads();
    const int lane = threadIdx.x & 63, wave = threadIdx.x >> 6;
    const int gw = blockIdx.x * 4 + wave, ngw = gridDim.x * 4;
    for (int row = gw; row < NX + NMETA; row += ngw) {
        const float* src = row < NX ? x + (size_t)row * DM : meta + (size_t)(row - NX) * DM;
        float4 v[4]; float s = 0.f;
#pragma unroll
        for (int j = 0; j < 4; ++j) { v[j] = ((const float4*)src)[lane + 64 * j]; s += (v[j].x + v[j].y) + (v[j].z + v[j].w); }
        const float mean = wave_sum(s) * (1.f / DM);
        float s2 = 0.f;
#pragma unroll
        for (int j = 0; j < 4; ++j) { v[j].x -= mean; v[j].y -= mean; v[j].z -= mean; v[j].w -= mean; s2 += (v[j].x * v[j].x + v[j].y * v[j].y) + (v[j].z * v[j].z + v[j].w * v[j].w); }
        const float rstd = 1.f / sqrtf(wave_sum(s2) * (1.f / DM) + LN_EPS);
        float f[8];
#pragma unroll
        for (int h = 0; h < 8; ++h) f[h] = 0.f;
#pragma unroll
        for (int j = 0; j < 4; ++j) {
            const float4 gg = ((const float4*)g)[lane + 64 * j], bb = ((const float4*)bta)[lane + 64 * j];
            float y0 = v[j].x * rstd * gg.x + bb.x, y1 = v[j].y * rstd * gg.y + bb.y, y2 = v[j].z * rstd * gg.z + bb.z, y3 = v[j].w * rstd * gg.w + bb.w;
            uint2 o; o.x = (unsigned)f2bf(y0) | ((unsigned)f2bf(y1) << 16); o.y = (unsigned)f2bf(y2) | ((unsigned)f2bf(y3) << 16);
            ((uint2*)(XN + (size_t)row * DM))[lane + 64 * j] = o;
            const int k0 = 4 * (lane + 64 * j);
#pragma unroll
            for (int h = 0; h < 8; ++h) f[h] += y0 * wf[(k0 + 0) * 8 + h] + y1 * wf[(k0 + 1) * 8 + h] + y2 * wf[(k0 + 2) * 8 + h] + y3 * wf[(k0 + 3) * 8 + h];
        }
        float z = 0.f;
#pragma unroll
        for (int h = 0; h < 8; ++h) { const float t = wave_sum(f[h]); if (lane == h) z = t; }
        if (lane < 8) { z += b_forget[lane]; LOGF[(size_t)row * 8 + lane] = fminf(z, 0.f) - log1pf(expf(-fabsf(z))); }
    }
}

__global__ void __launch_bounds__(64) k_bias(const float* __restrict__ LOGF, float* BIAS) {
    const int bh = blockIdx.x, b = bh >> 3, h = bh & 7, lane = threadIdx.x;
    float* out = BIAS + (size_t)bh * LT;
    for (int p = lane; p < XPOS0; p += 64) if (p < FMETA0 || p >= FMETA0 + NMETA) out[p] = -1e30f;
    float carry = 0.f;
    for (int t0 = 0; t0 < NMETA + SEQ; t0 += 64) {
        const int t = t0 + lane; float v = 0.f;
        if (t < NMETA + SEQ) { const int row = t < NMETA ? NX + t : b * SEQ + t - NMETA; v = LOGF[(size_t)row * 8 + h]; }
#pragma unroll
        for (int o = 1; o < 64; o <<= 1) { const float u = __shfl_up(v, o); if (lane >= o) v += u; }
        v += carry;
        if (t < NMETA + SEQ) { const int pos = t < NMETA ? FMETA0 + t : XPOS0 + t - NMETA; out[pos] = -v * LOG2E; }
        carry = __shfl(v, 63);
    }
}

template <class AF, class BF, class EF>
__global__ void __launch_bounds__(256) naive_gemm(int M, int N, int K, int padarg, AF af, BF bf, EF ef) {
    __shared__ float As[16][65];
    __shared__ float Bs[16][65];
    const int tx = threadIdx.x & 15, ty = threadIdx.x >> 4;
    const int m0 = blockIdx.y * 64, n0 = blockIdx.x * 64;
    float acc[4][4];
#pragma unroll
    for (int i = 0; i < 4; ++i)
#pragma unroll
        for (int j = 0; j < 4; ++j) acc[i][j] = 0.f;
    for (int k0 = 0; k0 < K; k0 += 16) {
        for (int i = threadIdx.x; i < 1024; i += 256) { const int m = i >> 4, k = i & 15; As[k][m] = (m0 + m < M) ? af(m0 + m, k0 + k) : 0.f; }
        for (int i = threadIdx.x; i < 1024; i += 256) { const int k = i >> 6, n = i & 63; Bs[k][n] = (n0 + n < N) ? bf(k0 + k, n0 + n) : 0.f; }
        __syncthreads();
#pragma unroll
        for (int k = 0; k < 16; ++k) {
            float a[4], b[4];
#pragma unroll
            for (int i = 0; i < 4; ++i) { a[i] = As[k][ty * 4 + i]; b[i] = Bs[k][tx * 4 + i]; }
#pragma unroll
            for (int i = 0; i < 4; ++i)
#pragma unroll
                for (int j = 0; j < 4; ++j) acc[i][j] += a[i] * b[j];
        }
        __syncthreads();
    }
#pragma unroll
    for (int i = 0; i < 4; ++i)
#pragma unroll
        for (int j = 0; j < 4; ++j) { const int m = m0 + ty * 4 + i, n = n0 + tx * 4 + j; if (m < M && n < N) ef(m, n, acc[i][j]); }
}
struct AF_bf16 { const bf16_t* p; int ld; int pad; __device__ float operator()(int m, int k) const { return bf2f(p[(size_t)m * ld + k]); } };
struct BF_f32 { const float* p; int ld; int pad; __device__ float operator()(int k, int n) const { return p[(size_t)k * ld + n]; } };
struct EF_inproj {
    bf16_t* bufs;
    __device__ void operator()(int row, int col, float v) const {
        const int g = col >> 9, cc = col & 511;
        if (g == 1) v *= RK_SCALE; else if (g == 3) v = v / (1.f + __expf(-v)); else if (g == 4) v *= C2;
        const bf16_t o = f2bf(v);
        bf16_t* base = bufs + (size_t)g * BUFE;
        if (row < NX) { const int b = row >> 12, i = row & 4095; base[((size_t)b * LT + XPOS0 + i) * 512 + cc] = o; }
        else { const int pos = (g < 4 ? RMETA0 : FMETA0) + (row - NX); for (int b = 0; b < NB; ++b) base[((size_t)b * LT + pos) * 512 + cc] = o; }
    }
};
struct EF_outproj { float* y; const bf16_t* XN; __device__ void operator()(int row, int col, float v) const { const size_t o = (size_t)row * DM + col; y[o] = v + ALPHA * bf2f(XN[o]); } };
struct EF_store { float* p; int ld; int pad; __device__ void operator()(int row, int col, float v) const { p[(size_t)row * ld + col] = v; } };

__global__ void __launch_bounds__(256) k_rotary(bf16_t* RQ, bf16_t* RK) {
    const size_t idx = (size_t)blockIdx.x * 256 + threadIdx.x;
    if (idx >= (size_t)NB * (NMETA + SEQ) * 256) return;
    const int j = (int)(idx & 63), h = (int)((idx >> 6) & 3); const size_t r = idx >> 8; const int t = (int)(r % (NMETA + SEQ)), b = (int)(r / (NMETA + SEQ));
    const int pos = RMETA0 + t;
    const double inv = exp2(-(double)j * (13.287712379549449 / 64.0));
    double rv = (double)t * inv * 0.15915494309189535; rv -= floor(rv);
    const float fr = (float)rv, s = __builtin_amdgcn_sinf(fr), c = __builtin_amdgcn_cosf(fr);
    bf16_t* p = RQ + ((size_t)b * LT + pos) * 512 + h * 128 + j;
    float x1 = bf2f(p[0]), x2 = bf2f(p[64]); p[0] = f2bf(x1 * c - x2 * s); p[64] = f2bf(x2 * c + x1 * s);
    p = RK + ((size_t)b * LT + pos) * 512 + h * 128 + j;
    x1 = bf2f(p[0]); x2 = bf2f(p[64]); p[0] = f2bf(x1 * c - x2 * s); p[64] = f2bf(x2 * c + x1 * s);
}

__device__ __forceinline__ void unpack8(const uint4 u, float* d) {
    d[0] = __uint_as_float(u.x << 16); d[1] = __uint_as_float(u.x & 0xffff0000u); d[2] = __uint_as_float(u.y << 16); d[3] = __uint_as_float(u.y & 0xffff0000u);
    d[4] = __uint_as_float(u.z << 16); d[5] = __uint_as_float(u.z & 0xffff0000u); d[6] = __uint_as_float(u.w << 16); d[7] = __uint_as_float(u.w & 0xffff0000u);
}

__global__ void __launch_bounds__(64) k_ret_naive(const bf16_t* __restrict__ RQ, const bf16_t* __restrict__ RK, const bf16_t* __restrict__ RV, const bf16_t* __restrict__ RG, bf16_t* MIXED) {
    __shared__ float Ks[64 * 128];
    __shared__ float Vs[64 * 128];
    const int blk = blockIdx.x, qt = blk & 63, h = (blk >> 6) & 3, b = blk >> 8, lane = threadIdx.x;
    const int i = qt * 64 + lane, qpos = XPOS0 + i;
    const float lg2g = log2f(1.f - exp2f(-5.f - (float)h));
    float q[128], o[128];
    const bf16_t* qp = RQ + ((size_t)b * LT + qpos) * 512 + h * 128;
#pragma unroll
    for (int d = 0; d < 128; d += 8) unpack8(*(const uint4*)(qp + d), q + d);
#pragma unroll
    for (int e = 0; e < 128; ++e) o[e] = 0.f;
    const int last_pos = XPOS0 + qt * 64 + 63;
    for (int kp0 = 192; kp0 <= last_pos; kp0 += 64) {
        __syncthreads();
        for (int c = lane; c < 1024; c += 64) {
            const int key = c >> 4, d8 = (c & 15) * 8; const size_t off = ((size_t)b * LT + kp0 + key) * 512 + h * 128 + d8;
            unpack8(*(const uint4*)(RK + off), Ks + key * 128 + d8); unpack8(*(const uint4*)(RV + off), Vs + key * 128 + d8);
        }
        __syncthreads();
        for (int s = 0; s < 64; ++s) {
            const int kpos = kp0 + s;
            if (kpos < RMETA0) continue;
            float sc = 0.f;
#pragma unroll
            for (int d = 0; d < 128; d += 4) { const float4 kk = *(const float4*)(Ks + s * 128 + d); sc += q[d] * kk.x + q[d + 1] * kk.y + q[d + 2] * kk.z + q[d + 3] * kk.w; }
            const float w = (kpos <= qpos) ? sc * exp2f((float)(qpos - kpos) * lg2g) : 0.f;
#pragma unroll
            for (int e = 0; e < 128; e += 4) { const float4 vv = *(const float4*)(Vs + s * 128 + e); o[e] += w * vv.x; o[e + 1] += w * vv.y; o[e + 2] += w * vv.z; o[e + 3] += w * vv.w; }
        }
    }
    float mean = 0.f;
#pragma unroll
    for (int e = 0; e < 128; ++e) mean += o[e];
    mean *= (1.f / 128.f);
    float var = 0.f;
#pragma unroll
    for (int e = 0; e < 128; ++e) { o[e] -= mean; var += o[e] * o[e]; }
    const float rstd = 1.f / sqrtf(var * (1.f / 128.f) + LN_EPS);
    const bf16_t* gp = RG + ((size_t)b * LT + qpos) * 512 + h * 128;
    bf16_t* op = MIXED + ((size_t)b * SEQ + i) * DM + h * 128;
#pragma unroll
    for (int e = 0; e < 128; e += 8) {
        float gg[8]; unpack8(*(const uint4*)(gp + e), gg);
        uint4 w;
        w.x = (unsigned)f2bf(o[e] * rstd * gg[0]) | ((unsigned)f2bf(o[e + 1] * rstd * gg[1]) << 16);
        w.y = (unsigned)f2bf(o[e + 2] * rstd * gg[2]) | ((unsigned)f2bf(o[e + 3] * rstd * gg[3]) << 16);
        w.z = (unsigned)f2bf(o[e + 4] * rstd * gg[4]) | ((unsigned)f2bf(o[e + 5] * rstd * gg[5]) << 16);
        w.w = (unsigned)f2bf(o[e + 6] * rstd * gg[6]) | ((unsigned)f2bf(o[e + 7] * rstd * gg[7]) << 16);
        *(uint4*)(op + e) = w;
    }
}

__global__ void __launch_bounds__(64) k_fox_naive(const bf16_t* __restrict__ FQ, const bf16_t* __restrict__ FK, const bf16_t* __restrict__ FV, const float* __restrict__ BIAS, bf16_t* MIXED) {
    __shared__ float Ks[64 * 64];
    __shared__ float Vs[64 * 64];
    __shared__ float Bsh[64];
    const int blk = blockIdx.x, qt = blk & 63, h = (blk >> 6) & 7, b = blk >> 9, lane = threadIdx.x;
    const int i = qt * 64 + lane, qpos = XPOS0 + i;
    float q[64], o[64];
    const bf16_t* qp = FQ + ((size_t)b * LT + qpos) * 512 + h * 64;
#pragma unroll
    for (int d = 0; d < 64; d += 8) unpack8(*(const uint4*)(qp + d), q + d);
#pragma unroll
    for (int e = 0; e < 64; ++e) o[e] = 0.f;
    float m = -1e30f, l = 0.f;
    const int last_pos = XPOS0 + qt * 64 + 63;
    for (int kp0 = FMETA0; kp0 <= last_pos; kp0 += 64) {
        __syncthreads();
        for (int c = lane; c < 512; c += 64) {
            const int key = c >> 3, d8 = (c & 7) * 8; const size_t off = ((size_t)b * LT + kp0 + key) * 512 + h * 64 + d8;
            unpack8(*(const uint4*)(FK + off), Ks + key * 64 + d8); unpack8(*(const uint4*)(FV + off), Vs + key * 64 + d8);
        }
        Bsh[lane] = BIAS[(size_t)(b * 8 + h) * LT + kp0 + lane];
        __syncthreads();
        for (int s = 0; s < 64; ++s) {
            float sc = Bsh[s];
#pragma unroll
            for (int d = 0; d < 64; d += 4) { const float4 kk = *(const float4*)(Ks + s * 64 + d); sc += q[d] * kk.x + q[d + 1] * kk.y + q[d + 2] * kk.z + q[d + 3] * kk.w; }
            if (kp0 + s > qpos) sc = -1e30f;
            const float mn = fmaxf(m, sc), f = exp2f(m - mn), p = exp2f(sc - mn);
            m = mn; l = l * f + p;
#pragma unroll
            for (int e = 0; e < 64; e += 4) { const float4 vv = *(const float4*)(Vs + s * 64 + e); o[e] = o[e] * f + p * vv.x; o[e + 1] = o[e + 1] * f + p * vv.y; o[e + 2] = o[e + 2] * f + p * vv.z; o[e + 3] = o[e + 3] * f + p * vv.w; }
        }
    }
    const float rl = 1.f / l;
    bf16_t* op = MIXED + ((size_t)b * SEQ + i) * DM + 512 + h * 64;
#pragma unroll
    for (int e = 0; e < 64; e += 8) {
        uint4 w;
        w.x = (unsigned)f2bf(o[e] * rl) | ((unsigned)f2bf(o[e + 1] * rl) << 16); w.y = (unsigned)f2bf(o[e + 2] * rl) | ((unsigned)f2bf(o[e + 3] * rl) << 16);
        w.z = (unsigned)f2bf(o[e + 4] * rl) | ((unsigned)f2bf(o[e + 5] * rl) << 16); w.w = (unsigned)f2bf(o[e + 6] * rl) | ((unsigned)f2bf(o[e + 7] * rl) << 16);
        *(uint4*)(op + e) = w;
    }
}

__global__ void __launch_bounds__(256) k_ln_rows(const float* __restrict__ y, const float* __restrict__ g, const float* __restrict__ bta, bf16_t* H) {
    const int lane = threadIdx.x & 63, wave = threadIdx.x >> 6;
    const int gw = blockIdx.x * 4 + wave, ngw = gridDim.x * 4;
    for (int row = gw; row < NX; row += ngw) {
        const float* src = y + (size_t)row * DM;
        float4 v[4]; float s = 0.f;
#pragma unroll
        for (int j = 0; j < 4; ++j) { v[j] = ((const float4*)src)[lane + 64 * j]; s += (v[j].x + v[j].y) + (v[j].z + v[j].w); }
        const float mean = wave_sum(s) * (1.f / DM);
        float s2 = 0.f;
#pragma unroll
        for (int j = 0; j < 4; ++j) { v[j].x -= mean; v[j].y -= mean; v[j].z -= mean; v[j].w -= mean; s2 += (v[j].x * v[j].x + v[j].y * v[j].y) + (v[j].z * v[j].z + v[j].w * v[j].w); }
        const float rstd = 1.f / sqrtf(wave_sum(s2) * (1.f / DM) + LN_EPS);
#pragma unroll
        for (int j = 0; j < 4; ++j) {
            const float4 gg = ((const float4*)g)[lane + 64 * j], bb = ((const float4*)bta)[lane + 64 * j];
            uint2 o; o.x = (unsigned)f2bf(v[j].x * rstd * gg.x + bb.x) | ((unsigned)f2bf(v[j].y * rstd * gg.y + bb.y) << 16);
            o.y = (unsigned)f2bf(v[j].z * rstd * gg.z + bb.z) | ((unsigned)f2bf(v[j].w * rstd * gg.w + bb.w) << 16);
            ((uint2*)(H + (size_t)row * DM))[lane + 64 * j] = o;
        }
    }
}

__global__ void __launch_bounds__(256) k_route(const float* __restrict__ LOGITS, const float* __restrict__ rbias, int* cnt, int* TOKL, float* GATEL, int* ASG) {
    __shared__ float sc[256 * 65];
    __shared__ float rb[64];
    if (threadIdx.x < 64) rb[threadIdx.x] = rbias[threadIdx.x];
    const int tok0 = blockIdx.x * 256;
    for (int i = threadIdx.x; i < 256 * 64; i += 256) { const int t = i >> 6, e = i & 63; const float x = LOGITS[(size_t)(tok0 + t) * 64 + e]; sc[t * 65 + e] = 1.f / (1.f + expf(-x)); }
    __syncthreads();
    const int tok = tok0 + threadIdx.x;
    const float* my = sc + threadIdx.x * 65;
    float gs[8];
#pragma unroll
    for (int g = 0; g < 8; ++g) {
        float m1 = -3e38f, m2 = -3e38f;
#pragma unroll
        for (int j = 0; j < 8; ++j) { const float v = my[g * 8 + j] + rb[g * 8 + j]; if (v > m1) { m2 = m1; m1 = v; } else if (v > m2) m2 = v; }
        gs[g] = m1 + m2;
    }
    unsigned gmask = 0;
#pragma unroll
    for (int r = 0; r < 4; ++r) {
        float best = -3e38f; int bi = 0;
#pragma unroll
        for (int g = 0; g < 8; ++g) { const bool take = !((gmask >> g) & 1u) && gs[g] > best; if (take) { best = gs[g]; bi = g; } }
        gmask |= 1u << bi;
    }
    unsigned long long chosen = 0ull; int sel[6]; float gv[6]; float gsum = 0.f;
#pragma unroll
    for (int r = 0; r < 6; ++r) {
        float best = -3e38f; int bi = 0;
        for (int e = 0; e < 64; ++e) { if (((gmask >> (e >> 3)) & 1u) && !((chosen >> e) & 1ull)) { const float v = my[e] + rb[e]; if (v > best) { best = v; bi = e; } } }
        chosen |= 1ull << bi; sel[r] = bi; gv[r] = my[bi]; gsum += gv[r];
    }
    const float scale = ROUTED_SCALE / gsum;
#pragma unroll
    for (int r = 0; r < 6; ++r) {
        const int e = sel[r]; const int rank = atomicAdd(&cnt[e], 1);
        TOKL[(size_t)e * CAP + rank] = tok; GATEL[(size_t)e * CAP + rank] = gv[r] * scale; ASG[(size_t)tok * 6 + r] = (e << 16) | rank;
    }
}

__global__ void __launch_bounds__(256) k_exp_up_naive(const bf16_t* __restrict__ H1, const float* __restrict__ we_gate, const float* __restrict__ we_up, const float* __restrict__ ws_gate, const float* __restrict__ ws_up,
                                                     const int* __restrict__ cnt, const int* __restrict__ TOKL, bf16_t* HID) {
    __shared__ float As[16][65];
    __shared__ float Bg[16][65];
    __shared__ float Bu[16][65];
    __shared__ int toks[64];
    __shared__ int hs_sh;
    const int e = blockIdx.z, n_e = e < 64 ? cnt[e] : NX, r0 = blockIdx.y * 64;
    if (r0 >= n_e) return;
    if (threadIdx.x == 0) { int hs = 0; for (int j = 0; j < e; ++j) hs += (cnt[j] + 255) & ~255; hs_sh = hs; }
    if (threadIdx.x < 64) { const int r = r0 + threadIdx.x; toks[threadIdx.x] = r < n_e ? (e < 64 ? TOKL[(size_t)e * CAP + r] : r) : -1; }
    __syncthreads();
    const float* Wg = e < 64 ? we_gate + (size_t)e * DM * EFF : ws_gate;
    const float* Wu = e < 64 ? we_up + (size_t)e * DM * EFF : ws_up;
    const int tx = threadIdx.x & 15, ty = threadIdx.x >> 4, n0 = blockIdx.x * 64;
    float ag[4][4], au[4][4];
#pragma unroll
    for (int i = 0; i < 4; ++i)
#pragma unroll
        for (int j = 0; j < 4; ++j) { ag[i][j] = 0.f; au[i][j] = 0.f; }
    for (int k0 = 0; k0 < DM; k0 += 16) {
        for (int i = threadIdx.x; i < 1024; i += 256) { const int m = i >> 4, k = i & 15; const int t = toks[m]; As[k][m] = t >= 0 ? bf2f(H1[(size_t)t * DM + k0 + k]) : 0.f; }
        for (int i = threadIdx.x; i < 1024; i += 256) { const int k = i >> 6, n = i & 63; Bg[k][n] = Wg[(size_t)(k0 + k) * EFF + n0 + n]; Bu[k][n] = Wu[(size_t)(k0 + k) * EFF + n0 + n]; }
        __syncthreads();
#pragma unroll
        for (int k = 0; k < 16; ++k) {
            float a[4], bg[4], bu[4];
#pragma unroll
            for (int i = 0; i < 4; ++i) { a[i] = As[k][ty * 4 + i]; bg[i] = Bg[k][tx * 4 + i]; bu[i] = Bu[k][tx * 4 + i]; }
#pragma unroll
            for (int i = 0; i < 4; ++i)
#pragma unroll
                for (int j = 0; j < 4; ++j) { ag[i][j] += a[i] * bg[j]; au[i][j] += a[i] * bu[j]; }
        }
        __syncthreads();
    }
    const int hs = hs_sh;
#pragma unroll
    for (int i = 0; i < 4; ++i)
#pragma unroll
        for (int j = 0; j < 4; ++j) { const int r = r0 + ty * 4 + i; if (r < n_e) { const float gq = ag[i][j]; HID[(size_t)(hs + r) * EFF + n0 + tx * 4 + j] = f2bf(gq / (1.f + __expf(-gq)) * au[i][j]); } }
}

__global__ void __launch_bounds__(256) k_exp_down_naive(const bf16_t* __restrict__ HID, const float* __restrict__ we_down, const float* __restrict__ ws_down, const int* __restrict__ cnt, const float* __restrict__ GATEL,
                                                       bf16_t* Y, bf16_t* H1) {
    __shared__ float As[16][65];
    __shared__ float Bs[16][65];
    __shared__ int hs_sh, ys_sh;
    const int e = blockIdx.z, n_e = e < 64 ? cnt[e] : NX, r0 = blockIdx.y * 64;
    if (r0 >= n_e) return;
    if (threadIdx.x == 0) { int hs = 0, ys = 0; for (int j = 0; j < e; ++j) { hs += (cnt[j] + 255) & ~255; ys += cnt[j]; } hs_sh = hs; ys_sh = ys; }
    __syncthreads();
    const int hs = hs_sh, ys = ys_sh;
    const float* Wd = e < 64 ? we_down + (size_t)e * EFF * DM : ws_down;
    const int tx = threadIdx.x & 15, ty = threadIdx.x >> 4, n0 = blockIdx.x * 64;
    float acc[4][4];
#pragma unroll
    for (int i = 0; i < 4; ++i)
#pragma unroll
        for (int j = 0; j < 4; ++j) acc[i][j] = 0.f;
    for (int k0 = 0; k0 < EFF; k0 += 16) {
        for (int i = threadIdx.x; i < 1024; i += 256) { const int m = i >> 4, k = i & 15; As[k][m] = (r0 + m < n_e) ? bf2f(HID[(size_t)(hs + r0 + m) * EFF + k0 + k]) : 0.f; }
        for (int i = threadIdx.x; i < 1024; i += 256) { const int k = i >> 6, n = i & 63; Bs[k][n] = Wd[(size_t)(k0 + k) * DM + n0 + n]; }
        __syncthreads();
#pragma unroll
        for (int k = 0; k < 16; ++k) {
            float a[4], b[4];
#pragma unroll
            for (int i = 0; i < 4; ++i) { a[i] = As[k][ty * 4 + i]; b[i] = Bs[k][tx * 4 + i]; }
#pragma unroll
            for (int i = 0; i < 4; ++i)
#pragma unroll
                for (int j = 0; j < 4; ++j) acc[i][j] += a[i] * b[j];
        }
        __syncthreads();
    }
#pragma unroll
    for (int i = 0; i < 4; ++i) {
        const int r = r0 + ty * 4 + i; if (r >= n_e) continue;
        if (e < 64) { const float gt = GATEL[(size_t)e * CAP + r];
#pragma unroll
            for (int j = 0; j < 4; ++j) Y[(size_t)(ys + r) * DM + n0 + tx * 4 + j] = f2bf(acc[i][j] * gt); }
        else {
#pragma unroll
            for (int j = 0; j < 4; ++j) { const size_t o = (size_t)r * DM + n0 + tx * 4 + j; H1[o] = f2bf(ALPHA * bf2f(H1[o]) + acc[i][j]); } }
    }
}

__global__ void __launch_bounds__(256) k_final(const bf16_t* __restrict__ BASE, const bf16_t* __restrict__ Y, const int* __restrict__ ASG, const int* __restrict__ cnt, const float* __restrict__ g, const float* __restrict__ bta, float* out) {
    __shared__ int ys[64];
    if (threadIdx.x == 0) { int a = 0; for (int j = 0; j < 64; ++j) { ys[j] = a; a += cnt[j]; } }
    __syncthreads();
    const int lane = threadIdx.x & 63, wave = threadIdx.x >> 6;
    const int gw = blockIdx.x * 4 + wave, ngw = gridDim.x * 4;
    for (int tok = gw; tok < NX; tok += ngw) {
        float v[16];
        { const bf16_t* src = BASE + (size_t)tok * DM;
#pragma unroll
          for (int j = 0; j < 2; ++j) unpack8(((const uint4*)src)[lane + 64 * j], v + 8 * j); }
#pragma unroll
        for (int r = 0; r < 6; ++r) {
            const int a = ASG[(size_t)tok * 6 + r]; const int e = a >> 16, rank = a & 0xffff;
            const bf16_t* src = Y + (size_t)(ys[e] + rank) * DM; float t[8];
#pragma unroll
            for (int j = 0; j < 2; ++j) { unpack8(((const uint4*)src)[lane + 64 * j], t);
#pragma unroll
                for (int q = 0; q < 8; ++q) v[8 * j + q] += t[q]; }
        }
        float s = 0.f;
#pragma unroll
        for (int q = 0; q < 16; ++q) s += v[q];
        const float mean = wave_sum(s) * (1.f / DM);
        float s2 = 0.f;
#pragma unroll
        for (int q = 0; q < 16; ++q) { v[q] -= mean; s2 += v[q] * v[q]; }
        const float rstd = 1.f / sqrtf(wave_sum(s2) * (1.f / DM) + LN_EPS);
#pragma unroll
        for (int j = 0; j < 2; ++j) {
            const int c0 = (lane + 64 * j) * 8;
            const float4 g0 = *(const float4*)(g + c0), g1 = *(const float4*)(g + c0 + 4), b0 = *(const float4*)(bta + c0), b1 = *(const float4*)(bta + c0 + 4);
            float4 o0, o1;
            o0.x = v[8 * j + 0] * rstd * g0.x + b0.x; o0.y = v[8 * j + 1] * rstd * g0.y + b0.y; o0.z = v[8 * j + 2] * rstd * g0.z + b0.z; o0.w = v[8 * j + 3] * rstd * g0.w + b0.w;
            o1.x = v[8 * j + 4] * rstd * g1.x + b1.x; o1.y = v[8 * j + 5] * rstd * g1.y + b1.y; o1.z = v[8 * j + 6] * rstd * g1.z + b1.z; o1.w = v[8 * j + 7] * rstd * g1.w + b1.w;
            *(float4*)(out + (size_t)tok * DM + c0) = o0; *(float4*)(out + (size_t)tok * DM + c0 + 4) = o1;
        }
    }
}


namespace pg8 {
#define PG8_LAS __attribute__((address_space(3)))
typedef unsigned short bf16_t;
typedef short bf16x8 __attribute__((ext_vector_type(8)));
typedef float f32x4 __attribute__((ext_vector_type(4)));
typedef unsigned u32x4 __attribute__((ext_vector_type(4)));
constexpr int BM = 256, BK = 64, HALF = 128, HTB = HALF * BK * 2  , STAGE_BYTES = 8 * HTB, NXCD = 8, WGM = 8;

__host__ __device__ __forceinline__ int lds_byte(int r, int c) { const int st = (r >> 4) * 2 + (c >> 5), rr = r & 15, cc = c & 31, ob = rr * 64 + cc * 2; return st * 1024 + (ob ^ (((ob >> 9) & 1) << 5)); }
__host__ __device__ __forceinline__ void stage_rc(int b, int& R, int& C) { const int st = b / 1024, sb = b % 1024, swz = sb ^ (((sb >> 9) & 1) << 5); R = (st >> 1) * 16 + swz / 64; C = (st & 1) * 32 + (swz % 64) / 2; }
__host__ __device__ __forceinline__ int perm32(int rho) { const int n = rho >> 4, i = rho & 15; return 8 * (i >> 2) + 4 * n + (i & 3); }

struct Unit { int pm, pn, idx; };
struct Gemm { const bf16_t* A; const bf16_t* Bt; int M, N, K; };

struct StaticOrder {
    int nM, nN, nwg, G, c;
    __host__ __device__ void init(int M, int N, int G_, int c_) { nM = M / BM; nN = N / BM; nwg = nM * nN; G = G_; c = c_; }
    __host__ __device__ bool next(int i, Unit& u) const {
        const long L = (long)i * G + c; if (L >= nwg) return false;
        int wgid = (int)L; { const int q = nwg / NXCD, r = nwg % NXCD, xcd = wgid % NXCD, off = wgid / NXCD; wgid = (xcd < r ? xcd * (q + 1) : r * (q + 1) + (xcd - r) * q) + off; }
        const int nig = WGM * nN, gid = wgid / nig, fm = gid * WGM, gsz = (nM - fm) < WGM ? (nM - fm) : WGM;
        u.pm = fm + ((wgid % nig) % gsz); u.pn = (wgid % nig) / gsz; return true;
    }
    __device__ __forceinline__ void a_ready(const Unit&) const {}
    __device__ __forceinline__ void done(const Unit&) const {}
    __device__ __forceinline__ const char* a_base(const Gemm& g, const Unit& u) const { return (const char*)g.A + (size_t)u.pm * ((size_t)BM * g.K * 2); }
    __device__ __forceinline__ const char* b_base(const Gemm& g, const Unit& u) const { return (const char*)g.Bt + (size_t)u.pn * ((size_t)BM * g.K * 2); }
    __device__ __forceinline__ void a_offs(const Gemm& g, const Unit& u, int tid, unsigned (&VO)[2][2]) const {
#pragma unroll
        for (int i = 0; i < 2; ++i) { int R, C; stage_rc(tid * 16 + i * 8192, R, C);
#pragma unroll
            for (int h = 0; h < 2; ++h) VO[h][i] = (unsigned)((u.pm * BM + h * HALF + R) * g.K + C) * 2u; } }
};

__device__ __forceinline__ unsigned cvt_pk_bf16(float lo, float hi) { unsigned r; asm volatile("v_cvt_pk_bf16_f32 %0, %1, %2" : "=v"(r) : "v"(lo), "v"(hi)); return r; }

struct EpiOutproj {
    static constexpr bool PERM = true, AFTER_DRAIN = false;
    float* y; const bf16_t* XN;
    __device__ __forceinline__ void operator()(const f32x4 (&acc)[2][2][4][2], const Unit& u, int wr, int wc, int fr, int fq) const {
#pragma unroll
        for (int ai = 0; ai < 2; ++ai)
#pragma unroll
            for (int m = 0; m < 4; ++m) {
                const size_t ro = (size_t)(u.pm * BM + ai * HALF + wr * 64 + m * 16 + fr) * DM + u.pn * BM + wc * 32 + 8 * fq;
#pragma unroll
                for (int bj = 0; bj < 2; ++bj) {
                    const u32x4 xn = *(const u32x4*)(XN + ro + bj * HALF);
                    f32x4 v0 = acc[ai][bj][m][0], v1 = acc[ai][bj][m][1];
                    v0[0] += ALPHA * __uint_as_float(xn.x << 16); v0[1] += ALPHA * __uint_as_float(xn.x & 0xffff0000u); v0[2] += ALPHA * __uint_as_float(xn.y << 16); v0[3] += ALPHA * __uint_as_float(xn.y & 0xffff0000u);
                    v1[0] += ALPHA * __uint_as_float(xn.z << 16); v1[1] += ALPHA * __uint_as_float(xn.z & 0xffff0000u); v1[2] += ALPHA * __uint_as_float(xn.w << 16); v1[3] += ALPHA * __uint_as_float(xn.w & 0xffff0000u);
                    *(f32x4*)(y + ro + bj * HALF) = v0; *(f32x4*)(y + ro + bj * HALF + 4) = v1;
                }
            }
    }
};
struct SingleUnit {
    int pm, pn, have;
    __device__ __forceinline__ bool next(int i, Unit& u) const { if (i > 0 || !have) return false; u.pm = pm; u.pn = pn; u.idx = 0; return true; }
    __device__ __forceinline__ void a_ready(const Unit&) const {}
    __device__ __forceinline__ void done(const Unit&) const {}
    __device__ __forceinline__ const char* b_base(const Gemm& g, const Unit& u) const { return (const char*)g.Bt + (size_t)u.pn * ((size_t)BM * g.K * 2); }
    __device__ __forceinline__ void a_offs(const Gemm& g, const Unit& u, int tid, unsigned (&VO)[2][2]) const {
#pragma unroll
        for (int i = 0; i < 2; ++i) { int R, C; stage_rc(tid * 16 + i * 8192, R, C);
#pragma unroll
            for (int h = 0; h < 2; ++h) VO[h][i] = (unsigned)((u.pm * BM + h * HALF + R) * g.K + C) * 2u; } }
};
template <bool GATHER> struct GroupOrder {
    const PG8_LAS int* ul; int n; const int* tokl; int b_rows;
    __device__ __forceinline__ bool next(int i, Unit& u) const { if (i >= n) return false; const PG8_LAS int* p = ul + 6 * i; u.pm = p[1]; u.pn = p[2]; u.idx = i; return true; }
    __device__ __forceinline__ void a_ready(const Unit&) const {}
    __device__ __forceinline__ void done(const Unit&) const {}
    __device__ __forceinline__ const char* b_base(const Gemm& g, const Unit& u) const { return (const char*)g.Bt + ((size_t)ul[6 * u.idx] * b_rows + (size_t)u.pn * BM) * ((size_t)g.K * 2); }
    __device__ __forceinline__ void a_offs(const Gemm& g, const Unit& u, int tid, unsigned (&VO)[2][2]) const {
        const PG8_LAS int* p = ul + 6 * u.idx; const int e = p[0], aux = p[3], nv = p[5];
#pragma unroll
        for (int i = 0; i < 2; ++i) { int R, C; stage_rc(tid * 16 + i * 8192, R, C);
#pragma unroll
            for (int h = 0; h < 2; ++h) {
                const int rl = h * HALF + R; int row;
                if (GATHER) { row = 0; if (rl < nv) row = tokl[(size_t)e * CAP + u.pm * BM + rl]; }
                else row = aux + rl;
                VO[h][i] = (unsigned)(row * g.K + C) * 2u; } }
    }
};
__device__ __forceinline__ float silu_f(float v) { return v / (1.f + __expf(-v)); }
template <bool LIST> struct EpiGU {
    static constexpr bool PERM = true, AFTER_DRAIN = false;
    bf16_t* HID; const PG8_LAS int* ul;
    __device__ __forceinline__ void operator()(const f32x4 (&acc)[2][2][4][2], const Unit& u, int wr, int wc, int fr, int fq) const {
        const int aux = LIST ? ul[6 * u.idx + 3] : u.pm * BM;
#pragma unroll
        for (int ai = 0; ai < 2; ++ai)
#pragma unroll
            for (int m = 0; m < 4; ++m) {
                bf16_t* rowp = HID + (size_t)(aux + ai * HALF + wr * 64 + m * 16 + fr) * EFF + u.pn * 128 + wc * 16 + fq * 4;
#pragma unroll
                for (int bj = 0; bj < 2; ++bj) {
                    const f32x4 v0 = acc[ai][bj][m][0], v1 = acc[ai][bj][m][1];
                    unsigned w0 = cvt_pk_bf16(silu_f(v0[0]) * v1[0], silu_f(v0[1]) * v1[1]), w1 = cvt_pk_bf16(silu_f(v0[2]) * v1[2], silu_f(v0[3]) * v1[3]);
                    typedef unsigned u32x2 __attribute__((ext_vector_type(2)));
                    *(u32x2*)(rowp + bj * 64) = (u32x2){w0, w1};
                }
            }
    }
};
struct EpiBase {
    static constexpr bool PERM = true, AFTER_DRAIN = false;
    bf16_t* H1;
    __device__ __forceinline__ void operator()(const f32x4 (&acc)[2][2][4][2], const Unit& u, int wr, int wc, int fr, int fq) const {
#pragma unroll
        for (int ai = 0; ai < 2; ++ai)
#pragma unroll
            for (int m = 0; m < 4; ++m) {
                bf16_t* rowp = H1 + (size_t)(u.pm * BM + ai * HALF + wr * 64 + m * 16 + fr) * DM + u.pn * BM + wc * 32 + 8 * fq;
#pragma unroll
                for (int bj = 0; bj < 2; ++bj) {
                    const u32x4 xn = *(const u32x4*)(rowp + bj * HALF);
                    const f32x4 v0 = acc[ai][bj][m][0], v1 = acc[ai][bj][m][1];
                    u32x4 w;
                    w.x = cvt_pk_bf16(v0[0] + ALPHA * __uint_as_float(xn.x << 16), v0[1] + ALPHA * __uint_as_float(xn.x & 0xffff0000u)); w.y = cvt_pk_bf16(v0[2] + ALPHA * __uint_as_float(xn.y << 16), v0[3] + ALPHA * __uint_as_float(xn.y & 0xffff0000u));
                    w.z = cvt_pk_bf16(v1[0] + ALPHA * __uint_as_float(xn.z << 16), v1[1] + ALPHA * __uint_as_float(xn.z & 0xffff0000u)); w.w = cvt_pk_bf16(v1[2] + ALPHA * __uint_as_float(xn.w << 16), v1[3] + ALPHA * __uint_as_float(xn.w & 0xffff0000u));
                    *(u32x4*)(rowp + bj * HALF) = w;
                }
            }
    }
};
struct EpiY {
    static constexpr bool PERM = true, AFTER_DRAIN = false;
    bf16_t* Y; const float* GATEL; const PG8_LAS int* ul;
    __device__ __forceinline__ void operator()(const f32x4 (&acc)[2][2][4][2], const Unit& u, int wr, int wc, int fr, int fq) const {
        const PG8_LAS int* p = ul + 6 * u.idx; const int e = p[0], aux2 = p[4], nv = p[5];
#pragma unroll
        for (int ai = 0; ai < 2; ++ai)
#pragma unroll
            for (int m = 0; m < 4; ++m) {
                const int rl = ai * HALF + wr * 64 + m * 16 + fr;
                if (rl < nv) {
                    const float gt = GATEL[(size_t)e * CAP + u.pm * BM + rl];
                    bf16_t* rowp = Y + (size_t)(aux2 + rl) * DM + u.pn * BM + wc * 32 + 8 * fq;
#pragma unroll
                    for (int bj = 0; bj < 2; ++bj) {
                        const f32x4 v0 = acc[ai][bj][m][0] * gt, v1 = acc[ai][bj][m][1] * gt;
                        u32x4 w; w.x = cvt_pk_bf16(v0[0], v0[1]); w.y = cvt_pk_bf16(v0[2], v0[3]); w.z = cvt_pk_bf16(v1[0], v1[1]); w.w = cvt_pk_bf16(v1[2], v1[3]);
                        *(u32x4*)(rowp + bj * HALF) = w;
                    }
                }
            }
    }
};
struct EpiRouter {
    static constexpr bool PERM = true, AFTER_DRAIN = true;
    const float* rbias; int* cnt; int* TOKL; float* GATEL; int* ASG;
    __device__ __forceinline__ void fused(f32x4 (&acc)[2][2][4][2], const Unit& u, int wr, int wc, int fr, int fq, PG8_LAS unsigned char* lds, int wid, int lane) const {
        PG8_LAS float* L = (PG8_LAS float*)lds;
        PG8_LAS float* rb = L + 256 * 65; PG8_LAS int* lcnt = (PG8_LAS int*)(rb + 64); PG8_LAS int* base = lcnt + 64;
        const int tid = wid * 64 + lane;
        if (tid < 64) { rb[tid] = rbias[tid]; lcnt[tid] = 0; }
        if (wc < 2) {
#pragma unroll
            for (int ai = 0; ai < 2; ++ai)
#pragma unroll
                for (int m = 0; m < 4; ++m)
#pragma unroll
                    for (int n = 0; n < 2; ++n) { const int rl = ai * HALF + wr * 64 + m * 16 + fr, e0 = wc * 32 + fq * 8 + n * 4; const f32x4 v = acc[ai][0][m][n];
#pragma unroll
                        for (int q = 0; q < 4; ++q) L[rl * 65 + e0 + q] = 1.f / (1.f + expf(-v[q])); }
        }
        __syncthreads();
        int sel[6]; int lr[6]; float gv[6]; float scale = 0.f;
        if (tid < 256) {
            const PG8_LAS float* my = L + tid * 65;
            float gs[8];
#pragma unroll
            for (int g = 0; g < 8; ++g) {
                float m1 = -3e38f, m2 = -3e38f;
#pragma unroll
                for (int j = 0; j < 8; ++j) { const float v = my[g * 8 + j] + rb[g * 8 + j]; if (v > m1) { m2 = m1; m1 = v; } else if (v > m2) m2 = v; }
                gs[g] = m1 + m2;
            }
            unsigned gmask = 0;
#pragma unroll
            for (int r = 0; r < 4; ++r) {
                float best = -3e38f; int bi = 0;
#pragma unroll
                for (int g = 0; g < 8; ++g) { const bool take = !((gmask >> g) & 1u) && gs[g] > best; if (take) { best = gs[g]; bi = g; } }
                gmask |= 1u << bi;
            }
            unsigned long long chosen = 0ull; float gsum = 0.f;
#pragma unroll
            for (int r = 0; r < 6; ++r) {
                float best = -3e38f; int bi = 0;
                for (int e = 0; e < 64; ++e) { if (((gmask >> (e >> 3)) & 1u) && !((chosen >> e) & 1ull)) { const float v = my[e] + rb[e]; if (v > best) { best = v; bi = e; } } }
                chosen |= 1ull << bi; sel[r] = bi; gv[r] = my[bi]; gsum += gv[r];
                lr[r] = __hip_atomic_fetch_add(lcnt + bi, 1, __ATOMIC_RELAXED, __HIP_MEMORY_SCOPE_WORKGROUP);
            }
            scale = ROUTED_SCALE / gsum;
        }
        __syncthreads();
        if (tid < 64) base[tid] = atomicAdd(cnt + tid, lcnt[tid]);
        __syncthreads();
        if (tid < 256) {
            const int tok = u.pm * BM + tid;
#pragma unroll
            for (int r = 0; r < 6; ++r) { const int e = sel[r], rank = base[e] + lr[r]; TOKL[(size_t)e * CAP + rank] = tok; GATEL[(size_t)e * CAP + rank] = gv[r] * scale; ASG[(size_t)tok * 6 + r] = (e << 16) | rank; }
        }
        __syncthreads();
    }
};
struct EpiInproj {
    static constexpr bool PERM = true, AFTER_DRAIN = false;
    bf16_t* bufs; const float* tab;
    __device__ __forceinline__ void operator()(const f32x4 (&acc)[2][2][4][2], const Unit& u, int wr, int wc, int fr, int fq) const {
        const int g = u.pn >> 1;
        bf16_t* base = bufs + (size_t)g * BUFE;
        const int ccb = (u.pn & 1) * 256 + wc * 32 + 8 * fq;
        float ihi[4], ilo[4];
#pragma unroll
        for (int jj = 0; jj < 4; ++jj) { ihi[jj] = 0.f; ilo[jj] = 0.f; }
        if (g < 2) {
#pragma unroll
            for (int jj = 0; jj < 4; ++jj) { const int j = 16 * wc + 4 * fq + jj; ihi[jj] = tab[2 * j]; ilo[jj] = tab[2 * j + 1]; }
        }
#pragma unroll
        for (int ai = 0; ai < 2; ++ai)
#pragma unroll
            for (int m = 0; m < 4; ++m) {
                const int row = u.pm * BM + ai * HALF + wr * 64 + m * 16 + fr; const int b = row >> 12, i = row & 4095;
                bf16_t* rowp = base + ((size_t)b * LT + XPOS0 + i) * 512 + ccb;
                float cs[4], sn[4];
                if (g < 2) {
                    const float t = (float)(NMETA + i);
#pragma unroll
                    for (int jj = 0; jj < 4; ++jj) { const float p = t * ihi[jj]; const float e = __builtin_fmaf(t, ihi[jj], -p) + t * ilo[jj]; const float f = (p - __builtin_floorf(p)) + e;
                        sn[jj] = __builtin_amdgcn_sinf(f); cs[jj] = __builtin_amdgcn_cosf(f); }
                }
#pragma unroll
                for (int bj = 0; bj < 2; ++bj) {
                    f32x4 v0 = acc[ai][bj][m][0], v1 = acc[ai][bj][m][1];
                    if (g < 2) {
                        f32x4 r0, r1;
                        r0[0] = v0[0] * cs[0] - v0[1] * sn[0]; r0[1] = v0[1] * cs[0] + v0[0] * sn[0]; r0[2] = v0[2] * cs[1] - v0[3] * sn[1]; r0[3] = v0[3] * cs[1] + v0[2] * sn[1];
                        r1[0] = v1[0] * cs[2] - v1[1] * sn[2]; r1[1] = v1[1] * cs[2] + v1[0] * sn[2]; r1[2] = v1[2] * cs[3] - v1[3] * sn[3]; r1[3] = v1[3] * cs[3] + v1[2] * sn[3];
                        const float sc = (g == 1) ? RK_SCALE : 1.f; v0 = r0 * sc; v1 = r1 * sc;
                    } else if (g == 3) {
#pragma unroll
                        for (int q = 0; q < 4; ++q) { v0[q] = v0[q] / (1.f + __expf(-v0[q])); v1[q] = v1[q] / (1.f + __expf(-v1[q])); }
                    } else if (g == 4) { v0 = v0 * C2; v1 = v1 * C2; }
                    u32x4 w; w.x = cvt_pk_bf16(v0[0], v0[1]); w.y = cvt_pk_bf16(v0[2], v0[3]); w.z = cvt_pk_bf16(v1[0], v1[1]); w.w = cvt_pk_bf16(v1[2], v1[3]);
                    *(u32x4*)(rowp + bj * HALF) = w;
                }
            }
    }
};
template <class Epi, class Sched, bool ALIGN_EPI = false, bool SP2 = false>
__device__ __forceinline__ void gemm_phase(PG8_LAS unsigned char* lds, const Gemm g, const Sched& S, const Epi& E) {
    const int tid = threadIdx.x, wid = __builtin_amdgcn_readfirstlane(tid >> 6), lane = tid & 63, wr = wid >> 2, wc = wid & 3, fr = lane & 15, fq = lane >> 4;
    const int K = g.K, nt = K / BK;
    unsigned voffB[2];
#pragma unroll
    for (int i = 0; i < 2; ++i) { int R, C; stage_rc(tid * 16 + i * 8192, R, C); const int Rb = Epi::PERM ? ((R & ~31) + perm32(R & 31)) : R;
        voffB[i] = (unsigned)(Rb * K + C) * 2u; }
    const size_t kstep = (size_t)(BK * 2);
    const size_t hstep = (size_t)HALF * K * 2;
    const unsigned ldsw = (unsigned)wid * 1024u;
    const int aoff = lds_byte(wr * 64 + fr, fq * 8), boff = lds_byte(wc * 32 + fr, fq * 8);
#define PG8_SA(b, h) (((b) * 2 + (h)) * HTB)
#define PG8_SB(b, h) ((4 + (b) * 2 + (h)) * HTB)
#define PG8_STAGE(bufoff, gbase, voff) do { _Pragma("unroll") for (int _i = 0; _i < 2; ++_i) \
        __builtin_amdgcn_global_load_lds((const unsigned*)((const char*)(gbase) + (voff)[_i]), (PG8_LAS unsigned*)(lds + (bufoff) + ldsw + _i * 8192), 16, 0, 0); } while (0)
#define PG8_STAGEA(bufoff, VO, h, kofs) do { _Pragma("unroll") for (int _i = 0; _i < 2; ++_i) \
        __builtin_amdgcn_global_load_lds((const unsigned*)(Ab + (size_t)(VO)[h][_i] + (size_t)(kofs)), (PG8_LAS unsigned*)(lds + (bufoff) + ldsw + _i * 8192), 16, 0, 0); } while (0)
#define PG8_LDA(dst, b, h) do { _Pragma("unroll") for (int m = 0; m < 4; ++m) _Pragma("unroll") for (int k = 0; k < 2; ++k) dst[m][k] = *(const PG8_LAS bf16x8*)(lds + PG8_SA(b, h) + aoff + m * 2048 + k * 1024); } while (0)
#define PG8_LDB(dst, b, h) do { _Pragma("unroll") for (int n = 0; n < 2; ++n) _Pragma("unroll") for (int k = 0; k < 2; ++k) dst[n][k] = *(const PG8_LAS bf16x8*)(lds + PG8_SB(b, h) + boff + n * 2048 + k * 1024); } while (0)
#define PG8_MMA(ai, bj, At, Bt) do { __builtin_amdgcn_s_setprio(1); _Pragma("unroll") for (int m = 0; m < 4; ++m) _Pragma("unroll") for (int n = 0; n < 2; ++n) _Pragma("unroll") for (int k = 0; k < 2; ++k) \
        acc[ai][bj][m][n] = __builtin_amdgcn_mfma_f32_16x16x32_bf16(Bt[n][k], At[m][k], acc[ai][bj][m][n], 0, 0, 0); __builtin_amdgcn_s_setprio(0); } while (0)
#define PG8_WAIT_V(n) asm volatile("s_waitcnt vmcnt(" #n ")" ::: "memory")
#define PG8_WAIT_L(n) asm volatile("s_waitcnt lgkmcnt(" #n ")" ::: "memory")
#define PG8_BAR __builtin_amdgcn_s_barrier()
#define PG8_SCHED __builtin_amdgcn_sched_barrier(0)
    Unit cur, nxt; int ui = 0;
    if (!S.next(0, cur)) return;
    f32x4 acc[2][2][4][2];
#pragma unroll
    for (int a = 0; a < 2; ++a)
#pragma unroll
        for (int b = 0; b < 2; ++b)
#pragma unroll
            for (int m = 0; m < 4; ++m)
#pragma unroll
                for (int n = 0; n < 2; ++n) acc[a][b][m][n] = (f32x4){0.f, 0.f, 0.f, 0.f};
    bf16x8 At[4][2], B0[2][2], B1[2][2];
    const char* Ab = (const char*)g.A; const char* cB = S.b_base(g, cur);
    unsigned VA[2][2], VN[2][2];
    S.a_offs(g, cur, tid, VA);
    S.a_ready(cur);
    if constexpr (SP2) {
        PG8_STAGE(PG8_SB(0, 0), cB, voffB); PG8_STAGE(PG8_SB(0, 1), cB + hstep, voffB); PG8_STAGEA(PG8_SA(0, 0), VA, 0, 0); PG8_STAGEA(PG8_SA(0, 1), VA, 1, 0);
        if (wr == 1) PG8_BAR;
        PG8_WAIT_V(2); PG8_BAR;
        PG8_STAGE(PG8_SB(1, 0), cB + kstep, voffB); PG8_STAGEA(PG8_SA(1, 0), VA, 0, kstep); PG8_STAGE(PG8_SB(1, 1), cB + hstep + kstep, voffB);
        PG8_WAIT_V(6); PG8_BAR;
    } else { static_assert(SP2, "only the SP2 loop is kept in this file"); }
    for (;;) {
        const bool has_next = S.next(ui + 1, nxt);
        const char* nB = has_next ? S.b_base(g, nxt) : cB;
        if (has_next) S.a_offs(g, nxt, tid, VN);
        else {
#pragma unroll
            for (int h = 0; h < 2; ++h)
#pragma unroll
                for (int i = 0; i < 2; ++i) VN[h][i] = VA[h][i]; }
#pragma unroll 1
        for (int t = 0; t < nt; t += 2) {
            const bool last = (t == nt - 2);
            const size_t k1 = (size_t)(t + 1) * kstep, k2 = last ? (size_t)0 : (size_t)(t + 2) * kstep;
            const char* b2 = last ? nB : cB + (size_t)(t + 2) * kstep; const char* b3 = b2 + kstep;
            if (last && has_next) S.a_ready(nxt);
            if constexpr (SP2) {
            PG8_LDB(B0, 0, 0); PG8_LDB(B1, 0, 1); PG8_SCHED; PG8_LDA(At, 0, 0); PG8_STAGEA(PG8_SA(1, 1), VA, 1, k1);
            if (last) {
#pragma unroll
                for (int h = 0; h < 2; ++h)
#pragma unroll
                    for (int i = 0; i < 2; ++i) VA[h][i] = VN[h][i]; }
            PG8_WAIT_V(8); PG8_WAIT_L(0); PG8_BAR; PG8_MMA(0, 0, At, B0); PG8_MMA(0, 1, At, B1); PG8_BAR; PG8_SCHED;
            PG8_LDA(At, 0, 1); PG8_STAGE(PG8_SB(0, 0), b2, voffB); PG8_STAGE(PG8_SB(0, 1), b2 + hstep, voffB); PG8_STAGEA(PG8_SA(0, 0), VA, 0, k2);
            PG8_WAIT_V(8); PG8_WAIT_L(0); PG8_BAR; PG8_MMA(1, 0, At, B0); PG8_MMA(1, 1, At, B1); PG8_BAR; PG8_SCHED;
            PG8_LDB(B0, 1, 0); PG8_LDB(B1, 1, 1); PG8_SCHED; PG8_LDA(At, 1, 0); PG8_STAGEA(PG8_SA(0, 1), VA, 1, k2);
            PG8_WAIT_V(8); PG8_WAIT_L(0); PG8_BAR; PG8_MMA(0, 0, At, B0); PG8_MMA(0, 1, At, B1); PG8_BAR; PG8_SCHED;
            PG8_LDA(At, 1, 1); PG8_STAGE(PG8_SB(1, 0), b3, voffB); PG8_STAGE(PG8_SB(1, 1), b3 + hstep, voffB); PG8_STAGEA(PG8_SA(1, 0), VA, 0, k2 + kstep);
            PG8_WAIT_V(8); PG8_WAIT_L(0); PG8_BAR; PG8_MMA(1, 0, At, B0); PG8_MMA(1, 1, At, B1); PG8_BAR; PG8_SCHED;
            }
        }
        if constexpr (ALIGN_EPI) { if (wr == 0) PG8_BAR; }
        if constexpr (!Epi::AFTER_DRAIN) { E(acc, cur, wr, wc, fr, fq); S.done(cur); }
        if (!has_next) break;
#pragma unroll
        for (int a = 0; a < 2; ++a)
#pragma unroll
            for (int b = 0; b < 2; ++b)
#pragma unroll
                for (int m = 0; m < 4; ++m)
#pragma unroll
                    for (int n = 0; n < 2; ++n) acc[a][b][m][n] = (f32x4){0.f, 0.f, 0.f, 0.f};
        cur = nxt; cB = nB; ++ui;
        if constexpr (ALIGN_EPI) { if (wr == 1) PG8_BAR; }
    }
    PG8_WAIT_V(0);
    if constexpr (!ALIGN_EPI) { if (wr == 0) PG8_BAR; }
    PG8_BAR;
    if constexpr (Epi::AFTER_DRAIN) { E.fused(acc, cur, wr, wc, fr, fq, lds, wid, lane); S.done(cur); }
#undef PG8_SA
#undef PG8_SB
#undef PG8_STAGE
#undef PG8_STAGEA
#undef PG8_LDA
#undef PG8_LDB
#undef PG8_MMA
#undef PG8_WAIT_V
#undef PG8_WAIT_L
#undef PG8_BAR
#undef PG8_SCHED
}
}

#include <hip/hip_bf16.h>
namespace attn_body {
using bf16=__hip_bfloat16;
using bf16x8=__attribute__((ext_vector_type(8)))short;
using s16x4=__attribute__((ext_vector_type(4)))short;
using f32x16=__attribute__((ext_vector_type(16)))float;
using u32x4=__attribute__((ext_vector_type(4)))unsigned;
constexpr int BATCH=8,NHEAD=8,SEQ=4352,D=64,DM=512,OPITCH=1024,OCOL0=512,T0=2,XROWS=4096;
constexpr int NW=8,QBLK=32,QB=QBLK*NW,KVBLK=64,NQB=SEQ/QB;
constexpr int ATTN_PITCH=DM, ATTN_UNIT_ROWS=QB;
__device__ __forceinline__ int crow(int r,int hi){return (r&3)+8*(r>>2)+4*hi;}
#define SBAR() __builtin_amdgcn_sched_barrier(0)
__device__ __forceinline__ void cmask(f32x16&p0,f32x16&p1,int jb,int qrel,int hi){
  const float NEG=-INFINITY; int kb=64*jb+4*hi;
  #pragma unroll
  for(int r=0;r<16;++r){int kv=kb+(r&3)+8*(r>>2); if(kv>qrel)p0[r]=NEG; if(kv+32>qrel)p1[r]=NEG;}
}

constexpr int NSLOT=3, SLOTB=8192;
constexpr int LDS_K=0, LDS_V=NSLOT*SLOTB, LDS_WS=2*NSLOT*SLOTB, LDS_OST=LDS_WS+NW*64*4, LDS_BIAS=LDS_OST+NW*4096, LDS_BYTES=LDS_BIAS+SEQ*4;
constexpr float C2=0.125f*1.4426950408889634f;
__device__ __forceinline__ void glds16(const void*gsrc,unsigned lds_dst){unsigned keep;
  asm volatile("s_mov_b32 %0, m0\n\ts_mov_b32 m0, %2\n\ts_nop 0\n\tglobal_load_lds_dwordx4 %1, off\n\ts_mov_b32 m0, %0":"=&s"(keep):"v"(gsrc),"s"(lds_dst):"memory");}
__device__ __forceinline__ float max3f(float a,float b,float c){float r;asm("v_max3_f32 %0, %1, %2, %3":"=v"(r):"v"(a),"v"(b),"v"(c));return r;}
__device__ __forceinline__ float max2f(float a,float b){float r;asm("v_max_f32_e32 %0, %1, %2":"=v"(r):"v"(a),"v"(b));return r;}
__device__ __forceinline__ float fadd_s(float a,float b){float r;asm("v_add_f32_e32 %0, %1, %2":"=v"(r):"v"(a),"v"(b));return r;}
__device__ __forceinline__ float fsub_s(float a,float b){float r;asm("v_sub_f32_e32 %0, %1, %2":"=v"(r):"v"(a),"v"(b));return r;}
typedef float f32x2_t __attribute__((ext_vector_type(2))); typedef __bf16 bf16x2_t __attribute__((ext_vector_type(2)));
__device__ __forceinline__ unsigned cvtpk_s(float lo,float hi){f32x2_t v={lo,hi};bf16x2_t b=__builtin_convertvector(v,bf16x2_t);return __builtin_bit_cast(unsigned,b);}
#define WAIT_BAR(N) asm volatile("s_waitcnt vmcnt(" #N ") lgkmcnt(0)\n\ts_barrier":::"memory")

__device__ __forceinline__ void qkt(f32x16&p0,f32x16&p1,const char*Kslot,const bf16x8*qr,const f32x16 c0in,const f32x16 c1in,int r32,int hi){
  const char*kb=Kslot+hi*1024+r32*16;
  #pragma unroll
  for(int d0=0;d0<4;++d0){
    const bf16x8 b0=*reinterpret_cast<const bf16x8*>(kb+d0*2048);
    const bf16x8 b1=*reinterpret_cast<const bf16x8*>(kb+d0*2048+512);
    if(d0==0){p0=__builtin_amdgcn_mfma_f32_32x32x16_bf16(b0,qr[0],c0in,0,0,0);p1=__builtin_amdgcn_mfma_f32_32x32x16_bf16(b1,qr[0],c1in,0,0,0);}
    else{p0=__builtin_amdgcn_mfma_f32_32x32x16_bf16(b0,qr[d0],p0,0,0,0);p1=__builtin_amdgcn_mfma_f32_32x32x16_bf16(b1,qr[d0],p1,0,0,0);}}
}
typedef __attribute__((address_space(3))) const char* lds_cptr;
typedef short v4i16_t __attribute__((ext_vector_type(4)));
__device__ __forceinline__ void kload8(bf16x8*kf,lds_cptr kp){
  kf[0]=*(const __attribute__((address_space(3))) bf16x8*)(kp);      kf[1]=*(const __attribute__((address_space(3))) bf16x8*)(kp+512);
  kf[2]=*(const __attribute__((address_space(3))) bf16x8*)(kp+2048); kf[3]=*(const __attribute__((address_space(3))) bf16x8*)(kp+2560);
  kf[4]=*(const __attribute__((address_space(3))) bf16x8*)(kp+4096); kf[5]=*(const __attribute__((address_space(3))) bf16x8*)(kp+4608);
  kf[6]=*(const __attribute__((address_space(3))) bf16x8*)(kp+6144); kf[7]=*(const __attribute__((address_space(3))) bf16x8*)(kp+6656);
}
__device__ __forceinline__ void kload2(bf16x8*kf,lds_cptr kp,int j){ kf[2*j]=*(const __attribute__((address_space(3))) bf16x8*)(kp+j*2048); kf[2*j+1]=*(const __attribute__((address_space(3))) bf16x8*)(kp+j*2048+512); }
__device__ __forceinline__ s16x4 vtr(lds_cptr p){ return __builtin_bit_cast(s16x4,__builtin_amdgcn_ds_read_tr16_b64_v4i16((__attribute__((address_space(3))) v4i16_t*)p)); }
__device__ __forceinline__ float rowmax(const f32x16&p0,const f32x16&p1){
  float a=max3f(p0[0],p0[1],p1[0]),b=max3f(p0[2],p0[3],p1[1]);a=max3f(a,p1[2],p1[3]);
  #pragma unroll
  for(int r=4;r<16;r+=4){a=max3f(a,p0[r],p0[r+1]);b=max3f(b,p0[r+2],p0[r+3]);a=max3f(a,p1[r],p1[r+1]);b=max3f(b,p1[r+2],p1[r+3]);}
  const float m=max2f(a,b);
  auto rr=__builtin_amdgcn_permlane32_swap(__float_as_uint(m),__float_as_uint(m),false,false);
  return max2f(__uint_as_float(rr[0]),__uint_as_float(rr[1]));
}
__device__ __forceinline__ void pv(f32x16*o,int vb,bf16x8 pa0,bf16x8 pa1,bf16x8 pa2,bf16x8 pa3){
  #pragma unroll
  for(int d0=0;d0<2;++d0){s16x4 lo[4],hi[4];
    #pragma unroll
    for(int ks=0;ks<4;++ks){
      asm volatile("ds_read_b64_tr_b16 %0,%1 offset:%c2":"=&v"(lo[ks]):"v"(vb),"i"(d0*4096+ks*1024):"memory");
      asm volatile("ds_read_b64_tr_b16 %0,%1 offset:%c2":"=&v"(hi[ks]):"v"(vb),"i"(d0*4096+ks*1024+512):"memory");}
    asm volatile("s_waitcnt lgkmcnt(0)":::"memory");SBAR();
    #define PK(k) (bf16x8){lo[k][0],lo[k][1],lo[k][2],lo[k][3],hi[k][0],hi[k][1],hi[k][2],hi[k][3]}
    o[d0]=__builtin_amdgcn_mfma_f32_32x32x16_bf16(pa0,PK(0),o[d0],0,0,0);
    o[d0]=__builtin_amdgcn_mfma_f32_32x32x16_bf16(pa1,PK(1),o[d0],0,0,0);
    o[d0]=__builtin_amdgcn_mfma_f32_32x32x16_bf16(pa2,PK(2),o[d0],0,0,0);
    o[d0]=__builtin_amdgcn_mfma_f32_32x32x16_bf16(pa3,PK(3),o[d0],0,0,0);
    #undef PK
  }
}

#ifndef ATTN_STORE16
#define ATTN_STORE16(p,v) (*(u32x4*)(p)=(v))
#endif
typedef float f32x4v __attribute__((ext_vector_type(4)));
template<int THRL> __device__ __forceinline__ void attn_unit(int b,int h,int qb,unsigned char*ws,char*shm,int tid_in){
  const bf16*Q=(const bf16*)(ws+WS_RQ)+4*BUFE; const bf16*__restrict__ K=Q+BUFE; const bf16*__restrict__ V=Q+2*BUFE; const float*__restrict__ BIAS=(const float*)(ws+WS_BIAS); bf16*O=(bf16*)(ws+WS_MIXED);
  const int tid=tid_in,lane=tid&63,r32=lane&31,hi=lane>>5; const int wid=__builtin_amdgcn_readfirstlane(tid>>6);
  const long rowbase=(long)b*SEQ; const int q0=(qb+1)*QB;
  const bf16*Qw=Q+(rowbase+q0+wid*QBLK)*DM+h*D;
  const bf16*Kh=K+(rowbase+T0*KVBLK)*DM+h*D; const bf16*Vh=V+(rowbase+T0*KVBLK)*DM+h*D;
  int tskip=0;
  int NT=(q0+QB)/KVBLK-T0;
  { const float*ba=BIAS+(long)(b*NHEAD+h)*SEQ; const unsigned*qk=(const unsigned*)(ws+WS_CTL)+CW_QK2+2*(b*NHEAD+h);
    const float thr=2.f*sqrtf(__uint_as_float(qk[0])*__uint_as_float(qk[1]))+40.f; const float bq0=ba[q0];
    const int cand=2*lane; bool ok=false; if(cand>=2&&cand<=NT-4){int pe=T0*KVBLK+cand*KVBLK-1; if(pe<256)pe=143; ok=(bq0-ba[pe])>thr;}
    const unsigned long long mk=__ballot(ok); const int ts=__builtin_amdgcn_readfirstlane(mk?2*(63-__builtin_clzll(mk)):0);
    Kh+=(long)ts*KVBLK*DM; Vh+=(long)ts*KVBLK*DM; NT-=ts; tskip=ts; }
  const unsigned lds0=(unsigned)(uintptr_t)shm;
  float*wsf=(float*)(shm+LDS_WS)+wid*64;
  const bf16*ksrc=Kh+(long)lane*DM+wid*8;
  const bf16*vsrc=Vh+(long)(16*(wid&3)+(lane>>2))*DM+(wid>>2)*32+(lane&3)*8;
  const unsigned kdst=lds0+LDS_K+wid*1024, vdst=lds0+LDS_V+wid*1024;
  #define DMA_K(t,slot) glds16(ksrc+(long)(t)*KVBLK*DM,(unsigned)__builtin_amdgcn_readfirstlane(kdst+(slot)))
  #define DMA_V(t,slot) glds16(vsrc+(long)(t)*KVBLK*DM,(unsigned)__builtin_amdgcn_readfirstlane(vdst+(slot)))
  const int vb0=(int)(lds0+LDS_V)+((lane>>4)&1)*32+(lane&3)*8+(4*hi+((lane&15)>>2))*64;
  const char*Kbase=shm+LDS_K; bf16x8 kf[8];
  const lds_cptr shm3=(lds_cptr)shm; const lds_cptr kp0=shm3+LDS_K+hi*1024+r32*16; const lds_cptr vp0=shm3+LDS_V+((lane>>4)&1)*32+(lane&3)*8+(4*hi+((lane&15)>>2))*64;
  { const float*bsrc=BIAS+(long)(b*NHEAD+h)*SEQ+(T0+tskip)*KVBLK; float*bl=(float*)(shm+LDS_BIAS); const int nb=NT*KVBLK; for(int p=tid;p<nb;p+=NW*64)bl[p]=bsrc[p]; }
  const __attribute__((address_space(3))) float* bl3=(const __attribute__((address_space(3))) float*)((lds_cptr)shm+LDS_BIAS);
  #define BIASLD(C0,C1,t) do{ const __attribute__((address_space(3))) f32x4v* bp_=(const __attribute__((address_space(3))) f32x4v*)(bl3+(t)*KVBLK+4*hi); \
    _Pragma("unroll") for(int g_=0;g_<4;++g_){ const f32x4v x0_=bp_[2*g_],x1_=bp_[8+2*g_]; \
      C0[4*g_]=x0_[0]-mhat;C0[4*g_+1]=x0_[1]-mhat;C0[4*g_+2]=x0_[2]-mhat;C0[4*g_+3]=x0_[3]-mhat; C1[4*g_]=x1_[0]-mhat;C1[4*g_+1]=x1_[1]-mhat;C1[4*g_+2]=x1_[2]-mhat;C1[4*g_+3]=x1_[3]-mhat; } }while(0)
  DMA_K(0,0);DMA_V(0,0);DMA_K(1,SLOTB);
  bf16x8 qr[4];
  #pragma unroll
  for(int d0=0;d0<4;++d0)qr[d0]=*reinterpret_cast<const bf16x8*>(&Qw[(long)r32*DM+d0*16+hi*8]);
  float mhat=0.f,l_reg=0.f;f32x16 o[2];o[0]=f32x16{};o[1]=f32x16{};
  const int qrel=wid*QBLK+r32;
  #define CMASK(P0,P1,t) do{int jb_=(t)-(NT-4); if(jb_>=0)cmask(P0,P1,jb_,qrel,hi);}while(0)
  bool resc=false;
  #define START(P0,P1) do{ const float rm=rowmax(P0,P1); resc=false; \
    { const float dl=rm; mhat=fadd_s(mhat,dl); \
      _Pragma("unroll") for(int r=0;r<16;++r){P0[r]=fsub_s(P0[r],dl);P1[r]=fsub_s(P1[r],dl);} } \
    _Pragma("unroll") for(int r=0;r<16;++r)P0[r]=__builtin_amdgcn_exp2f(P0[r]); }while(0)
  #define RESC() do{ if(resc){ asm volatile("s_waitcnt lgkmcnt(0)":::"memory"); \
      _Pragma("unroll") for(int d_=0;d_<2;++d_) _Pragma("unroll") for(int r=0;r<16;++r)o[d_][r]*=wsf[crow(r,hi)]; } }while(0)
  f32x16 pA0,pA1,pB0,pB1;
  int sl_prev=0,sl_cur=0,sl_next=SLOTB;
  #define ROT() do{sl_prev=sl_cur;sl_cur=sl_next;sl_next=(sl_next==(NSLOT-1)*SLOTB)?0:sl_next+SLOTB;}while(0)
  DMA_K(2,2*SLOTB);
  WAIT_BAR(3);
  BIASLD(pA0,pA1,0);qkt(pA0,pA1,Kbase,qr,pA0,pA1,r32,hi);asm volatile("s_nop 15\n\ts_nop 7":"+v"(pA0),"+v"(pA1));CMASK(pA0,pA1,0);
  START(pA0,pA1);
  _Pragma("unroll") for(int r=0;r<16;++r)pA1[r]=__builtin_amdgcn_exp2f(pA1[r]);
  WAIT_BAR(0);
  DMA_K(3,0);DMA_V(1,SLOTB);
  ROT();
  kload8(kf,kp0+sl_cur);
  WAIT_BAR(2);
  s16x4 vlo[8],vhi[8]; u32x4 pw0,pw1,pw2,pw3;
  #define PKW(P,B) cvtpk_s(P[B],P[B+1])
  #define PAF(k) __builtin_bit_cast(bf16x8,pw##k)
  #define VFR(i) (bf16x8){vlo[i][0],vlo[i][1],vlo[i][2],vlo[i][3],vhi[i][0],vhi[i][1],vhi[i][2],vhi[i][3]}
  #define PIN(x) asm volatile("":"+v"(x))
  #define MX3(a,b,c) __builtin_fmaxf(__builtin_fmaxf((a),(b)),(c))
  #define GAPA(MF,A0,A1,A2,A3,W0,W1,PW) do{ MF; sacc+=A0; sacc+=A1; sacc+=A2; sacc+=A3; PIN(sacc); W0; W1; PIN(PW); SBAR(); }while(0)
  #define EX(v) __builtin_amdgcn_exp2f(v)
  #define GAPB(MF,X,B) do{ MF; X[B]=EX(X[B]); X[B+1]=EX(X[B+1]); X[B+2]=EX(X[B+2]); X[B+3]=EX(X[B+3]); PIN(X); SBAR(); }while(0)
  #define VRD(i) do{ vlo[i]=vtr(vp_+(((i)>>2)*4096+((i)&3)*1024)); vhi[i]=vtr(vp_+(((i)>>2)*4096+((i)&3)*1024+512)); }while(0)
  #define KRD(G,j) do{ if(G){ kload2(kf,kp0+sl_next,j); SBAR(); } }while(0)
  #define STEP(C0,C1,P0,P1,t,GK,GV,GL) do{ BIASLD(C0,C1,t); SBAR(); \
    const lds_cptr vp_=vp0+sl_prev; \
    VRD(0); SBAR(); float sacc=(P0[0]+P0[1]); \
    GAPA(C0=__builtin_amdgcn_mfma_f32_32x32x16_bf16(kf[0],qr[0],C0,0,0,0), P0[2],P0[3],P0[4],P0[5],     pw0[0]=PKW(P0,0), pw0[1]=PKW(P0,2), pw0); \
    VRD(4); SBAR(); GAPA(C1=__builtin_amdgcn_mfma_f32_32x32x16_bf16(kf[1],qr[0],C1,0,0,0), P0[6],P0[7],P0[8],P0[9],     pw0[2]=PKW(P0,4), pw0[3]=PKW(P0,6), pw0); \
    VRD(1); SBAR(); GAPA(C0=__builtin_amdgcn_mfma_f32_32x32x16_bf16(kf[2],qr[1],C0,0,0,0),   P0[10],P0[11],P0[12],P0[13], pw1[0]=PKW(P0,8), pw1[1]=PKW(P0,10), pw1); \
    VRD(5); SBAR(); GAPA(C1=__builtin_amdgcn_mfma_f32_32x32x16_bf16(kf[3],qr[1],C1,0,0,0),   P0[14],P0[15],P1[0],P1[1],   pw1[2]=PKW(P0,12),pw1[3]=PKW(P0,14), pw1); \
    VRD(2); SBAR(); GAPA(C0=__builtin_amdgcn_mfma_f32_32x32x16_bf16(kf[4],qr[2],C0,0,0,0),   P1[2],P1[3],P1[4],P1[5],     pw2[0]=PKW(P1,0), pw2[1]=PKW(P1,2), pw2); \
    VRD(6); SBAR(); GAPA(C1=__builtin_amdgcn_mfma_f32_32x32x16_bf16(kf[5],qr[2],C1,0,0,0),   P1[6],P1[7],P1[8],P1[9],     pw2[2]=PKW(P1,4), pw2[3]=PKW(P1,6), pw2); \
    VRD(3); SBAR(); GAPA(C0=__builtin_amdgcn_mfma_f32_32x32x16_bf16(kf[6],qr[3],C0,0,0,0),   P1[10],P1[11],P1[12],P1[13], pw3[0]=PKW(P1,8), pw3[1]=PKW(P1,10), pw3); \
    VRD(7); SBAR(); GAPA(C1=__builtin_amdgcn_mfma_f32_32x32x16_bf16(kf[7],qr[3],C1,0,0,0),   P1[14],P1[15],0.f,0.f,       pw3[2]=PKW(P1,12),pw3[3]=PKW(P1,14), pw3); \
    l_reg+=sacc; \
    if(GK){DMA_K((t)+3,sl_cur);} if(GV){DMA_V((t)+1,sl_next);} \
    CMASK(C0,C1,t); \
    { float a=MX3(C0[0],C0[1],C1[0]),b=MX3(C0[2],C0[3],C1[1]); a=MX3(a,C1[2],C1[3]); \
      _Pragma("unroll") for(int r=4;r<16;r+=4){a=MX3(a,C0[r],C0[r+1]);b=MX3(b,C0[r+2],C0[r+3]);a=MX3(a,C1[r],C1[r+1]);b=MX3(b,C1[r+2],C1[r+3]);} \
      float rm=__builtin_fmaxf(a,b); { auto rr=__builtin_amdgcn_permlane32_swap(__float_as_uint(rm),__float_as_uint(rm),false,false); rm=__builtin_fmaxf(__uint_as_float(rr[0]),__uint_as_float(rr[1])); } \
      resc=false; \
      if(__builtin_expect(__any(rm>(float)THRL),0)){ const float dl=__builtin_fmaxf(rm,0.f); mhat+=dl; \
        _Pragma("unroll") for(int r=0;r<16;++r){C0[r]-=dl;C1[r]-=dl;} \
        const float f=__builtin_amdgcn_exp2f(-dl); l_reg*=f; if(hi==0)wsf[r32]=f; resc=true; } } \
    SBAR(); \
    GAPB(o[0]=__builtin_amdgcn_mfma_f32_32x32x16_bf16(PAF(0),VFR(0),o[0],0,0,0), C0,0); \
    GAPB(o[1]=__builtin_amdgcn_mfma_f32_32x32x16_bf16(PAF(0),VFR(4),o[1],0,0,0), C0,4); \
    KRD(GL,0); GAPB(o[0]=__builtin_amdgcn_mfma_f32_32x32x16_bf16(PAF(1),VFR(1),o[0],0,0,0), C0,8); \
    KRD(GL,1); GAPB(o[1]=__builtin_amdgcn_mfma_f32_32x32x16_bf16(PAF(1),VFR(5),o[1],0,0,0), C0,12); \
    KRD(GL,2); GAPB(o[0]=__builtin_amdgcn_mfma_f32_32x32x16_bf16(PAF(2),VFR(2),o[0],0,0,0), C1,0); \
    KRD(GL,3); GAPB(o[1]=__builtin_amdgcn_mfma_f32_32x32x16_bf16(PAF(2),VFR(6),o[1],0,0,0), C1,4); \
    GAPB(o[0]=__builtin_amdgcn_mfma_f32_32x32x16_bf16(PAF(3),VFR(3),o[0],0,0,0), C1,8); \
    GAPB(o[1]=__builtin_amdgcn_mfma_f32_32x32x16_bf16(PAF(3),VFR(7),o[1],0,0,0), C1,12); \
    }while(0)
  int t=1;
  #undef CMASK
  #define CMASK(P0,P1,t) do{}while(0)
  for(;t+5<NT;t+=2){
    STEP(pB0,pB1,pA0,pA1,t,true,true,true);     WAIT_BAR(2); RESC(); ROT();
    STEP(pA0,pA1,pB0,pB1,t+1,true,true,true);   WAIT_BAR(2); RESC(); ROT();
  }
  #undef CMASK
  #define CMASK(P0,P1,t) do{int jb_=(t)-(NT-4); if(jb_>=0)cmask(P0,P1,jb_,qrel,hi);}while(0)
  #define ENDW(tt) do{ if((tt)+3<NT){WAIT_BAR(2);} else if((tt)+2<NT){WAIT_BAR(1);} else {WAIT_BAR(0);} }while(0)
  for(;t+1<NT;t+=2){
    STEP(pB0,pB1,pA0,pA1,t,(t+3<NT),(t+1<NT),(t+1<NT));       ENDW(t);   RESC(); ROT();
    STEP(pA0,pA1,pB0,pB1,t+1,(t+4<NT),(t+2<NT),(t+2<NT));     ENDW(t+1); RESC(); ROT();
  }
  STEP(pB0,pB1,pA0,pA1,NT-1,false,false,false); RESC();
  { float sacc=pB0[0]+pB0[1]; _Pragma("unroll") for(int r=2;r<16;++r)sacc+=pB0[r]; _Pragma("unroll") for(int r=0;r<16;++r)sacc+=pB1[r]; l_reg+=sacc;
    pw0=(u32x4){PKW(pB0,0),PKW(pB0,2),PKW(pB0,4),PKW(pB0,6)};pw1=(u32x4){PKW(pB0,8),PKW(pB0,10),PKW(pB0,12),PKW(pB0,14)};pw2=(u32x4){PKW(pB1,0),PKW(pB1,2),PKW(pB1,4),PKW(pB1,6)};pw3=(u32x4){PKW(pB1,8),PKW(pB1,10),PKW(pB1,12),PKW(pB1,14)};
    SBAR(); pv(o,vb0+sl_cur,PAF(0),PAF(1),PAF(2),PAF(3)); }
  #undef PKW
  #undef PAF
  #undef VFR
  #undef PIN
  #undef MX3
  #undef GAPA
  #undef GAPB
  #undef EX
  #undef VRD
  #undef KRD
  #undef STEP
  #undef ENDW
  {auto rr=__builtin_amdgcn_permlane32_swap(__float_as_uint(l_reg),__float_as_uint(l_reg),false,false);l_reg=__uint_as_float(rr[0])+__uint_as_float(rr[1]);}
  if(hi==0)wsf[32+r32]=l_reg;asm volatile("s_waitcnt lgkmcnt(0)":::"memory");
  float rli[16];
  #pragma unroll
  for(int r=0;r<16;++r)rli[r]=__builtin_amdgcn_rcpf(wsf[32+crow(r,hi)]);
  bf16*Ow=O+((long)b*XROWS+qb*QB+wid*QBLK)*OPITCH+OCOL0+h*D;
  { bf16*stg=(bf16*)(shm+LDS_OST)+wid*2048;
    #pragma unroll
    for(int r=0;r<16;++r){const int orow=crow(r,hi);
      #pragma unroll
      for(int d0=0;d0<2;++d0)stg[orow*64+d0*32+r32]=__float2bfloat16(o[d0][r]*rli[r]);}
    asm volatile("s_waitcnt lgkmcnt(0)":::"memory");
    #pragma unroll
    for(int i=0;i<4;++i){const int row=i*8+(lane>>3),ch=lane&7; const u32x4 v=*(const u32x4*)(stg+row*64+ch*8); ATTN_STORE16(Ow+(long)row*OPITCH+ch*8,v);} }
  asm volatile("s_waitcnt lgkmcnt(0)\n\ts_barrier":::"memory");
  #undef DMA_K
  #undef DMA_V
  #undef CMASK
  #undef BIASLD
  #undef START
  #undef RESC
  #undef ROT
}
constexpr int ATTN_LDS_BYTES=LDS_BYTES;
struct AttnTensors { const bf16* Q; const bf16* K; const bf16* V; const float* BIAS; bf16* O; };
struct AttnUnit { int bh; int qb; };
struct StaticOrder {
  int vcu, grid;
  __device__ __forceinline__ explicit StaticOrder(int grid_,int block):vcu((grid_%8==0)?(block%8)*(grid_/8)+block/8:block),grid(grid_){}
  __device__ __forceinline__ bool next(int i,AttnUnit&u)const{
    if(grid==256){ if(i>=4)return false; const int s=vcu&3; u.bh=vcu>>2; u.qb=(i==0)?15-s:(i==1)?8+s:(i==2)?7-s:s; return true; }
    const int L=i*grid+vcu; if(L>=BATCH*NHEAD*16)return false; u.bh=L>>4; u.qb=15-(L&15); return true; }
  __device__ __forceinline__ void a_ready(const AttnUnit&)const{}
  __device__ __forceinline__ void done(const AttnUnit&)const{}
};
template<class Sched,int THRL=8> __device__ __forceinline__ void attn_phase(char*lds,const AttnTensors&T,const Sched&S){
  AttnUnit u;
  for(int i=0;S.next(i,u);++i){ S.a_ready(u); attn_unit<THRL>(u.bh/NHEAD,u.bh%NHEAD,u.qb,(unsigned char*)T.O,lds,(int)threadIdx.x);    S.done(u); }
}
#undef SBAR
#undef WAIT_BAR
}


namespace ret_body {
typedef __attribute__((address_space(3))) const char* lds_cptr;
using bf16x8 = __attribute__((ext_vector_type(8))) short;
using s16x4 = __attribute__((ext_vector_type(4))) short;
using f32x16 = __attribute__((ext_vector_type(16))) float;
using u32x4 = __attribute__((ext_vector_type(4))) unsigned;
using u32x2 = __attribute__((ext_vector_type(2))) unsigned;
typedef short v4i16_t __attribute__((ext_vector_type(4)));
#define RLAS __attribute__((address_space(3)))
constexpr int TQ = 0, TK = 32768, TV = 65536, TS = 98304;
__device__ __forceinline__ unsigned off_b(unsigned row, unsigned ch) { return 256u * row + 16u * (ch ^ (((row & 3u) << 2) | ((row >> 2) & 3u))); }
__device__ __forceinline__ int crow(int r, int hi) { return (r & 3) + 8 * (r >> 2) + 4 * hi; }
__device__ __forceinline__ bf16x8 ldrow(lds_cptr tile, unsigned row, unsigned ch) { return *(const RLAS bf16x8*)(tile + off_b(row, ch)); }
__device__ __forceinline__ s16x4 ldtr(lds_cptr p) { return __builtin_bit_cast(s16x4, __builtin_amdgcn_ds_read_tr16_b64_v4i16((RLAS v4i16_t*)p)); }
__device__ __forceinline__ bf16x8 trfrag_nat(lds_cptr tile, unsigned lane, unsigned c, unsigned row0) {
    const unsigned h = lane >> 5, blk = (lane >> 4) & 1, q = (lane & 15) >> 2, p = lane & 3, ch = 4 * c + 2 * blk + (p >> 1), ob = 8 * (p & 1);
    const s16x4 lo = ldtr(tile + off_b(row0 + 8 * h + q, ch) + ob), hi = ldtr(tile + off_b(row0 + 8 * h + 4 + q, ch) + ob);
    return (bf16x8){lo[0], lo[1], lo[2], lo[3], hi[0], hi[1], hi[2], hi[3]};
}
__device__ __forceinline__ bf16x8 trfrag_acc(lds_cptr tile, unsigned lane, unsigned c, unsigned row0) {
    const unsigned h = lane >> 5, blk = (lane >> 4) & 1, q = (lane & 15) >> 2, p = lane & 3, ch = 4 * c + 2 * blk + (p >> 1), ob = 8 * (p & 1);
    const s16x4 lo = ldtr(tile + off_b(row0 + 4 * h + q, ch) + ob), hi = ldtr(tile + off_b(row0 + 8 + 4 * h + q, ch) + ob);
    return (bf16x8){lo[0], lo[1], lo[2], lo[3], hi[0], hi[1], hi[2], hi[3]};
}
typedef float f32x2_t __attribute__((ext_vector_type(2))); typedef __bf16 bf16x2_t __attribute__((ext_vector_type(2)));
__device__ __forceinline__ unsigned cvtpk(float lo, float hi) { f32x2_t v = {lo, hi}; bf16x2_t b = __builtin_convertvector(v, bf16x2_t); return __builtin_bit_cast(unsigned, b); }
__device__ __forceinline__ float bflo(unsigned u) { return __uint_as_float(u << 16); }
__device__ __forceinline__ float bfhi(unsigned u) { return __uint_as_float(u & 0xffff0000u); }
#define RMFMA(a, b, c) __builtin_amdgcn_mfma_f32_32x32x16_bf16(a, b, c, 0, 0, 0)

__device__ __forceinline__ void ret_unit(int b, int h, unsigned char* ws, char* shm, int tid_in) {
    const unsigned short* __restrict__ RQ = (const unsigned short*)(ws + WS_RQ); const unsigned short* __restrict__ RK = RQ + BUFE; const unsigned short* __restrict__ RV = RQ + 2 * BUFE; const unsigned short* __restrict__ RG = RQ + 3 * BUFE;
    unsigned short* MIXED = (unsigned short*)(ws + WS_MIXED); float* xch = (float*)(shm + 131072 + 1024);
    int tid = tid_in; const int wid = __builtin_amdgcn_readfirstlane(tid >> 6); const int ib = wid >> 1, ep = wid & 1;
    const lds_cptr s3 = (lds_cptr)shm; const lds_cptr Qt = s3 + TQ, Kt = s3 + TK, Vt = s3 + TV, St = s3 + TS;
    RLAS char* w3 = (RLAS char*)shm;
    const float lg = log2f(1.f - exp2f(-5.f - (float)h));
    const float g128 = exp2f(128.f * lg);
    f32x16 st0 = {}, st1 = {};
    const size_t rowbase = (size_t)b * LT;
    for (int i = tid; i < 2048; i += 512) *(RLAS u32x4*)(w3 + TS + 16 * i) = (u32x4){0u, 0u, 0u, 0u};
    for (int c = 1; c <= 33; ++c) {
        asm volatile("" : "+v"(tid));
        const int lane = tid & 63, r32 = lane & 31, hi = lane >> 5;
        const float xi = __builtin_amdgcn_exp2f((float)(32 * ib + r32 + 1) * lg);
#pragma unroll
        for (int i = 0; i < 4; ++i) {
            const int n = tid + 512 * i, row = n >> 4, ch = n & 15; const size_t go = (rowbase + 128 * c + row) * 512 + h * 128 + 8 * ch;
            u32x4 q = *(const u32x4*)(RQ + go), k = *(const u32x4*)(RK + go), v = *(const u32x4*)(RV + go);
            if (c == 1 && row < 112) { k = (u32x4){0u, 0u, 0u, 0u}; v = k; q = k; }
            const unsigned o = off_b(row, ch);
            *(RLAS u32x4*)(w3 + TQ + o) = q; *(RLAS u32x4*)(w3 + TK + o) = k; *(RLAS u32x4*)(w3 + TV + o) = v;
        }
        __syncthreads();
        bf16x8 qf[8];
#pragma unroll
        for (int s = 0; s < 8; ++s) qf[s] = ldrow(Qt, 32 * ib + r32, 2 * s + hi);
        f32x16 o0 = {}, o1 = {};
        if (c > 1) {
#pragma unroll
            for (int s = 0; s < 8; ++s) { const bf16x8 a0 = ldrow(St, 64 * ep + r32, 2 * s + hi), a1 = ldrow(St, 64 * ep + 32 + r32, 2 * s + hi); o0 = RMFMA(a0, qf[s], o0); o1 = RMFMA(a1, qf[s], o1); if (s & 1) __builtin_amdgcn_sched_barrier(0); }
        }
        for (int jb = 0; jb <= ib; ++jb) {
            f32x16 S = {};
#pragma unroll
            for (int s = 0; s < 8; ++s) { const bf16x8 kf = ldrow(Kt, 32 * jb + r32, 2 * s + hi); S = RMFMA(kf, qf[s], S); if ((s & 3) == 3) __builtin_amdgcn_sched_barrier(0); }
#pragma unroll
            for (int r = 0; r < 16; ++r) { float pv = S[r] * __builtin_amdgcn_exp2f(-(float)(32 * jb + crow(r, hi) + 1) * lg); if (jb == ib && crow(r, hi) > r32) pv = 0.f; S[r] = pv; }
            const u32x4 w0 = {cvtpk(S[0], S[1]), cvtpk(S[2], S[3]), cvtpk(S[4], S[5]), cvtpk(S[6], S[7])}, w1 = {cvtpk(S[8], S[9]), cvtpk(S[10], S[11]), cvtpk(S[12], S[13]), cvtpk(S[14], S[15])};
            const bf16x8 p0 = __builtin_bit_cast(bf16x8, w0), p1 = __builtin_bit_cast(bf16x8, w1);
            __builtin_amdgcn_sched_barrier(0);
            { const bf16x8 a0 = trfrag_acc(Vt, lane, 2 * ep, 32 * jb), a1 = trfrag_acc(Vt, lane, 2 * ep, 32 * jb + 16); o0 = RMFMA(a0, p0, o0); o0 = RMFMA(a1, p1, o0); }
            { const bf16x8 a0 = trfrag_acc(Vt, lane, 2 * ep + 1, 32 * jb), a1 = trfrag_acc(Vt, lane, 2 * ep + 1, 32 * jb + 16); o1 = RMFMA(a0, p0, o1); o1 = RMFMA(a1, p1, o1); }
            __builtin_amdgcn_sched_barrier(0);
        }
        float s1 = 0.f, s2 = 0.f;
#pragma unroll
        for (int r = 0; r < 16; ++r) { o0[r] *= xi; o1[r] *= xi; s1 += o0[r] + o1[r]; s2 += o0[r] * o0[r] + o1[r] * o1[r]; }
        s1 += __shfl_xor(s1, 32); s2 += __shfl_xor(s2, 32);
        if (hi == 0) { xch[(wid * 32 + r32) * 2] = s1; xch[(wid * 32 + r32) * 2 + 1] = s2; }
#pragma unroll
        for (int r = 0; r < 16; ++r) { st0[r] *= g128; st1[r] *= g128; }
#pragma unroll
        for (int ks = 0; ks < 8; ++ks) {
            const bf16x8 kr = trfrag_nat(Kt, lane, ib, 16 * ks);
            const float zx = (float)(127 - 16 * ks - 8 * hi) * lg;
#define ZF(j) __builtin_amdgcn_exp2f(zx - (float)(j) * lg)
            const u32x4 ku = __builtin_bit_cast(u32x4, kr);
            const u32x4 kz = {cvtpk(bflo(ku[0]) * ZF(0), bfhi(ku[0]) * ZF(1)), cvtpk(bflo(ku[1]) * ZF(2), bfhi(ku[1]) * ZF(3)),
                              cvtpk(bflo(ku[2]) * ZF(4), bfhi(ku[2]) * ZF(5)), cvtpk(bflo(ku[3]) * ZF(6), bfhi(ku[3]) * ZF(7))};
#undef ZF
            const bf16x8 ka = __builtin_bit_cast(bf16x8, kz);
            const bf16x8 v0 = trfrag_nat(Vt, lane, 2 * ep, 16 * ks), v1 = trfrag_nat(Vt, lane, 2 * ep + 1, 16 * ks);
            st0 = RMFMA(ka, v0, st0); st1 = RMFMA(ka, v1, st1);
            __builtin_amdgcn_sched_barrier(0);
        }
        __syncthreads();
        { const float* xp = xch + ((wid ^ 1) * 32 + r32) * 2; s1 += xp[0]; s2 += xp[1]; }
        const float mean = s1 * (1.f / 128.f), var = fmaxf(s2 * (1.f / 128.f) - mean * mean, 0.f), rstd = 1.f / sqrtf(var + LN_EPS);
        if (c >= 2) {
            const size_t grow = (rowbase + 128 * c + 32 * ib + r32) * 512 + h * 128, orow = ((size_t)b * SEQ + 128 * (c - 2) + 32 * ib + r32) * DM + h * 128;
#pragma unroll
            for (int g = 0; g < 4; ++g) {
                { const int e0 = 64 * ep + 8 * g + 4 * hi; const u32x2 gg = *(const u32x2*)(RG + grow + e0);
                  u32x2 w; w[0] = cvtpk((o0[4 * g] - mean) * rstd * bflo(gg[0]), (o0[4 * g + 1] - mean) * rstd * bfhi(gg[0])); w[1] = cvtpk((o0[4 * g + 2] - mean) * rstd * bflo(gg[1]), (o0[4 * g + 3] - mean) * rstd * bfhi(gg[1]));
                  *(u32x2*)(MIXED + orow + e0) = w; }
                { const int e0 = 64 * ep + 32 + 8 * g + 4 * hi; const u32x2 gg = *(const u32x2*)(RG + grow + e0);
                  u32x2 w; w[0] = cvtpk((o1[4 * g] - mean) * rstd * bflo(gg[0]), (o1[4 * g + 1] - mean) * rstd * bfhi(gg[0])); w[1] = cvtpk((o1[4 * g + 2] - mean) * rstd * bflo(gg[1]), (o1[4 * g + 3] - mean) * rstd * bfhi(gg[1]));
                  *(u32x2*)(MIXED + orow + e0) = w; }
            }
        }
#pragma unroll
        for (int g = 0; g < 4; ++g) {
            *(RLAS u32x2*)(w3 + TS + off_b(64 * ep + r32, 4 * ib + g) + 8 * hi) = (u32x2){cvtpk(st0[4 * g], st0[4 * g + 1]), cvtpk(st0[4 * g + 2], st0[4 * g + 3])};
            *(RLAS u32x2*)(w3 + TS + off_b(64 * ep + 32 + r32, 4 * ib + g) + 8 * hi) = (u32x2){cvtpk(st1[4 * g], st1[4 * g + 1]), cvtpk(st1[4 * g + 2], st1[4 * g + 3])};
        }
    }
    __syncthreads();
}

__device__ __forceinline__ void ret_kv_unit(int bh, int c, unsigned char* ws, float* KV, char* shm, int tid_in) {
    const unsigned short* __restrict__ RK = (const unsigned short*)(ws + WS_RQ) + BUFE; const unsigned short* __restrict__ RV = RK + BUFE;
    int tid = tid_in; asm volatile("" : "+v"(tid));
    const int lane = tid & 63, r32 = lane & 31, hi = lane >> 5; const int wid = __builtin_amdgcn_readfirstlane(tid >> 6); const int ib = wid >> 1, ep = wid & 1;
    const int b = bh >> 2, h = bh & 3;
    const lds_cptr s3 = (lds_cptr)shm; const lds_cptr Kt = s3 + TK, Vt = s3 + TV;
    RLAS char* w3 = (RLAS char*)shm;
    const float lg = log2f(1.f - exp2f(-5.f - (float)h));
    const size_t rowbase = (size_t)b * LT;
#pragma unroll
    for (int i = 0; i < 4; ++i) {
        const int n = tid + 512 * i, row = n >> 4, ch = n & 15; const size_t go = (rowbase + 128 * c + row) * 512 + h * 128 + 8 * ch;
        u32x4 k = *(const u32x4*)(RK + go), v = *(const u32x4*)(RV + go);
        if (c == 1 && row < 112) { k = (u32x4){0u, 0u, 0u, 0u}; v = k; }
        const unsigned o = off_b(row, ch);
        *(RLAS u32x4*)(w3 + TK + o) = k; *(RLAS u32x4*)(w3 + TV + o) = v;
    }
    __syncthreads();
    f32x16 st0 = {}, st1 = {};
#pragma unroll
    for (int ks = 0; ks < 8; ++ks) {
        const bf16x8 kr = trfrag_nat(Kt, lane, ib, 16 * ks);
        const float zx = (float)(127 - 16 * ks - 8 * hi) * lg;
#define ZF(j) __builtin_amdgcn_exp2f(zx - (float)(j) * lg)
        const u32x4 ku = __builtin_bit_cast(u32x4, kr);
        const u32x4 kz = {cvtpk(bflo(ku[0]) * ZF(0), bfhi(ku[0]) * ZF(1)), cvtpk(bflo(ku[1]) * ZF(2), bfhi(ku[1]) * ZF(3)),
                          cvtpk(bflo(ku[2]) * ZF(4), bfhi(ku[2]) * ZF(5)), cvtpk(bflo(ku[3]) * ZF(6), bfhi(ku[3]) * ZF(7))};
#undef ZF
        const bf16x8 ka = __builtin_bit_cast(bf16x8, kz);
        const bf16x8 v0 = trfrag_nat(Vt, lane, 2 * ep, 16 * ks), v1 = trfrag_nat(Vt, lane, 2 * ep + 1, 16 * ks);
        st0 = RMFMA(ka, v0, st0); st1 = RMFMA(ka, v1, st1);
        __builtin_amdgcn_sched_barrier(0);
    }
    float* dst = KV + ((size_t)(bh * 33 + c) << 14);
    typedef float f32x4s __attribute__((ext_vector_type(4)));
#pragma unroll
    for (int g = 0; g < 4; ++g) {
        *(f32x4s*)(dst + (64 * ep + r32) * 128 + 32 * ib + 8 * g + 4 * hi) = (f32x4s){st0[4 * g], st0[4 * g + 1], st0[4 * g + 2], st0[4 * g + 3]};
        *(f32x4s*)(dst + (64 * ep + 32 + r32) * 128 + 32 * ib + 8 * g + 4 * hi) = (f32x4s){st1[4 * g], st1[4 * g + 1], st1[4 * g + 2], st1[4 * g + 3]};
    }
    __syncthreads();
}
__device__ __forceinline__ void ret_scan(const float* KV, unsigned short* PREV, int gtid, int nthreads) {
    typedef float f32x4s __attribute__((ext_vector_type(4)));
    for (int grp = gtid; grp < 32 * 4096; grp += nthreads) {
        const int bh = grp >> 12, idx4 = (grp & 4095) * 4, h = bh & 3;
        const float g128 = exp2f(128.f * log2f(1.f - exp2f(-5.f - (float)h)));
        f32x4s sacc = {0.f, 0.f, 0.f, 0.f};
#pragma unroll 4
        for (int c = 1; c <= 32; ++c) {
            const f32x4s kv = *(const f32x4s*)(KV + ((size_t)(bh * 33 + c) << 14) + idx4);
            sacc = sacc * g128 + kv;
            *(u32x2*)(PREV + ((size_t)(bh * 33 + c + 1) << 14) + idx4) = (u32x2){cvtpk(sacc[0], sacc[1]), cvtpk(sacc[2], sacc[3])};
        }
    }
}
__device__ __forceinline__ void ret_out_unit(int bh, int c, unsigned char* ws, const unsigned short* PREV, char* shm, int tid_in) {
    const unsigned short* __restrict__ RQ = (const unsigned short*)(ws + WS_RQ); const unsigned short* __restrict__ RK = RQ + BUFE; const unsigned short* __restrict__ RV = RQ + 2 * BUFE; const unsigned short* __restrict__ RG = RQ + 3 * BUFE;
    unsigned short* MIXED = (unsigned short*)(ws + WS_MIXED); float* xch = (float*)(shm + 131072 + 1024);
    int tid = tid_in; asm volatile("" : "+v"(tid));
    const int lane = tid & 63, r32 = lane & 31, hi = lane >> 5; const int wid = __builtin_amdgcn_readfirstlane(tid >> 6); const int ib = wid >> 1, ep = wid & 1;
    const int b = bh >> 2, h = bh & 3;
    const lds_cptr s3 = (lds_cptr)shm; const lds_cptr Qt = s3 + TQ, Kt = s3 + TK, Vt = s3 + TV, St = s3 + TS;
    RLAS char* w3 = (RLAS char*)shm;
    const float lg = log2f(1.f - exp2f(-5.f - (float)h));
    const size_t rowbase = (size_t)b * LT;
    const unsigned short* pv_ = PREV + ((size_t)(bh * 33 + c) << 14);
#pragma unroll
    for (int i = 0; i < 4; ++i) {
        const int n = tid + 512 * i, row = n >> 4, ch = n & 15; const size_t go = (rowbase + 128 * c + row) * 512 + h * 128 + 8 * ch;
        const u32x4 q = *(const u32x4*)(RQ + go), k = *(const u32x4*)(RK + go), v = *(const u32x4*)(RV + go), p = *(const u32x4*)(pv_ + row * 128 + 8 * ch);
        const unsigned o = off_b(row, ch);
        *(RLAS u32x4*)(w3 + TQ + o) = q; *(RLAS u32x4*)(w3 + TK + o) = k; *(RLAS u32x4*)(w3 + TV + o) = v; *(RLAS u32x4*)(w3 + TS + o) = p;
    }
    __syncthreads();
    const float xi = __builtin_amdgcn_exp2f((float)(32 * ib + r32 + 1) * lg);
    bf16x8 qf[8];
#pragma unroll
    for (int s = 0; s < 8; ++s) qf[s] = ldrow(Qt, 32 * ib + r32, 2 * s + hi);
    f32x16 o0 = {}, o1 = {};
#pragma unroll
    for (int s = 0; s < 8; ++s) { const bf16x8 a0 = ldrow(St, 64 * ep + r32, 2 * s + hi), a1 = ldrow(St, 64 * ep + 32 + r32, 2 * s + hi); o0 = RMFMA(a0, qf[s], o0); o1 = RMFMA(a1, qf[s], o1); if (s & 1) __builtin_amdgcn_sched_barrier(0); }
    for (int jb = 0; jb <= ib; ++jb) {
        f32x16 S = {};
#pragma unroll
        for (int s = 0; s < 8; ++s) { const bf16x8 kf = ldrow(Kt, 32 * jb + r32, 2 * s + hi); S = RMFMA(kf, qf[s], S); if ((s & 3) == 3) __builtin_amdgcn_sched_barrier(0); }
#pragma unroll
        for (int r = 0; r < 16; ++r) { float pv = S[r] * __builtin_amdgcn_exp2f(-(float)(32 * jb + crow(r, hi) + 1) * lg); if (jb == ib && crow(r, hi) > r32) pv = 0.f; S[r] = pv; }
        const u32x4 w0 = {cvtpk(S[0], S[1]), cvtpk(S[2], S[3]), cvtpk(S[4], S[5]), cvtpk(S[6], S[7])}, w1 = {cvtpk(S[8], S[9]), cvtpk(S[10], S[11]), cvtpk(S[12], S[13]), cvtpk(S[14], S[15])};
        const bf16x8 p0 = __builtin_bit_cast(bf16x8, w0), p1 = __builtin_bit_cast(bf16x8, w1);
        __builtin_amdgcn_sched_barrier(0);
        { const bf16x8 a0 = trfrag_acc(Vt, lane, 2 * ep, 32 * jb), a1 = trfrag_acc(Vt, lane, 2 * ep, 32 * jb + 16); o0 = RMFMA(a0, p0, o0); o0 = RMFMA(a1, p1, o0); }
        { const bf16x8 a0 = trfrag_acc(Vt, lane, 2 * ep + 1, 32 * jb), a1 = trfrag_acc(Vt, lane, 2 * ep + 1, 32 * jb + 16); o1 = RMFMA(a0, p0, o1); o1 = RMFMA(a1, p1, o1); }
        __builtin_amdgcn_sched_barrier(0);
    }
    float s1 = 0.f, s2 = 0.f;
#pragma unroll
    for (int r = 0; r < 16; ++r) { o0[r] *= xi; o1[r] *= xi; s1 += o0[r] + o1[r]; s2 += o0[r] * o0[r] + o1[r] * o1[r]; }
    s1 += __shfl_xor(s1, 32); s2 += __shfl_xor(s2, 32);
    if (hi == 0) { xch[(wid * 32 + r32) * 2] = s1; xch[(wid * 32 + r32) * 2 + 1] = s2; }
    __syncthreads();
    { const float* xp = xch + ((wid ^ 1) * 32 + r32) * 2; s1 += xp[0]; s2 += xp[1]; }
    const float mean = s1 * (1.f / 128.f), var = fmaxf(s2 * (1.f / 128.f) - mean * mean, 0.f), rstd = 1.f / sqrtf(var + LN_EPS);
    const size_t grow = (rowbase + 128 * c + 32 * ib + r32) * 512 + h * 128, orow = ((size_t)b * SEQ + 128 * (c - 2) + 32 * ib + r32) * DM + h * 128;
#pragma unroll
    for (int g = 0; g < 4; ++g) {
        { const int e0 = 64 * ep + 8 * g + 4 * hi; const u32x2 gg = *(const u32x2*)(RG + grow + e0);
          u32x2 w; w[0] = cvtpk((o0[4 * g] - mean) * rstd * bflo(gg[0]), (o0[4 * g + 1] - mean) * rstd * bfhi(gg[0])); w[1] = cvtpk((o0[4 * g + 2] - mean) * rstd * bflo(gg[1]), (o0[4 * g + 3] - mean) * rstd * bfhi(gg[1]));
          *(u32x2*)(MIXED + orow + e0) = w; }
        { const int e0 = 64 * ep + 32 + 8 * g + 4 * hi; const u32x2 gg = *(const u32x2*)(RG + grow + e0);
          u32x2 w; w[0] = cvtpk((o1[4 * g] - mean) * rstd * bflo(gg[0]), (o1[4 * g + 1] - mean) * rstd * bfhi(gg[0])); w[1] = cvtpk((o1[4 * g + 2] - mean) * rstd * bflo(gg[1]), (o1[4 * g + 3] - mean) * rstd * bfhi(gg[1]));
          *(u32x2*)(MIXED + orow + e0) = w; }
    }
    __syncthreads();
}
#undef RLAS
#undef RMFMA
}

constexpr int NWAVES = 8;
constexpr int RING_OFF = 0, RING_BYTES = 131072;
constexpr int LDSCTL_OFF = RING_BYTES, MISC_OFF = LDSCTL_OFF + 320;
constexpr int LDS_BYTES = 147456;
constexpr int CW_BAR = 4096;
#define GAS __attribute__((address_space(1)))
#define LAS __attribute__((address_space(3)))
typedef unsigned short bf16;
typedef unsigned v4u __attribute__((ext_vector_type(4)));
typedef float f32x4 __attribute__((ext_vector_type(4)));
typedef short bf16x8 __attribute__((ext_vector_type(8)));
typedef GAS unsigned gu32;
typedef GAS unsigned long long gu64;
#define RLX_AGENT __ATOMIC_RELAXED, __HIP_MEMORY_SCOPE_AGENT
#define LDS_WAIT() asm volatile("s_waitcnt lgkmcnt(0)" ::: "memory")
#define VM_WAIT() asm volatile("s_waitcnt vmcnt(0)" ::: "memory")
__device__ __forceinline__ unsigned long long rt() { return __builtin_amdgcn_s_memrealtime(); }
__device__ __forceinline__ unsigned pk2(float lo, float hi) { return f2bf(lo) | (f2bf(hi) << 16); }

#define XB_TMO      128
#define XB_XCNT(j)  (256  + 64 * (j))
#define XB_XSUB(j)  (1280 + 64 * (j))
#define XB_XGEN(j)  (2304 + 64 * (j))
#define XB_TOP      3328
#define XB_TOPGEN   3392
#define XCD_BAR_WORDS 3456
#define XB_SPIN_CAP (1u << 18)

__device__ __forceinline__ unsigned xb_ld(unsigned* p)              { return __hip_atomic_load(p, __ATOMIC_RELAXED, __HIP_MEMORY_SCOPE_AGENT); }
__device__ __forceinline__ unsigned xb_add(unsigned* p, unsigned v) { return __hip_atomic_fetch_add(p, v, __ATOMIC_RELAXED, __HIP_MEMORY_SCOPE_AGENT); }
__device__ __forceinline__ unsigned xb_xcc_id() { return (unsigned)__builtin_amdgcn_s_getreg((3 << 11) | 20) & 0xFu; }
#define XB_SPIN(cond, bar) do { unsigned _sp = 0; while (cond) { __builtin_amdgcn_s_sleep(1); \
    if ((++_sp & 255u) == 0u) { if (xb_ld(&(bar)[XB_TMO])) break; if (_sp > XB_SPIN_CAP) { atomicAdd(&(bar)[XB_TMO], 1u); break; } } } } while (0)

struct XcdBarrier {
    unsigned* bar; unsigned x;
    volatile LAS unsigned* st;
};

__device__ __forceinline__ XcdBarrier xcd_barrier_post(unsigned* bar, volatile LAS unsigned* st) {
    XcdBarrier b; b.bar = bar; b.x = xb_xcc_id(); b.st = st;
    if (threadIdx.x == 0) (void)xb_add(&bar[XB_XCNT(b.x)], 1u);
    return b;
}
__device__ __forceinline__ void xcd_barrier_complete(unsigned* bar, unsigned x, unsigned& nloc, unsigned& nx) {
    const unsigned G = gridDim.x * gridDim.y * gridDim.z;
    unsigned sum, cnt, mine, sp = 0u;
    for (;;) {
        sum = 0u; cnt = 0u; mine = 0u;
#pragma unroll
        for (unsigned j = 0; j < 16; ++j) { const unsigned c = xb_ld(&bar[XB_XCNT(j)]); sum += c; cnt += (c > 0u) ? 1u : 0u; mine = (j == x) ? c : mine; }
        if (sum == G) break;
        __builtin_amdgcn_s_sleep(1);
        if ((++sp & 255u) == 0u) { if (xb_ld(&bar[XB_TMO])) break; if (sp > XB_SPIN_CAP) { atomicAdd(&bar[XB_TMO], 1u); break; } }
    }
    nloc = mine > 0u ? mine : 1u; nx = cnt > 0u ? cnt : 1u;
}

__device__ __forceinline__ void xcd_barrier(const XcdBarrier& b) {
    asm volatile("s_waitcnt vmcnt(0)" ::: "memory");
    __syncthreads();
    if (threadIdx.x == 0) {
        unsigned* bar = b.bar;
        __builtin_amdgcn_s_waitcnt(0);
        unsigned nloc = b.st[0], nx = b.st[1];
        if (nloc == 0u) { xcd_barrier_complete(bar, b.x, nloc, nx); b.st[0] = nloc; b.st[1] = nx; }
        const unsigned old = xb_add(&bar[XB_XSUB(b.x)], 1u);
        const unsigned gen = old / nloc;
        if (old + 1u == (gen + 1u) * nloc) {
            __builtin_amdgcn_fence(__ATOMIC_RELEASE, "agent");
            asm volatile("s_waitcnt vmcnt(0)" ::: "memory");
            const unsigned og = xb_add(&bar[XB_TOP], 1u);
            const unsigned tg = og / nx;
            if (og + 1u == (tg + 1u) * nx) xb_add(&bar[XB_TOPGEN], 1u);
            else XB_SPIN(xb_ld(&bar[XB_TOPGEN]) == tg, bar);
            __builtin_amdgcn_fence(__ATOMIC_ACQUIRE, "agent");
            xb_add(&bar[XB_XGEN(b.x)], 1u);
            asm volatile("s_waitcnt vmcnt(0)" ::: "memory");
        } else {
            XB_SPIN(xb_ld(&bar[XB_XGEN(b.x)]) == gen, bar);
            __builtin_amdgcn_fence(__ATOMIC_ACQUIRE, "agent");
            asm volatile("s_waitcnt vmcnt(0)" ::: "memory");
        }
    }
    __syncthreads();
}

template <class SrcF>
__device__ __forceinline__ void transpose_item(const SrcF& src, int K, bf16* WT, LAS float* scr, int kb, int nb, int lane) {
    const int k0 = 64 * kb, n0 = 32 * nb;
#pragma unroll 8
    for (int i = 0; i < 32; ++i) { const int kk = 2 * i + (lane >> 5); scr[kk * 33 + (lane & 31)] = src(k0 + kk, n0 + (lane & 31)); }
    LDS_WAIT(); asm volatile("" ::: "memory");
    const int c = lane & 7;
#pragma unroll
    for (int j = 0; j < 4; ++j) { const int n = (lane >> 3) + 8 * j; const LAS float* s = scr + (8 * c) * 33 + n;
        v4u o; o.x = pk2(s[0 * 33], s[1 * 33]); o.y = pk2(s[2 * 33], s[3 * 33]); o.z = pk2(s[4 * 33], s[5 * 33]); o.w = pk2(s[6 * 33], s[7 * 33]);
        *(GAS v4u*)(WT + (size_t)(n0 + n) * K + k0 + 8 * c) = o; }
    LDS_WAIT(); asm volatile("" ::: "memory");
}
template <class SrcF>
__device__ __forceinline__ void transpose_item4(const SrcF& src, int K, bf16* WT, LAS float* scr, int kb, int nb, int lane) {
    const int k0 = 64 * kb, n0 = 32 * nb;
    f32x4 v[8];
#pragma unroll
    for (int i = 0; i < 8; ++i) v[i] = src(k0 + 8 * i + (lane >> 3), n0 + 4 * (lane & 7));
#pragma unroll
    for (int i = 0; i < 8; ++i) *(LAS f32x4*)(scr + (8 * i + (lane >> 3)) * 36 + 4 * (lane & 7)) = v[i];
    LDS_WAIT(); asm volatile("" ::: "memory");
    const int c = lane & 7;
#pragma unroll
    for (int j = 0; j < 4; ++j) { const int n = (lane >> 3) + 8 * j; const LAS float* sp = scr + (8 * c) * 36 + n;
        v4u o; o.x = pk2(sp[0 * 36], sp[1 * 36]); o.y = pk2(sp[2 * 36], sp[3 * 36]); o.z = pk2(sp[4 * 36], sp[5 * 36]); o.w = pk2(sp[6 * 36], sp[7 * 36]);
        *(GAS v4u*)(WT + (size_t)(n0 + n) * K + k0 + 8 * c) = o; }
    LDS_WAIT(); asm volatile("" ::: "memory");
}
struct Src4Plain { const float* w; int ld; __device__ __forceinline__ f32x4 operator()(int k, int n) const { return *(const f32x4*)(w + (size_t)k * ld + n); } };
struct Src4GU { const float* wg; const float* wu; __device__ __forceinline__ f32x4 operator()(int k, int n) const { const long long d = (long long)(wu - wg); return *(const f32x4*)(wg + (long long)((n >> 2) & 1) * d + (long long)k * EFF + 4 * (n >> 3)); } };
struct SrcWin { const float* w; __device__ __forceinline__ float operator()(int k, int n) const { int col = n; if (n < 1024) { const int cp = n & 127; col = (n & ~127) + (cp & 1) * 64 + (cp >> 1); } return w[(size_t)k * INC + col]; } };
struct SrcPlain { const float* w; int ld; __device__ __forceinline__ float operator()(int k, int n) const { return w[(size_t)k * ld + n]; } };
struct SrcGU { const float* wg; const float* wu; __device__ __forceinline__ float operator()(int k, int n) const { const long long d = (long long)(wu - wg); return wg[(long long)(n & 1) * d + (long long)k * EFF + (n >> 1)]; } };

struct Args {
    const float* in[19]; float* out; unsigned char* ws; int ph_lo, ph_hi;
};

__device__ __forceinline__ void ln0_row(const float* src, const float* g, const float* bta, const LAS float* wf, const float* b_forget, bf16* xn_row, float* logf_row, int lane) {
    float4 v[4]; float s = 0.f;
#pragma unroll
    for (int j = 0; j < 4; ++j) { v[j] = ((const float4*)src)[lane + 64 * j]; s += (v[j].x + v[j].y) + (v[j].z + v[j].w); }
    const float mean = wave_sum(s) * (1.f / DM);
    float s2 = 0.f;
#pragma unroll
    for (int j = 0; j < 4; ++j) { v[j].x -= mean; v[j].y -= mean; v[j].z -= mean; v[j].w -= mean; s2 += (v[j].x * v[j].x + v[j].y * v[j].y) + (v[j].z * v[j].z + v[j].w * v[j].w); }
    const float rstd = 1.f / sqrtf(wave_sum(s2) * (1.f / DM) + LN_EPS);
    float f[8];
#pragma unroll
    for (int h = 0; h < 8; ++h) f[h] = 0.f;
#pragma unroll
    for (int j = 0; j < 4; ++j) {
        const float4 gg = ((const float4*)g)[lane + 64 * j], bb = ((const float4*)bta)[lane + 64 * j];
        const float y0 = v[j].x * rstd * gg.x + bb.x, y1 = v[j].y * rstd * gg.y + bb.y, y2 = v[j].z * rstd * gg.z + bb.z, y3 = v[j].w * rstd * gg.w + bb.w;
        uint2 o; o.x = pk2(y0, y1); o.y = pk2(y2, y3);
        ((uint2*)xn_row)[lane + 64 * j] = o;
        const LAS float* wp = wf + 32 * (lane + 64 * j);
#pragma unroll
        for (int h = 0; h < 8; ++h) f[h] += y0 * wp[h] + y1 * wp[8 + h] + y2 * wp[16 + h] + y3 * wp[24 + h];
    }
    float z = 0.f;
#pragma unroll
    for (int h = 0; h < 8; ++h) { const float t = wave_sum(f[h]); if (lane == h) z = t; }
    if (lane < 8) { z += b_forget[lane]; logf_row[lane] = fminf(z, 0.f) - log1pf(expf(-fabsf(z))); }
}

__device__ __forceinline__ void metaproj_item(const Args& a, LAS unsigned char* lds, int item, int tid, int lane, int wave) {
    const int g = item >> 2, qt = item & 3;
    LAS float* xm = (LAS float*)lds;
    LAS float* T = (LAS float*)(lds + 65536);
    const float* meta = a.in[1]; const float* g0 = a.in[2]; const float* b0 = a.in[3]; const float* w_in = a.in[4];
#pragma unroll
    for (int rr = 0; rr < 2; ++rr) {
        const int m = wave * 2 + rr; const float* src = meta + (size_t)m * DM;
        float4 v[4]; float s = 0.f;
#pragma unroll
        for (int j = 0; j < 4; ++j) { v[j] = ((const float4*)src)[lane + 64 * j]; s += (v[j].x + v[j].y) + (v[j].z + v[j].w); }
        const float mean = wave_sum(s) * (1.f / DM);
        float s2 = 0.f;
#pragma unroll
        for (int j = 0; j < 4; ++j) { v[j].x -= mean; v[j].y -= mean; v[j].z -= mean; v[j].w -= mean; s2 += (v[j].x * v[j].x + v[j].y * v[j].y) + (v[j].z * v[j].z + v[j].w * v[j].w); }
        const float rstd = 1.f / sqrtf(wave_sum(s2) * (1.f / DM) + LN_EPS);
#pragma unroll
        for (int j = 0; j < 4; ++j) {
            const float4 gg = ((const float4*)g0)[lane + 64 * j], bb = ((const float4*)b0)[lane + 64 * j]; const int k0 = 4 * (lane + 64 * j);
            xm[(k0 + 0) * 16 + m] = __uint_as_float(f2bf(v[j].x * rstd * gg.x + bb.x) << 16); xm[(k0 + 1) * 16 + m] = __uint_as_float(f2bf(v[j].y * rstd * gg.y + bb.y) << 16);
            xm[(k0 + 2) * 16 + m] = __uint_as_float(f2bf(v[j].z * rstd * gg.z + bb.z) << 16); xm[(k0 + 3) * 16 + m] = __uint_as_float(f2bf(v[j].w * rstd * gg.w + bb.w) << 16);
        }
    }
    __syncthreads();
    const int cb = g * 512 + qt * 128;
    float acc[16][2];
#pragma unroll
    for (int m = 0; m < 16; ++m) { acc[m][0] = 0.f; acc[m][1] = 0.f; }
    const float* wc = w_in + cb + 2 * lane;
#pragma unroll 4
    for (int kk = 0; kk < 128; ++kk) {
        const int k = wave * 128 + kk;
        const float2 w = *(const float2*)(wc + (size_t)k * INC);
        const f32x4 x0 = *(const LAS f32x4*)(xm + k * 16), x1 = *(const LAS f32x4*)(xm + k * 16 + 4), x2 = *(const LAS f32x4*)(xm + k * 16 + 8), x3 = *(const LAS f32x4*)(xm + k * 16 + 12);
#pragma unroll
        for (int q = 0; q < 4; ++q) { acc[q][0] += w.x * x0[q]; acc[q][1] += w.y * x0[q]; acc[4 + q][0] += w.x * x1[q]; acc[4 + q][1] += w.y * x1[q];
                                      acc[8 + q][0] += w.x * x2[q]; acc[8 + q][1] += w.y * x2[q]; acc[12 + q][0] += w.x * x3[q]; acc[12 + q][1] += w.y * x3[q]; }
    }
    for (int r = 0; r < NWAVES; ++r) {
        if (wave == r) {
#pragma unroll
            for (int m = 0; m < 16; ++m) { LAS float* tp = T + m * 128 + 2 * lane; if (r == 0) { tp[0] = acc[m][0]; tp[1] = acc[m][1]; } else { tp[0] += acc[m][0]; tp[1] += acc[m][1]; } }
        }
        __syncthreads();
    }
    bf16* base = (bf16*)(a.ws + WS_RQ) + (size_t)g * BUFE;
    const int m = tid >> 5, t5 = tid & 31;
    if (g < 2) {
        const float sc = (g == 1) ? RK_SCALE : 1.f; unsigned o[2];
#pragma unroll
        for (int jj = 0; jj < 2; ++jj) { const int j = 2 * t5 + jj;
            const double rr = exp2(-(double)j * (13.287712379549449 / 64.0)) * 0.15915494309189535;
            double rv = (double)m * rr; rv -= floor(rv); const float fr = (float)rv, sn = __builtin_amdgcn_sinf(fr), cs = __builtin_amdgcn_cosf(fr);
            const float x1 = T[m * 128 + j], x2 = T[m * 128 + 64 + j];
            o[jj] = pk2((x1 * cs - x2 * sn) * sc, (x2 * cs + x1 * sn) * sc); }
        for (int b = 0; b < NB; ++b) *(uint2*)(base + ((size_t)b * LT + RMETA0 + m) * 512 + qt * 128 + 4 * t5) = make_uint2(o[0], o[1]);
    } else {
        const int pos0 = (g < 4) ? RMETA0 : FMETA0; float v[4];
#pragma unroll
        for (int q = 0; q < 4; ++q) { v[q] = T[m * 128 + 4 * t5 + q]; if (g == 3) v[q] = v[q] / (1.f + __expf(-v[q])); else if (g == 4) v[q] *= C2; }
        const uint2 o = make_uint2(pk2(v[0], v[1]), pk2(v[2], v[3]));
        for (int b = 0; b < NB; ++b) *(uint2*)(base + ((size_t)b * LT + pos0 + m) * 512 + qt * 128 + 4 * t5) = o;
    }
    __syncthreads();
}

__device__ __forceinline__ void unpack8f(const uint4 u, float* d) {
    d[0] = __uint_as_float(u.x << 16); d[1] = __uint_as_float(u.x & 0xffff0000u); d[2] = __uint_as_float(u.y << 16); d[3] = __uint_as_float(u.y & 0xffff0000u);
    d[4] = __uint_as_float(u.z << 16); d[5] = __uint_as_float(u.z & 0xffff0000u); d[6] = __uint_as_float(u.w << 16); d[7] = __uint_as_float(u.w & 0xffff0000u);
}
__device__ __forceinline__ void qk_norms(unsigned char* ws, int gw, int NGW, int lane) {
    const bf16* FQ = (const bf16*)(ws + WS_RQ) + 4 * BUFE; const bf16* FK = FQ + BUFE;
    unsigned* qk = (unsigned*)(ws + WS_CTL) + CW_QK2;
    constexpr int RB = NMETA + SEQ, NR = NB * RB;
    const int rpw = (NR + NGW - 1) / NGW, r0 = gw * rpw, r1 = (r0 + rpw < NR) ? r0 + rpw : NR;
    int curb = -1; float mq = 0.f, mk = 0.f;
    for (int r = r0; r < r1; ++r) {
        const int b = r / RB, t = r - b * RB, pos = t < NMETA ? FMETA0 + t : XPOS0 + t - NMETA;
        if (b != curb) { if (curb >= 0 && (lane & 7) == 0) { atomicMax(qk + 2 * (curb * 8 + (lane >> 3)), __float_as_uint(mq)); atomicMax(qk + 2 * (curb * 8 + (lane >> 3)) + 1, __float_as_uint(mk)); } curb = b; mq = 0.f; mk = 0.f; }
        const size_t o = ((size_t)b * LT + pos) * 512 + lane * 8;
        float a[8], c[8]; unpack8f(*(const uint4*)(FQ + o), a); unpack8f(*(const uint4*)(FK + o), c);
        float sq = 0.f, sk = 0.f;
#pragma unroll
        for (int j = 0; j < 8; ++j) { sq += a[j] * a[j]; sk += c[j] * c[j]; }
        sq += __shfl_xor(sq, 1); sq += __shfl_xor(sq, 2); sq += __shfl_xor(sq, 4); sk += __shfl_xor(sk, 1); sk += __shfl_xor(sk, 2); sk += __shfl_xor(sk, 4);
        mq = fmaxf(mq, sq); mk = fmaxf(mk, sk);
    }
    if (curb >= 0 && (lane & 7) == 0) { atomicMax(qk + 2 * (curb * 8 + (lane >> 3)), __float_as_uint(mq)); atomicMax(qk + 2 * (curb * 8 + (lane >> 3)) + 1, __float_as_uint(mk)); }
}
__device__ __forceinline__ void bias_scan(const float* LOGF, float* BIAS, int bh, int lane) {
    const int b = bh >> 3, h = bh & 7;
    float* out = BIAS + (size_t)bh * LT;
    for (int p = lane; p < XPOS0; p += 64) if (p < FMETA0 || p >= FMETA0 + NMETA) out[p] = -1e30f;
    float carry = 0.f;
    for (int t0 = 0; t0 < NMETA + SEQ; t0 += 64) {
        const int t = t0 + lane; float v = 0.f;
        if (t < NMETA + SEQ) { const int row = t < NMETA ? NX + t : b * SEQ + t - NMETA; v = LOGF[(size_t)row * 8 + h]; }
#pragma unroll
        for (int o = 1; o < 64; o <<= 1) { const float u = __shfl_up(v, o); if (lane >= o) v += u; }
        v += carry;
        if (t < NMETA + SEQ) { const int pos = t < NMETA ? FMETA0 + t : XPOS0 + t - NMETA; out[pos] = -v * LOG2E; }
        carry = __shfl(v, 63);
    }
}
__device__ __forceinline__ void ln_row_f32_to_bf16(const float* src, const float* g, const float* bta, bf16* dst, int lane) {
    float4 v[4]; float s = 0.f;
#pragma unroll
    for (int j = 0; j < 4; ++j) { v[j] = ((const float4*)src)[lane + 64 * j]; s += (v[j].x + v[j].y) + (v[j].z + v[j].w); }
    const float mean = wave_sum(s) * (1.f / DM);
    float s2 = 0.f;
#pragma unroll
    for (int j = 0; j < 4; ++j) { v[j].x -= mean; v[j].y -= mean; v[j].z -= mean; v[j].w -= mean; s2 += (v[j].x * v[j].x + v[j].y * v[j].y) + (v[j].z * v[j].z + v[j].w * v[j].w); }
    const float rstd = 1.f / sqrtf(wave_sum(s2) * (1.f / DM) + LN_EPS);
#pragma unroll
    for (int j = 0; j < 4; ++j) {
        const float4 gg = ((const float4*)g)[lane + 64 * j], bb = ((const float4*)bta)[lane + 64 * j];
        uint2 o; o.x = pk2(v[j].x * rstd * gg.x + bb.x, v[j].y * rstd * gg.y + bb.y); o.y = pk2(v[j].z * rstd * gg.z + bb.z, v[j].w * rstd * gg.w + bb.w);
        ((uint2*)dst)[lane + 64 * j] = o;
    }
}
__device__ __forceinline__ void final_row(const bf16* BASE, const bf16* Y, const int* ASG, const LAS int* ys, const float* g, const float* bta, float* out, int tok, int lane) {
    float v[16];
    { const bf16* src = BASE + (size_t)tok * DM;
#pragma unroll
      for (int j = 0; j < 2; ++j) unpack8f(((const uint4*)src)[lane + 64 * j], v + 8 * j); }
#pragma unroll
    for (int r = 0; r < 6; ++r) {
        const int a = ASG[(size_t)tok * 6 + r]; const int e = a >> 16, rank = a & 0xffff;
        const bf16* src = Y + (size_t)(ys[e] + rank) * DM; float t[8];
#pragma unroll
        for (int j = 0; j < 2; ++j) { unpack8f(((const uint4*)src)[lane + 64 * j], t);
#pragma unroll
            for (int q = 0; q < 8; ++q) v[8 * j + q] += t[q]; }
    }
    float s = 0.f;
#pragma unroll
    for (int q = 0; q < 16; ++q) s += v[q];
    const float mean = wave_sum(s) * (1.f / DM);
    float s2 = 0.f;
#pragma unroll
    for (int q = 0; q < 16; ++q) { v[q] -= mean; s2 += v[q] * v[q]; }
    const float rstd = 1.f / sqrtf(wave_sum(s2) * (1.f / DM) + LN_EPS);
#pragma unroll
    for (int j = 0; j < 2; ++j) {
        const int c0 = (lane + 64 * j) * 8;
        const float4 g0 = *(const float4*)(g + c0), g1 = *(const float4*)(g + c0 + 4), b0 = *(const float4*)(bta + c0), b1 = *(const float4*)(bta + c0 + 4);
        float4 o0, o1;
        o0.x = v[8 * j + 0] * rstd * g0.x + b0.x; o0.y = v[8 * j + 1] * rstd * g0.y + b0.y; o0.z = v[8 * j + 2] * rstd * g0.z + b0.z; o0.w = v[8 * j + 3] * rstd * g0.w + b0.w;
        o1.x = v[8 * j + 4] * rstd * g1.x + b1.x; o1.y = v[8 * j + 5] * rstd * g1.y + b1.y; o1.z = v[8 * j + 6] * rstd * g1.z + b1.z; o1.w = v[8 * j + 7] * rstd * g1.w + b1.w;
        *(float4*)(out + (size_t)tok * DM + c0) = o0; *(float4*)(out + (size_t)tok * DM + c0 + 4) = o1;
    }
}
__global__ void __launch_bounds__(NWAVES * 64, 2) mega(Args args) {
    extern __shared__ __attribute__((aligned(16))) unsigned char lds_raw[];
    LAS unsigned char* lds = (LAS unsigned char*)lds_raw;
    volatile LAS unsigned* MISC = (volatile LAS unsigned*)(lds + MISC_OFF);
    const int tid = threadIdx.x, lane = tid & 63, wave = __builtin_amdgcn_readfirstlane(tid >> 6);
    const int G = gridDim.x; const int bx = blockIdx.x; const int vcu = (G % 8 == 0) ? (bx % 8) * (G / 8) + bx / 8 : bx;
    unsigned char* ws = args.ws;
    gu32* ctl = (gu32*)(ws + WS_CTL);
    for (int u = tid; u < (LDS_BYTES - LDSCTL_OFF) / 4; u += NWAVES * 64) ((LAS unsigned*)(lds + LDSCTL_OFF))[u] = 0u;
    __syncthreads();
    XcdBarrier bar = xcd_barrier_post((unsigned*)(ctl + CW_BAR), MISC + 8);
    const int lo = args.ph_lo, hi = args.ph_hi;
#ifndef PROBE_PHASE
#define PROBE_PHASE -1
#endif
#define REP(k) for (int rep_ = 0; rep_ < ((PROBE_PHASE == (k)) ? 2 : 1); ++rep_)
#define IN(k) (lo <= (k) && (k) < hi)
#define BOTH(k) (IN(k) && IN((k) + 1))
    bf16* XN = (bf16*)(ws + WS_XN); float* LOGF = (float*)(ws + WS_LOGF); float* TAB = (float*)(ws + WS_TAB);
    bf16* WIN_T = (bf16*)(ws + WS_WIN_T); bf16* WOUT_T = (bf16*)(ws + WS_WOUT_T); bf16* WGU_T = (bf16*)(ws + WS_WGU_T); bf16* WSD_T = (bf16*)(ws + WS_WSD_T); bf16* WR_T = (bf16*)(ws + WS_WR_T); bf16* WD_T = (bf16*)(ws + WS_WD_T);

    if (IN(0)) REP(0) {
        for (int it = vcu; it < 28; it += G) metaproj_item(args, lds, it, tid, lane, wave);
        {
            const int gw = vcu * NWAVES + wave, NGW = G * NWAVES;
            LAS float* scr = (LAS float*)(lds + wave * 9216);
            LAS float* wf = (LAS float*)(lds + 98304);
            const float* w_in = args.in[4];
            for (int i = tid; i < 1024 * 8; i += NWAVES * 64) { const int k = i >> 3, h = i & 7; wf[i] = w_in[(size_t)k * INC + 3584 + h]; }
            __syncthreads();
            if (gw == 0) { const double rr = exp2(-(double)lane * (13.287712379549449 / 64.0)) * 0.15915494309189535; const float h = (float)rr; TAB[2 * lane] = h; TAB[2 * lane + 1] = (float)(rr - (double)h); }
            for (int row = gw; row < NX + NMETA; row += NGW) {
                const float* src = row < NX ? args.in[0] + (size_t)row * DM : args.in[1] + (size_t)(row - NX) * DM;
                ln0_row(src, args.in[2], args.in[3], wf, args.in[5], XN + (size_t)row * DM, LOGF + (size_t)row * 8, lane);
            }
            constexpr int I0 = 16 * 112, I1 = 16 * 32, I2 = 16 * 2, I3 = 16 * 16, I4 = 4 * 32, ITOT = I0 + I1 + I2 + I3 + I4;
            for (int it = gw; it < ITOT; it += NGW) {
                int r = it;
                if (r < I0) { transpose_item(SrcWin{w_in}, DM, WIN_T, scr, r / 112, r % 112, lane); continue; } r -= I0;
                if (r < I1) { transpose_item4(Src4Plain{args.in[6], DM}, DM, WOUT_T, scr, r / 32, r % 32, lane); continue; } r -= I1;
                if (r < I2) { transpose_item(SrcPlain{args.in[9], NEXP}, DM, WR_T, scr, r / 2, r % 2, lane); continue; } r -= I2;
                if (r < I3) { transpose_item4(Src4GU{args.in[14], args.in[15]}, DM, WGU_T + (size_t)64 * 512 * DM, scr, r / 16, r % 16, lane); continue; } r -= I3;
                { transpose_item4(Src4Plain{args.in[16], DM}, EFF, WSD_T, scr, r / 32, r % 32, lane); }
            }
        }
        if (BOTH(0)) xcd_barrier(bar);
    }
    if (IN(1)) REP(1) {
        if (vcu < 64 && wave == 0) bias_scan(LOGF, (float*)(ws + WS_BIAS), vcu, lane);
        pg8::Gemm g{(const pg8::bf16_t*)XN, (const pg8::bf16_t*)WIN_T, NX, 3584, DM}; pg8::StaticOrder S; S.init(NX, 3584, G, (int)blockIdx.x);
        pg8::EpiInproj E{(pg8::bf16_t*)(ws + WS_RQ), TAB};
        pg8::gemm_phase<pg8::EpiInproj, pg8::StaticOrder, true, true>(lds + RING_OFF, g, S, E);
        if (BOTH(1)) xcd_barrier(bar);
    }
    if (IN(2)) {
        static_assert(attn_body::ATTN_LDS_BYTES <= RING_BYTES, "attention LDS");
        float* KV = (float*)args.out;
        unsigned short* PREV = (unsigned short*)((unsigned char*)args.out + 66 * MiB);
        for (int uu = vcu; uu < 1024; uu += G) { int tid_o = tid; asm volatile("" : "+v"(tid_o)); ret_body::ret_kv_unit(uu >> 5, 1 + (uu & 31), ws, KV, (char*)lds_raw + RING_OFF, tid_o); }
        xcd_barrier(bar);
        ret_body::ret_scan(KV, PREV, vcu * (NWAVES * 64) + tid, G * NWAVES * 64);
        qk_norms(ws, vcu * NWAVES + wave, G * NWAVES, lane);
        xcd_barrier(bar);
        REP(2) {
        const int qid = bx & 7;
        for (int dq = 0; dq < 8; ++dq) {
            const int q = (qid + dq) & 7;
            for (;;) {
                if (tid == 0) MISC[0] = __hip_atomic_fetch_add(ctl + CW_Q2 + 64 * q + 512 * rep_, 1u, RLX_AGENT);
                __syncthreads();
                const int it = (int)MISC[0];
                __syncthreads();
                if (it >= 640) break;
                int tid_o = tid; asm volatile("" : "+v"(tid_o));
                if (it < 512) {
                    const int grp = it >> 2, sub = it & 3;
                    if (sub == 0) { const int qb = 15 - (grp >> 3), bh = 8 * q + (grp & 7); attn_body::attn_unit<8>(bh >> 3, bh & 7, qb, ws, (char*)lds_raw + RING_OFF, tid_o); }
                    else {
                        LAS float* scr = (LAS float*)(lds + wave * 9216);
                        const int ci = (q * 384 + grp * 3 + (sub - 1)) * 8 + wave;
                        if (ci < 16384) { const int e = ci >> 8, qq = ci & 255; transpose_item4(Src4GU{args.in[11] + (size_t)e * DM * EFF, args.in[12] + (size_t)e * DM * EFF}, DM, WGU_T + (size_t)e * 512 * DM, scr, qq / 16, qq % 16, lane); }
                        else { const int r = ci - 16384, e = r >> 7, qq = r & 127; transpose_item4(Src4Plain{args.in[13] + (size_t)e * EFF * DM, DM}, EFF, WD_T + (size_t)e * DM * EFF, scr, qq / 32, qq % 32, lane); }
                        __syncthreads();
                    }
                } else { const int r = it - 512; ret_body::ret_out_unit(4 * q + (r >> 5), 2 + (r & 31), ws, PREV, (char*)lds_raw + RING_OFF, tid_o); }
            }
        }
        }
        if (BOTH(2)) xcd_barrier(bar);
    }
    if (IN(3)) REP(3) {
        pg8::Gemm g{(const pg8::bf16_t*)(ws + WS_MIXED), (const pg8::bf16_t*)WOUT_T, NX, DM, DM}; pg8::StaticOrder S; S.init(NX, DM, G, (int)blockIdx.x);
        pg8::EpiOutproj E{args.out, (const pg8::bf16_t*)XN};
        pg8::gemm_phase<pg8::EpiOutproj, pg8::StaticOrder, true, true>(lds + RING_OFF, g, S, E);
        if (BOTH(3)) xcd_barrier(bar);
    }
    if (IN(4)) REP(4) {
        const int gw = vcu * NWAVES + wave, NGW = G * NWAVES;
        for (int row = gw; row < NX; row += NGW) ln_row_f32_to_bf16(args.out + (size_t)row * DM, args.in[7], args.in[8], XN + (size_t)row * DM, lane);
        if (BOTH(4)) xcd_barrier(bar);
    }
    int* cnt = (int*)(ws + WS_CTL) + CW_CNT; int* TOKL = (int*)(ws + WS_TOKL); float* GATEL = (float*)(ws + WS_GATEL); int* ASG = (int*)(ws + WS_ASG);
    bf16* HID = (bf16*)args.out;
    if (IN(5)) {
        for (int pm = vcu; pm < 128; pm += G) {
            pg8::Gemm g{(const pg8::bf16_t*)XN, (const pg8::bf16_t*)WR_T, NX, 256, DM}; pg8::SingleUnit S{pm, 0, 1};
            pg8::EpiRouter E{args.in[10], cnt, TOKL, GATEL, ASG};
            pg8::gemm_phase<pg8::EpiRouter, pg8::SingleUnit, false, true>(lds + RING_OFF, g, S, E);
        }
        REP(5) { pg8::Gemm g{(const pg8::bf16_t*)XN, (const pg8::bf16_t*)(WGU_T + (size_t)64 * 512 * DM), NX, 512, DM}; pg8::StaticOrder S; S.init(NX, 512, G, (int)blockIdx.x);
          pg8::EpiGU<false> E{(pg8::bf16_t*)(HID + (size_t)HID_S_ROW0 * EFF), nullptr};
          pg8::gemm_phase<pg8::EpiGU<false>, pg8::StaticOrder, true, true>(lds + RING_OFF, g, S, E); }
        if (BOTH(5)) xcd_barrier(bar);
    }
    LAS int* tabs = (LAS int*)(lds + LDSCTL_OFF + 4096);
    LAS int* ulist = (LAS int*)(lds + LDSCTL_OFF + 8192);
#define BUILD_UNITS(NPN, nunits_out) do { \
        __syncthreads(); \
        if (tid < 64) tabs[3 * 65 + tid] = cnt[tid]; \
        __syncthreads(); \
        if (tid == 0) { int us = 0, hs = 0, ys = 0; for (int e = 0; e < 64; ++e) { const int c = tabs[3 * 65 + e], nt = (c + 255) >> 8; tabs[e] = us; tabs[65 + e] = hs; tabs[130 + e] = ys; us += nt * (NPN); hs += nt << 8; ys += c; } tabs[64] = us; tabs[129] = hs; tabs[194] = ys; } \
        __syncthreads(); \
        if (tid < 32) { const int Lu = tid * G + vcu; int e = -1; if (Lu < tabs[64]) { int lo_ = 0, hi_ = 63; while (lo_ < hi_) { const int mid = (lo_ + hi_ + 1) >> 1; if (tabs[mid] <= Lu) lo_ = mid; else hi_ = mid - 1; } e = lo_; } \
            LAS int* q_ = ulist + 6 * tid; if (e >= 0) { const int loc = Lu - tabs[e], rt = loc / (NPN), pn = loc % (NPN); q_[0] = e; q_[1] = rt; q_[2] = pn; q_[3] = tabs[65 + e] + (rt << 8); q_[4] = tabs[130 + e] + (rt << 8); q_[5] = tabs[3 * 65 + e] - (rt << 8); } else q_[0] = -1; } \
        __syncthreads(); \
        { const int tot_ = tabs[64]; nunits_out = (tot_ > vcu) ? (tot_ - vcu + G - 1) / G : 0; if (nunits_out > 32) nunits_out = 32; } \
    } while (0)
    if (IN(6)) REP(6) {
        int nun; BUILD_UNITS(2, nun);
        pg8::Gemm g{(const pg8::bf16_t*)XN, (const pg8::bf16_t*)WGU_T, NX, 512, DM}; pg8::GroupOrder<true> S{(const LAS int*)ulist, nun, TOKL, 512};
        pg8::EpiGU<true> E{(pg8::bf16_t*)HID, (const LAS int*)ulist};
        pg8::gemm_phase<pg8::EpiGU<true>, pg8::GroupOrder<true>, true, true>(lds + RING_OFF, g, S, E);
        if (BOTH(6)) xcd_barrier(bar);
    }
    if (IN(7)) {
        int nun; BUILD_UNITS(4, nun);
        REP(7) { pg8::Gemm g{(const pg8::bf16_t*)HID, (const pg8::bf16_t*)WD_T, NX, DM, EFF}; pg8::GroupOrder<false> S{(const LAS int*)ulist, nun, TOKL, DM};
          pg8::EpiY E{(pg8::bf16_t*)(ws + WS_Y), GATEL, (const LAS int*)ulist};
          pg8::gemm_phase<pg8::EpiY, pg8::GroupOrder<false>, true, true>(lds + RING_OFF, g, S, E); }
        { pg8::Gemm g{(const pg8::bf16_t*)(HID + (size_t)HID_S_ROW0 * EFF), (const pg8::bf16_t*)WSD_T, NX, DM, EFF}; pg8::StaticOrder S; S.init(NX, DM, G, (int)blockIdx.x);
          pg8::EpiBase E{(pg8::bf16_t*)XN};
          pg8::gemm_phase<pg8::EpiBase, pg8::StaticOrder, true, true>(lds + RING_OFF, g, S, E); }
        if (BOTH(7)) xcd_barrier(bar);
    }
    if (IN(8)) REP(8) {
        __syncthreads();
        if (tid == 0) { int a = 0; for (int e = 0; e < 64; ++e) { tabs[e] = a; a += cnt[e]; } }
        __syncthreads();
        const int gw = vcu * NWAVES + wave, NGW = G * NWAVES;
        for (int tok = gw; tok < NX; tok += NGW) final_row(XN, (const bf16*)(ws + WS_Y), ASG, (const LAS int*)tabs, args.in[17], args.in[18], args.out, tok, lane);
    }
#undef BUILD_UNITS
#undef REP
#undef IN
#undef BOTH
}

extern "C" void kernel_launch(void* const* d_in, const int* in_sizes, int n_in, void* d_out, int out_size, void* d_ws, size_t ws_size, hipStream_t stream) {
    if (n_in != 19 || ws_size < WS_END || out_size != NX * DM) { fprintf(stderr, "kernel_launch: unexpected sizes n_in=%d ws=%zu out=%d\n", n_in, ws_size, out_size); return; }
    static int grid = 0;
    if (grid == 0) {
        int dev = 0, cus = 0, per_cu = 0;
        if (hipGetDevice(&dev) != hipSuccess || hipDeviceGetAttribute(&cus, hipDeviceAttributeMultiprocessorCount, dev) != hipSuccess) { fprintf(stderr, "kernel_launch: device query failed\n"); grid = -1; return; }
        if (hipFuncSetAttribute((const void*)mega, hipFuncAttributeMaxDynamicSharedMemorySize, LDS_BYTES) != hipSuccess) { fprintf(stderr, "kernel_launch: hipFuncSetAttribute failed\n"); grid = -1; return; }
        if (hipOccupancyMaxActiveBlocksPerMultiprocessor(&per_cu, (const void*)mega, NWAVES * 64, LDS_BYTES) != hipSuccess || per_cu < 1) { fprintf(stderr, "kernel_launch: occupancy query says %d blocks per CU\n", per_cu); grid = -1; return; }
        (void)hipGetLastError();
        grid = cus;
    }
    if (grid < 0) return;
    const float* x = (const float*)d_in[0];
    const float* w_out = (const float*)d_in[6];
    const float* ln1_g = (const float*)d_in[7]; const float* ln1_b = (const float*)d_in[8]; const float* w_router = (const float*)d_in[9]; const float* router_bias = (const float*)d_in[10];
    const float* we_gate = (const float*)d_in[11]; const float* we_up = (const float*)d_in[12]; const float* we_down = (const float*)d_in[13];
    const float* ws_gate = (const float*)d_in[14]; const float* ws_up = (const float*)d_in[15]; const float* ws_down = (const float*)d_in[16];
    const float* ln2_g = (const float*)d_in[17]; const float* ln2_b = (const float*)d_in[18];
    (void)x;
    unsigned char* ws = (unsigned char*)d_ws; float* out = (float*)d_out;
    int* cnt = (int*)(ws + WS_CTL) + CW_CNT;
    float* LOGF = (float*)(ws + WS_LOGF); float* BIAS = (float*)(ws + WS_BIAS); int* ASG = (int*)(ws + WS_ASG); int* TOKL = (int*)(ws + WS_TOKL); float* GATEL = (float*)(ws + WS_GATEL);
    float* LOGITS = (float*)(ws + WS_LOGITS); bf16_t* XN = (bf16_t*)(ws + WS_XN); bf16_t* H1 = XN;
    bf16_t* RQ = (bf16_t*)(ws + WS_RQ); bf16_t* RK = RQ + BUFE; bf16_t* RV = RQ + 2 * BUFE; bf16_t* RG = RQ + 3 * BUFE; bf16_t* FQ = RQ + 4 * BUFE; bf16_t* FK = RQ + 5 * BUFE; bf16_t* FV = RQ + 6 * BUFE;
    bf16_t* MIXED = (bf16_t*)(ws + WS_MIXED); bf16_t* Y = (bf16_t*)(ws + WS_Y);
    float* yb = out;
    bf16_t* HID = (bf16_t*)d_out;

    (void)hipMemsetAsync(ws + WS_CTL, 0, 1 * MiB, stream);
    Args a{};
    for (int i = 0; i < 19; ++i) a.in[i] = (const float*)d_in[i];
#if defined(PROBE_HOST)
    a.out = out; a.ws = ws; a.ph_lo = 0; a.ph_hi = PROBE_HOST + 1;
    { void* kargs[] = {&a}; (void)hipLaunchCooperativeKernel((const void*)mega, dim3(grid), dim3(NWAVES * 64), kargs, LDS_BYTES, stream); }
    (void)hipMemsetAsync(ws + WS_CTL, 0, 1 * MiB, stream);
#endif
    a.out = out; a.ws = ws; a.ph_lo = 0; a.ph_hi = 9;
    { void* kargs[] = {&a}; hipError_t e = hipLaunchCooperativeKernel((const void*)mega, dim3(grid), dim3(NWAVES * 64), kargs, LDS_BYTES, stream);
      if (e != hipSuccess) fprintf(stderr, "kernel_launch: cooperative launch failed: %s\n", hipGetErrorString(e)); }
}
```

```cpp
#include <hip/hip_runtime.h>
#include <stdint.h>
#include <cstdio>

typedef unsigned short bf16_t;

constexpr int NB = 8, SEQ = 4096, DM = 1024, NMETA = 16, NX = NB * SEQ;
constexpr int LT = 4352;
constexpr int XPOS0 = 256;
constexpr int RMETA0 = 240;
constexpr int FMETA0 = 128;
constexpr int INC = 3592, NEXP = 64, TOPK = 6, EFF = 256;
constexpr int CAP = 32768;
constexpr float LN_EPS = 1e-5f;
constexpr float ALPHA = 1.189207115002721f;
constexpr float LOG2E = 1.4426950408889634f;
constexpr float C2 = 0.125f * LOG2E;
constexpr float RK_SCALE = 0.08838834764831845f;
constexpr float ROUTED_SCALE = 2.5f;

constexpr size_t MiB = 1u << 20;
constexpr size_t WS_CTL = 0;
constexpr size_t WS_LOGF = 1 * MiB;
constexpr size_t WS_BIAS = 3 * MiB;
constexpr size_t WS_ASG = 5 * MiB;
constexpr size_t WS_TOKL = 6 * MiB;
constexpr size_t WS_GATEL = 14 * MiB;
constexpr size_t WS_LOGITS = 22 * MiB;
constexpr size_t WS_XN = 30 * MiB;
constexpr size_t WS_A = 96 * MiB;
constexpr size_t BUFE = (size_t)NB * LT * 512;
constexpr size_t WS_RQ = WS_A;
constexpr size_t WS_MIXED = WS_A + 7 * BUFE * 2;
constexpr size_t WS_Y = WS_A;
constexpr size_t WS_WIN_T = 398 * MiB;
constexpr size_t WS_WOUT_T = 405 * MiB;
constexpr size_t WS_WGU_T = 407 * MiB;
constexpr size_t WS_WSD_T = 94 * MiB + 512 * 1024;
constexpr size_t WS_WR_T = 95 * MiB;
constexpr size_t WS_TAB = 95 * MiB + 512 * 1024;
constexpr size_t WS_WD_T = 480 * MiB;
constexpr size_t WS_END = 512 * MiB;
constexpr size_t HID_S_ROW0 = 212992;
constexpr int CW_CNT = 1024;
constexpr int CW_Q2 = 2048;
constexpr int CW_QK2 = 3584;

__device__ __forceinline__ float bf2f(bf16_t v) { return __uint_as_float(((unsigned)v) << 16); }
__device__ __forceinline__ unsigned f2bf(float f) { unsigned u = __float_as_uint(f); return (u + 0x7fffu + ((u >> 16) & 1u)) >> 16; }
__device__ __forceinline__ float wave_sum(float v) {
#pragma unroll
    for (int o = 1; o < 64; o <<= 1) v += __shfl_xor(v, o);
    return v;
}

__global__ void __launch_bounds__(256) k_ln0(const float* __restrict__ x, const float* __restrict__ meta, const float* __restrict__ g, const float* __restrict__ bta,
                                            const float* __restrict__ w_in, const float* __restrict__ b_forget, bf16_t* XN, float* LOGF) {
    __shared__ float wf[1024 * 8];
    for (int i = threadIdx.x; i < 1024 * 8; i += 256) { int k = i >> 3, h = i & 7; wf[i] = w_in[(size_t)k * INC + 3584 + h]; }
    __syncthreads();
    const int lane = threadIdx.x & 63, wave = threadIdx.x >> 6;
    const int gw = blockIdx.x * 4 + wave, ngw = gridDim.x * 4;
    for (int row = gw; row < NX + NMETA; row += ngw) {
        const float* src = row < NX ? x + (size_t)row * DM : meta + (size_t)(row - NX) * DM;
        float4 v[4]; float s = 0.f;
#pragma unroll
        for (int j = 0; j < 4; ++j) { v[j] = ((const float4*)src)[lane + 64 * j]; s += (v[j].x + v[j].y) + (v[j].z + v[j].w); }
        const float mean = wave_sum(s) * (1.f / DM);
        float s2 = 0.f;
#pragma unroll
        for (int j = 0; j < 4; ++j) { v[j].x -= mean; v[j].y -= mean; v[j].z -= mean; v[j].w -= mean; s2 += (v[j].x * v[j].x + v[j].y * v[j].y) + (v[j].z * v[j].z + v[j].w * v[j].w); }
        const float rstd = 1.f / sqrtf(wave_sum(s2) * (1.f / DM) + LN_EPS);
        float f[8];
#pragma unroll
        for (int h = 0; h < 8; ++h) f[h] = 0.f;
#pragma unroll
        for (int j = 0; j < 4; ++j) {
            const float4 gg = ((const float4*)g)[lane + 64 * j], bb = ((const float4*)bta)[lane + 64 * j];
            float y0 = v[j].x * rstd * gg.x + bb.x, y1 = v[j].y * rstd * gg.y + bb.y, y2 = v[j].z * rstd * gg.z + bb.z, y3 = v[j].w * rstd * gg.w + bb.w;
            uint2 o; o.x = (unsigned)f2bf(y0) | ((unsigned)f2bf(y1) << 16); o.y = (unsigned)f2bf(y2) | ((unsigned)f2bf(y3) << 16);
            ((uint2*)(XN + (size_t)row * DM))[lane + 64 * j] = o;
            const int k0 = 4 * (lane + 64 * j);
#pragma unroll
            for (int h = 0; h < 8; ++h) f[h] += y0 * wf[(k0 + 0) * 8 + h] + y1 * wf[(k0 + 1) * 8 + h] + y2 * wf[(k0 + 2) * 8 + h] + y3 * wf[(k0 + 3) * 8 + h];
        }
        float z = 0.f;
#pragma unroll
        for (int h = 0; h < 8; ++h) { const float t = wave_sum(f[h]); if (lane == h) z = t; }
        if (lane < 8) { z += b_forget[lane]; LOGF[(size_t)row * 8 + lane] = fminf(z, 0.f) - log1pf(expf(-fabsf(z))); }
    }
}

__global__ void __launch_bounds__(64) k_bias(const float* __restrict__ LOGF, float* BIAS) {
    const int bh = blockIdx.x, b = bh >> 3, h = bh & 7, lane = threadIdx.x;
    float* out = BIAS + (size_t)bh * LT;
    for (int p = lane; p < XPOS0; p += 64) if (p < FMETA0 || p >= FMETA0 + NMETA) out[p] = -1e30f;
    float carry = 0.f;
    for (int t0 = 0; t0 < NMETA + SEQ; t0 += 64) {
        const int t = t0 + lane; float v = 0.f;
        if (t < NMETA + SEQ) { const int row = t < NMETA ? NX + t : b * SEQ + t - NMETA; v = LOGF[(size_t)row * 8 + h]; }
#pragma unroll
        for (int o = 1; o < 64; o <<= 1) { const float u = __shfl_up(v, o); if (lane >= o) v += u; }
        v += carry;
        if (t < NMETA + SEQ) { const int pos = t < NMETA ? FMETA0 + t : XPOS0 + t - NMETA; out[pos] = -v * LOG2E; }
        carry = __shfl(v, 63);
    }
}

template <class AF, class BF, class EF>
__global__ void __launch_bounds__(256) naive_gemm(int M, int N, int K, int padarg, AF af, BF bf, EF ef) {
    __shared__ float As[16][65];
    __shared__ float Bs[16][65];
    const int tx = threadIdx.x & 15, ty = threadIdx.x >> 4;
    const int m0 = blockIdx.y * 64, n0 = blockIdx.x * 64;
    float acc[4][4];
#pragma unroll
    for (int i = 0; i < 4; ++i)
#pragma unroll
        for (int j = 0; j < 4; ++j) acc[i][j] = 0.f;
    for (int k0 = 0; k0 < K; k0 += 16) {
        for (int i = threadIdx.x; i < 1024; i += 256) { const int m = i >> 4, k = i & 15; As[k][m] = (m0 + m < M) ? af(m0 + m, k0 + k) : 0.f; }
        for (int i = threadIdx.x; i < 1024; i += 256) { const int k = i >> 6, n = i & 63; Bs[k][n] = (n0 + n < N) ? bf(k0 + k, n0 + n) : 0.f; }
        __syncthreads();
#pragma unroll
        for (int k = 0; k < 16; ++k) {
            float a[4], b[4];
#pragma unroll
            for (int i = 0; i < 4; ++i) { a[i] = As[k][ty * 4 + i]; b[i] = Bs[k][tx * 4 + i]; }
#pragma unroll
            for (int i = 0; i < 4; ++i)
#pragma unroll
                for (int j = 0; j < 4; ++j) acc[i][j] += a[i] * b[j];
        }
        __syncthreads();
    }
#pragma unroll
    for (int i = 0; i < 4; ++i)
#pragma unroll
        for (int j = 0; j < 4; ++j) { const int m = m0 + ty * 4 + i, n = n0 + tx * 4 + j; if (m < M && n < N) ef(m, n, acc[i][j]); }
}
struct AF_bf16 { const bf16_t* p; int ld; int pad; __device__ float operator()(int m, int k) const { return bf2f(p[(size_t)m * ld + k]); } };
struct BF_f32 { const float* p; int ld; int pad; __device__ float operator()(int k, int n) const { return p[(size_t)k * ld + n]; } };
struct EF_inproj {
    bf16_t* bufs;
    __device__ void operator()(int row, int col, float v) const {
        const int g = col >> 9, cc = col & 511;
        if (g == 1) v *= RK_SCALE; else if (g == 3) v = v / (1.f + __expf(-v)); else if (g == 4) v *= C2;
        const bf16_t o = f2bf(v);
        bf16_t* base = bufs + (size_t)g * BUFE;
        if (row < NX) { const int b = row >> 12, i = row & 4095; base[((size_t)b * LT + XPOS0 + i) * 512 + cc] = o; }
        else { const int pos = (g < 4 ? RMETA0 : FMETA0) + (row - NX); for (int b = 0; b < NB; ++b) base[((size_t)b * LT + pos) * 512 + cc] = o; }
    }
};
struct EF_outproj { float* y; const bf16_t* XN; __device__ void operator()(int row, int col, float v) const { const size_t o = (size_t)row * DM + col; y[o] = v + ALPHA * bf2f(XN[o]); } };
struct EF_store { float* p; int ld; int pad; __device__ void operator()(int row, int col, float v) const { p[(size_t)row * ld + col] = v; } };

__global__ void __launch_bounds__(256) k_rotary(bf16_t* RQ, bf16_t* RK) {
    const size_t idx = (size_t)blockIdx.x * 256 + threadIdx.x;
    if (idx >= (size_t)NB * (NMETA + SEQ) * 256) return;
    const int j = (int)(idx & 63), h = (int)((idx >> 6) & 3); const size_t r = idx >> 8; const int t = (int)(r % (NMETA + SEQ)), b = (int)(r / (NMETA + SEQ));
    const int pos = RMETA0 + t;
    const double inv = exp2(-(double)j * (13.287712379549449 / 64.0));
    double rv = (double)t * inv * 0.15915494309189535; rv -= floor(rv);
    const float fr = (float)rv, s = __builtin_amdgcn_sinf(fr), c = __builtin_amdgcn_cosf(fr);
    bf16_t* p = RQ + ((size_t)b * LT + pos) * 512 + h * 128 + j;
    float x1 = bf2f(p[0]), x2 = bf2f(p[64]); p[0] = f2bf(x1 * c - x2 * s); p[64] = f2bf(x2 * c + x1 * s);
    p = RK + ((size_t)b * LT + pos) * 512 + h * 128 + j;
    x1 = bf2f(p[0]); x2 = bf2f(p[64]); p[0] = f2bf(x1 * c - x2 * s); p[64] = f2bf(x2 * c + x1 * s);
}

__device__ __forceinline__ void unpack8(const uint4 u, float* d) {
    d[0] = __uint_as_float(u.x << 16); d[1] = __uint_as_float(u.x & 0xffff0000u); d[2] = __uint_as_float(u.y << 16); d[3] = __uint_as_float(u.y & 0xffff0000u);
    d[4] = __uint_as_float(u.z << 16); d[5] = __uint_as_float(u.z & 0xffff0000u); d[6] = __uint_as_float(u.w << 16); d[7] = __uint_as_float(u.w & 0xffff0000u);
}

__global__ void __launch_bounds__(64) k_ret_naive(const bf16_t* __restrict__ RQ, const bf16_t* __restrict__ RK, const bf16_t* __restrict__ RV, const bf16_t* __restrict__ RG, bf16_t* MIXED) {
    __shared__ float Ks[64 * 128];
    __shared__ float Vs[64 * 128];
    const int blk = blockIdx.x, qt = blk & 63, h = (blk >> 6) & 3, b = blk >> 8, lane = threadIdx.x;
    const int i = qt * 64 + lane, qpos = XPOS0 + i;
    const float lg2g = log2f(1.f - exp2f(-5.f - (float)h));
    float q[128], o[128];
    const bf16_t* qp = RQ + ((size_t)b * LT + qpos) * 512 + h * 128;
#pragma unroll
    for (int d = 0; d < 128; d += 8) unpack8(*(const uint4*)(qp + d), q + d);
#pragma unroll
    for (int e = 0; e < 128; ++e) o[e] = 0.f;
    const int last_pos = XPOS0 + qt * 64 + 63;
    for (int kp0 = 192; kp0 <= last_pos; kp0 += 64) {
        __syncthreads();
        for (int c = lane; c < 1024; c += 64) {
            const int key = c >> 4, d8 = (c & 15) * 8; const size_t off = ((size_t)b * LT + kp0 + key) * 512 + h * 128 + d8;
            unpack8(*(const uint4*)(RK + off), Ks + key * 128 + d8); unpack8(*(const uint4*)(RV + off), Vs + key * 128 + d8);
        }
        __syncthreads();
        for (int s = 0; s < 64; ++s) {
            const int kpos = kp0 + s;
            if (kpos < RMETA0) continue;
            float sc = 0.f;
#pragma unroll
            for (int d = 0; d < 128; d += 4) { const float4 kk = *(const float4*)(Ks + s * 128 + d); sc += q[d] * kk.x + q[d + 1] * kk.y + q[d + 2] * kk.z + q[d + 3] * kk.w; }
            const float w = (kpos <= qpos) ? sc * exp2f((float)(qpos - kpos) * lg2g) : 0.f;
#pragma unroll
            for (int e = 0; e < 128; e += 4) { const float4 vv = *(const float4*)(Vs + s * 128 + e); o[e] += w * vv.x; o[e + 1] += w * vv.y; o[e + 2] += w * vv.z; o[e + 3] += w * vv.w; }
        }
    }
    float mean = 0.f;
#pragma unroll
    for (int e = 0; e < 128; ++e) mean += o[e];
    mean *= (1.f / 128.f);
    float var = 0.f;
#pragma unroll
    for (int e = 0; e < 128; ++e) { o[e] -= mean; var += o[e] * o[e]; }
    const float rstd = 1.f / sqrtf(var * (1.f / 128.f) + LN_EPS);
    const bf16_t* gp = RG + ((size_t)b * LT + qpos) * 512 + h * 128;
    bf16_t* op = MIXED + ((size_t)b * SEQ + i) * DM + h * 128;
#pragma unroll
    for (int e = 0; e < 128; e += 8) {
        float gg[8]; unpack8(*(const uint4*)(gp + e), gg);
        uint4 w;
        w.x = (unsigned)f2bf(o[e] * rstd * gg[0]) | ((unsigned)f2bf(o[e + 1] * rstd * gg[1]) << 16);
        w.y = (unsigned)f2bf(o[e + 2] * rstd * gg[2]) | ((unsigned)f2bf(o[e + 3] * rstd * gg[3]) << 16);
        w.z = (unsigned)f2bf(o[e + 4] * rstd * gg[4]) | ((unsigned)f2bf(o[e + 5] * rstd * gg[5]) << 16);
        w.w = (unsigned)f2bf(o[e + 6] * rstd * gg[6]) | ((unsigned)f2bf(o[e + 7] * rstd * gg[7]) << 16);
        *(uint4*)(op + e) = w;
    }
}

__global__ void __launch_bounds__(64) k_fox_naive(const bf16_t* __restrict__ FQ, const bf16_t* __restrict__ FK, const bf16_t* __restrict__ FV, const float* __restrict__ BIAS, bf16_t* MIXED) {
    __shared__ float Ks[64 * 64];
    __shared__ float Vs[64 * 64];
    __shared__ float Bsh[64];
    const int blk = blockIdx.x, qt = blk & 63, h = (blk >> 6) & 7, b = blk >> 9, lane = threadIdx.x;
    const int i = qt * 64 + lane, qpos = XPOS0 + i;
    float q[64], o[64];
    const bf16_t* qp = FQ + ((size_t)b * LT + qpos) * 512 + h * 64;
#pragma unroll
    for (int d = 0; d < 64; d += 8) unpack8(*(const uint4*)(qp + d), q + d);
#pragma unroll
    for (int e = 0; e < 64; ++e) o[e] = 0.f;
    float m = -1e30f, l = 0.f;
    const int last_pos = XPOS0 + qt * 64 + 63;
    for (int kp0 = FMETA0; kp0 <= last_pos; kp0 += 64) {
        __syncthreads();
        for (int c = lane; c < 512; c += 64) {
            const int key = c >> 3, d8 = (c & 7) * 8; const size_t off = ((size_t)b * LT + kp0 + key) * 512 + h * 64 + d8;
            unpack8(*(const uint4*)(FK + off), Ks + key * 64 + d8); unpack8(*(const uint4*)(FV + off), Vs + key * 64 + d8);
        }
        Bsh[lane] = BIAS[(size_t)(b * 8 + h) * LT + kp0 + lane];
        __syncthreads();
        for (int s = 0; s < 64; ++s) {
            float sc = Bsh[s];
#pragma unroll
            for (int d = 0; d < 64; d += 4) { const float4 kk = *(const float4*)(Ks + s * 64 + d); sc += q[d] * kk.x + q[d + 1] * kk.y + q[d + 2] * kk.z + q[d + 3] * kk.w; }
            if (kp0 + s > qpos) sc = -1e30f;
            const float mn = fmaxf(m, sc), f = exp2f(m - mn), p = exp2f(sc - mn);
            m = mn; l = l * f + p;
#pragma unroll
            for (int e = 0; e < 64; e += 4) { const float4 vv = *(const float4*)(Vs + s * 64 + e); o[e] = o[e] * f + p * vv.x; o[e + 1] = o[e + 1] * f + p * vv.y; o[e + 2] = o[e + 2] * f + p * vv.z; o[e + 3] = o[e + 3] * f + p * vv.w; }
        }
    }
    const float rl = 1.f / l;
    bf16_t* op = MIXED + ((size_t)b * SEQ + i) * DM + 512 + h * 64;
#pragma unroll
    for (int e = 0; e < 64; e += 8) {
        uint4 w;
        w.x = (unsigned)f2bf(o[e] * rl) | ((unsigned)f2bf(o[e + 1] * rl) << 16); w.y = (unsigned)f2bf(o[e + 2] * rl) | ((unsigned)f2bf(o[e + 3] * rl) << 16);
        w.z = (unsigned)f2bf(o[e + 4] * rl) | ((unsigned)f2bf(o[e + 5] * rl) << 16); w.w = (unsigned)f2bf(o[e + 6] * rl) | ((unsigned)f2bf(o[e + 7] * rl) << 16);
        *(uint4*)(op + e) = w;
    }
}

__global__ void __launch_bounds__(256) k_ln_rows(const float* __restrict__ y, const float* __restrict__ g, const float* __restrict__ bta, bf16_t* H) {
    const int lane = threadIdx.x & 63, wave = threadIdx.x >> 6;
    const int gw = blockIdx.x * 4 + wave, ngw = gridDim.x * 4;
    for (int row = gw; row < NX; row += ngw) {
        const float* src = y + (size_t)row * DM;
        float4 v[4]; float s = 0.f;
#pragma unroll
        for (int j = 0; j < 4; ++j) { v[j] = ((const float4*)src)[lane + 64 * j]; s += (v[j].x + v[j].y) + (v[j].z + v[j].w); }
        const float mean = wave_sum(s) * (1.f / DM);
        float s2 = 0.f;
#pragma unroll
        for (int j = 0; j < 4; ++j) { v[j].x -= mean; v[j].y -= mean; v[j].z -= mean; v[j].w -= mean; s2 += (v[j].x * v[j].x + v[j].y * v[j].y) + (v[j].z * v[j].z + v[j].w * v[j].w); }
        const float rstd = 1.f / sqrtf(wave_sum(s2) * (1.f / DM) + LN_EPS);
#pragma unroll
        for (int j = 0; j < 4; ++j) {
            const float4 gg = ((const float4*)g)[lane + 64 * j], bb = ((const float4*)bta)[lane + 64 * j];
            uint2 o; o.x = (unsigned)f2bf(v[j].x * rstd * gg.x + bb.x) | ((unsigned)f2bf(v[j].y * rstd * gg.y + bb.y) << 16);
            o.y = (unsigned)f2bf(v[j].z * rstd * gg.z + bb.z) | ((unsigned)f2bf(v[j].w * rstd * gg.w + bb.w) << 16);
            ((uint2*)(H + (size_t)row * DM))[lane + 64 * j] = o;
        }
    }
}

__global__ void __launch_bounds__(256) k_route(const float* __restrict__ LOGITS, const float* __restrict__ rbias, int* cnt, int* TOKL, float* GATEL, int* ASG) {
    __shared__ float sc[256 * 65];
    __shared__ float rb[64];
    if (threadIdx.x < 64) rb[threadIdx.x] = rbias[threadIdx.x];
    const int tok0 = blockIdx.x * 256;
    for (int i = threadIdx.x; i < 256 * 64; i += 256) { const int t = i >> 6, e = i & 63; const float x = LOGITS[(size_t)(tok0 + t) * 64 + e]; sc[t * 65 + e] = 1.f / (1.f + expf(-x)); }
    __syncthreads();
    const int tok = tok0 + threadIdx.x;
    const float* my = sc + threadIdx.x * 65;
    float gs[8];
#pragma unroll
    for (int g = 0; g < 8; ++g) {
        float m1 = -3e38f, m2 = -3e38f;
#pragma unroll
        for (int j = 0; j < 8; ++j) { const float v = my[g * 8 + j] + rb[g * 8 + j]; if (v > m1) { m2 = m1; m1 = v; } else if (v > m2) m2 = v; }
        gs[g] = m1 + m2;
    }
    unsigned gmask = 0;
#pragma unroll
    for (int r = 0; r < 4; ++r) {
        float best = -3e38f; int bi = 0;
#pragma unroll
        for (int g = 0; g < 8; ++g) { const bool take = !((gmask >> g) & 1u) && gs[g] > best; if (take) { best = gs[g]; bi = g; } }
        gmask |= 1u << bi;
    }
    unsigned long long chosen = 0ull; int sel[6]; float gv[6]; float gsum = 0.f;
#pragma unroll
    for (int r = 0; r < 6; ++r) {
        float best = -3e38f; int bi = 0;
        for (int e = 0; e < 64; ++e) { if (((gmask >> (e >> 3)) & 1u) && !((chosen >> e) & 1ull)) { const float v = my[e] + rb[e]; if (v > best) { best = v; bi = e; } } }
        chosen |= 1ull << bi; sel[r] = bi; gv[r] = my[bi]; gsum += gv[r];
    }
    const float scale = ROUTED_SCALE / gsum;
#pragma unroll
    for (int r = 0; r < 6; ++r) {
        const int e = sel[r]; const int rank = atomicAdd(&cnt[e], 1);
        TOKL[(size_t)e * CAP + rank] = tok; GATEL[(size_t)e * CAP + rank] = gv[r] * scale; ASG[(size_t)tok * 6 + r] = (e << 16) | rank;
    }
}

__global__ void __launch_bounds__(256) k_exp_up_naive(const bf16_t* __restrict__ H1, const float* __restrict__ we_gate, const float* __restrict__ we_up, const float* __restrict__ ws_gate, const float* __restrict__ ws_up,
                                                     const int* __restrict__ cnt, const int* __restrict__ TOKL, bf16_t* HID) {
    __shared__ float As[16][65];
    __shared__ float Bg[16][65];
    __shared__ float Bu[16][65];
    __shared__ int toks[64];
    __shared__ int hs_sh;
    const int e = blockIdx.z, n_e = e < 64 ? cnt[e] : NX, r0 = blockIdx.y * 64;
    if (r0 >= n_e) return;
    if (threadIdx.x == 0) { int hs = 0; for (int j = 0; j < e; ++j) hs += (cnt[j] + 255) & ~255; hs_sh = hs; }
    if (threadIdx.x < 64) { const int r = r0 + threadIdx.x; toks[threadIdx.x] = r < n_e ? (e < 64 ? TOKL[(size_t)e * CAP + r] : r) : -1; }
    __syncthreads();
    const float* Wg = e < 64 ? we_gate + (size_t)e * DM * EFF : ws_gate;
    const float* Wu = e < 64 ? we_up + (size_t)e * DM * EFF : ws_up;
    const int tx = threadIdx.x & 15, ty = threadIdx.x >> 4, n0 = blockIdx.x * 64;
    float ag[4][4], au[4][4];
#pragma unroll
    for (int i = 0; i < 4; ++i)
#pragma unroll
        for (int j = 0; j < 4; ++j) { ag[i][j] = 0.f; au[i][j] = 0.f; }
    for (int k0 = 0; k0 < DM; k0 += 16) {
        for (int i = threadIdx.x; i < 1024; i += 256) { const int m = i >> 4, k = i & 15; const int t = toks[m]; As[k][m] = t >= 0 ? bf2f(H1[(size_t)t * DM + k0 + k]) : 0.f; }
        for (int i = threadIdx.x; i < 1024; i += 256) { const int k = i >> 6, n = i & 63; Bg[k][n] = Wg[(size_t)(k0 + k) * EFF + n0 + n]; Bu[k][n] = Wu[(size_t)(k0 + k) * EFF + n0 + n]; }
        __syncthreads();
#pragma unroll
        for (int k = 0; k < 16; ++k) {
            float a[4], bg[4], bu[4];
#pragma unroll
            for (int i = 0; i < 4; ++i) { a[i] = As[k][ty * 4 + i]; bg[i] = Bg[k][tx * 4 + i]; bu[i] = Bu[k][tx * 4 + i]; }
#pragma unroll
            for (int i = 0; i < 4; ++i)
#pragma unroll
                for (int j = 0; j < 4; ++j) { ag[i][j] += a[i] * bg[j]; au[i][j] += a[i] * bu[j]; }
        }
        __syncthreads();
    }
    const int hs = hs_sh;
#pragma unroll
    for (int i = 0; i < 4; ++i)
#pragma unroll
        for (int j = 0; j < 4; ++j) { const int r = r0 + ty * 4 + i; if (r < n_e) { const float gq = ag[i][j]; HID[(size_t)(hs + r) * EFF + n0 + tx * 4 + j] = f2bf(gq / (1.f + __expf(-gq)) * au[i][j]); } }
}

__global__ void __launch_bounds__(256) k_exp_down_naive(const bf16_t* __restrict__ HID, const float* __restrict__ we_down, const float* __restrict__ ws_down, const int* __restrict__ cnt, const float* __restrict__ GATEL,
                                                       bf16_t* Y, bf16_t* H1) {
    __shared__ float As[16][65];
    __shared__ float Bs[16][65];
    __shared__ int hs_sh, ys_sh;
    const int e = blockIdx.z, n_e = e < 64 ? cnt[e] : NX, r0 = blockIdx.y * 64;
    if (r0 >= n_e) return;
    if (threadIdx.x == 0) { int hs = 0, ys = 0; for (int j = 0; j < e; ++j) { hs += (cnt[j] + 255) & ~255; ys += cnt[j]; } hs_sh = hs; ys_sh = ys; }
    __syncthreads();
    const int hs = hs_sh, ys = ys_sh;
    const float* Wd = e < 64 ? we_down + (size_t)e * EFF * DM : ws_down;
    const int tx = threadIdx.x & 15, ty = threadIdx.x >> 4, n0 = blockIdx.x * 64;
    float acc[4][4];
#pragma unroll
    for (int i = 0; i < 4; ++i)
#pragma unroll
        for (int j = 0; j < 4; ++j) acc[i][j] = 0.f;
    for (int k0 = 0; k0 < EFF; k0 += 16) {
        for (int i = threadIdx.x; i < 1024; i += 256) { const int m = i >> 4, k = i & 15; As[k][m] = (r0 + m < n_e) ? bf2f(HID[(size_t)(hs + r0 + m) * EFF + k0 + k]) : 0.f; }
        for (int i = threadIdx.x; i < 1024; i += 256) { const int k = i >> 6, n = i & 63; Bs[k][n] = Wd[(size_t)(k0 + k) * DM + n0 + n]; }
        __syncthreads();
#pragma unroll
        for (int k = 0; k < 16; ++k) {
            float a[4], b[4];
#pragma unroll
            for (int i = 0; i < 4; ++i) { a[i] = As[k][ty * 4 + i]; b[i] = Bs[k][tx * 4 + i]; }
#pragma unroll
            for (int i = 0; i < 4; ++i)
#pragma unroll
                for (int j = 0; j < 4; ++j) acc[i][j] += a[i] * b[j];
        }
        __syncthreads();
    }
#pragma unroll
    for (int i = 0; i < 4; ++i) {
        const int r = r0 + ty * 4 + i; if (r >= n_e) continue;
        if (e < 64) { const float gt = GATEL[(size_t)e * CAP + r];
#pragma unroll
            for (int j = 0; j < 4; ++j) Y[(size_t)(ys + r) * DM + n0 + tx * 4 + j] = f2bf(acc[i][j] * gt); }
        else {
#pragma unroll
            for (int j = 0; j < 4; ++j) { const size_t o = (size_t)r * DM + n0 + tx * 4 + j; H1[o] = f2bf(ALPHA * bf2f(H1[o]) + acc[i][j]); } }
    }
}

__global__ void __launch_bounds__(256) k_final(const bf16_t* __restrict__ BASE, const bf16_t* __restrict__ Y, const int* __restrict__ ASG, const int* __restrict__ cnt, const float* __restrict__ g, const float* __restrict__ bta, float* out) {
    __shared__ int ys[64];
    if (threadIdx.x == 0) { int a = 0; for (int j = 0; j < 64; ++j) { ys[j] = a; a += cnt[j]; } }
    __syncthreads();
    const int lane = threadIdx.x & 63, wave = threadIdx.x >> 6;
    const int gw = blockIdx.x * 4 + wave, ngw = gridDim.x * 4;
    for (int tok = gw; tok < NX; tok += ngw) {
        float v[16];
        { const bf16_t* src = BASE + (size_t)tok * DM;
#pragma unroll
          for (int j = 0; j < 2; ++j) unpack8(((const uint4*)src)[lane + 64 * j], v + 8 * j); }
#pragma unroll
        for (int r = 0; r < 6; ++r) {
            const int a = ASG[(size_t)tok * 6 + r]; const int e = a >> 16, rank = a & 0xffff;
            const bf16_t* src = Y + (size_t)(ys[e] + rank) * DM; float t[8];
#pragma unroll
            for (int j = 0; j < 2; ++j) { unpack8(((const uint4*)src)[lane + 64 * j], t);
#pragma unroll
                for (int q = 0; q < 8; ++q) v[8 * j + q] += t[q]; }
        }
        float s = 0.f;
#pragma unroll
        for (int q = 0; q < 16; ++q) s += v[q];
        const float mean = wave_sum(s) * (1.f / DM);
        float s2 = 0.f;
#pragma unroll
        for (int q = 0; q < 16; ++q) { v[q] -= mean; s2 += v[q] * v[q]; }
        const float rstd = 1.f / sqrtf(wave_sum(s2) * (1.f / DM) + LN_EPS);
#pragma unroll
        for (int j = 0; j < 2; ++j) {
            const int c0 = (lane + 64 * j) * 8;
            const float4 g0 = *(const float4*)(g + c0), g1 = *(const float4*)(g + c0 + 4), b0 = *(const float4*)(bta + c0), b1 = *(const float4*)(bta + c0 + 4);
            float4 o0, o1;
            o0.x = v[8 * j + 0] * rstd * g0.x + b0.x; o0.y = v[8 * j + 1] * rstd * g0.y + b0.y; o0.z = v[8 * j + 2] * rstd * g0.z + b0.z; o0.w = v[8 * j + 3] * rstd * g0.w + b0.w;
            o1.x = v[8 * j + 4] * rstd * g1.x + b1.x; o1.y = v[8 * j + 5] * rstd * g1.y + b1.y; o1.z = v[8 * j + 6] * rstd * g1.z + b1.z; o1.w = v[8 * j + 7] * rstd * g1.w + b1.w;
            *(float4*)(out + (size_t)tok * DM + c0) = o0; *(float4*)(out + (size_t)tok * DM + c0 + 4) = o1;
        }
    }
}


namespace pg8 {
#define PG8_LAS __attribute__((address_space(3)))
typedef unsigned short bf16_t;
typedef short bf16x8 __attribute__((ext_vector_type(8)));
typedef float f32x4 __attribute__((ext_vector_type(4)));
typedef unsigned u32x4 __attribute__((ext_vector_type(4)));
constexpr int BM = 256, BK = 64, HALF = 128, HTB = HALF * BK * 2  , STAGE_BYTES = 8 * HTB, NXCD = 8, WGM = 8;

__host__ __device__ __forceinline__ int lds_byte(int r, int c) { const int st = (r >> 4) * 2 + (c >> 5), rr = r & 15, cc = c & 31, ob = rr * 64 + cc * 2; return st * 1024 + (ob ^ (((ob >> 9) & 1) << 5)); }
__host__ __device__ __forceinline__ void stage_rc(int b, int& R, int& C) { const int st = b / 1024, sb = b % 1024, swz = sb ^ (((sb >> 9) & 1) << 5); R = (st >> 1) * 16 + swz / 64; C = (st & 1) * 32 + (swz % 64) / 2; }
__host__ __device__ __forceinline__ int perm32(int rho) { const int n = rho >> 4, i = rho & 15; return 8 * (i >> 2) + 4 * n + (i & 3); }

struct Unit { int pm, pn, idx; };
struct Gemm { const bf16_t* A; const bf16_t* Bt; int M, N, K; };

struct StaticOrder {
    int nM, nN, nwg, G, c;
    __host__ __device__ void init(int M, int N, int G_, int c_) { nM = M / BM; nN = N / BM; nwg = nM * nN; G = G_; c = c_; }
    __host__ __device__ bool next(int i, Unit& u) const {
        const long L = (long)i * G + c; if (L >= nwg) return false;
        int wgid = (int)L; { const int q = nwg / NXCD, r = nwg % NXCD, xcd = wgid % NXCD, off = wgid / NXCD; wgid = (xcd < r ? xcd * (q + 1) : r * (q + 1) + (xcd - r) * q) + off; }
        const int nig = WGM * nN, gid = wgid / nig, fm = gid * WGM, gsz = (nM - fm) < WGM ? (nM - fm) : WGM;
        u.pm = fm + ((wgid % nig) % gsz); u.pn = (wgid % nig) / gsz; return true;
    }
    __device__ __forceinline__ void a_ready(const Unit&) const {}
    __device__ __forceinline__ void done(const Unit&) const {}
    __device__ __forceinline__ const char* a_base(const Gemm& g, const Unit& u) const { return (const char*)g.A + (size_t)u.pm * ((size_t)BM * g.K * 2); }
    __device__ __forceinline__ const char* b_base(const Gemm& g, const Unit& u) const { return (const char*)g.Bt + (size_t)u.pn * ((size_t)BM * g.K * 2); }
    __device__ __forceinline__ void a_offs(const Gemm& g, const Unit& u, int tid, unsigned (&VO)[2][2]) const {
#pragma unroll
        for (int i = 0; i < 2; ++i) { int R, C; stage_rc(tid * 16 + i * 8192, R, C);
#pragma unroll
            for (int h = 0; h < 2; ++h) VO[h][i] = (unsigned)((u.pm * BM + h * HALF + R) * g.K + C) * 2u; } }
};

__device__ __forceinline__ unsigned cvt_pk_bf16(float lo, float hi) { unsigned r; asm volatile("v_cvt_pk_bf16_f32 %0, %1, %2" : "=v"(r) : "v"(lo), "v"(hi)); return r; }

struct EpiOutproj {
    static constexpr bool PERM = true, AFTER_DRAIN = false;
    float* y;
    __device__ __forceinline__ void operator()(const f32x4 (&acc)[2][2][4][2], const Unit& u, int wr, int wc, int fr, int fq) const {
#pragma unroll
        for (int ai = 0; ai < 2; ++ai)
#pragma unroll
            for (int m = 0; m < 4; ++m) {
                const size_t ro = (size_t)(u.pm * BM + ai * HALF + wr * 64 + m * 16 + fr) * DM + u.pn * BM + wc * 32 + 8 * fq;
#pragma unroll
                for (int bj = 0; bj < 2; ++bj) { *(f32x4*)(y + ro + bj * HALF) = acc[ai][bj][m][0]; *(f32x4*)(y + ro + bj * HALF + 4) = acc[ai][bj][m][1]; }
            }
    }
};
struct SingleUnit {
    int pm, pn, have;
    __device__ __forceinline__ bool next(int i, Unit& u) const { if (i > 0 || !have) return false; u.pm = pm; u.pn = pn; u.idx = 0; return true; }
    __device__ __forceinline__ void a_ready(const Unit&) const {}
    __device__ __forceinline__ void done(const Unit&) const {}
    __device__ __forceinline__ const char* b_base(const Gemm& g, const Unit& u) const { return (const char*)g.Bt + (size_t)u.pn * ((size_t)BM * g.K * 2); }
    __device__ __forceinline__ void a_offs(const Gemm& g, const Unit& u, int tid, unsigned (&VO)[2][2]) const {
#pragma unroll
        for (int i = 0; i < 2; ++i) { int R, C; stage_rc(tid * 16 + i * 8192, R, C);
#pragma unroll
            for (int h = 0; h < 2; ++h) VO[h][i] = (unsigned)((u.pm * BM + h * HALF + R) * g.K + C) * 2u; } }
};
template <bool GATHER> struct GroupOrder {
    const PG8_LAS int* ul; int n; const PG8_LAS int* tokl; int b_rows;
    __device__ __forceinline__ bool next(int i, Unit& u) const { if (i >= n) return false; const PG8_LAS int* p = ul + 6 * i; u.pm = p[1]; u.pn = p[2]; u.idx = i; return true; }
    __device__ __forceinline__ void a_ready(const Unit&) const {}
    __device__ __forceinline__ void done(const Unit&) const {}
    __device__ __forceinline__ const char* b_base(const Gemm& g, const Unit& u) const { return (const char*)g.Bt + ((size_t)ul[6 * u.idx] * b_rows + (size_t)u.pn * BM) * ((size_t)g.K * 2); }
    __device__ __forceinline__ void a_offs(const Gemm& g, const Unit& u, int tid, unsigned (&VO)[2][2]) const {
        const PG8_LAS int* p = ul + 6 * u.idx; const int aux = p[3];
#pragma unroll
        for (int i = 0; i < 2; ++i) { int R, C; stage_rc(tid * 16 + i * 8192, R, C);
#pragma unroll
            for (int h = 0; h < 2; ++h) {
                const int rl = h * HALF + R; int row;
                if (GATHER) row = tokl[u.idx * BM + rl];
                else row = aux + rl;
                VO[h][i] = (unsigned)(row * g.K + C) * 2u; } }
    }
};
__device__ __forceinline__ float silu_f(float v) { return v / (1.f + __expf(-v)); }
template <bool LIST> struct EpiGU {
    static constexpr bool PERM = true, AFTER_DRAIN = false;
    bf16_t* HID; const PG8_LAS int* ul;
    __device__ __forceinline__ void operator()(const f32x4 (&acc)[2][2][4][2], const Unit& u, int wr, int wc, int fr, int fq) const {
        const int aux = LIST ? ul[6 * u.idx + 3] : u.pm * BM;
#pragma unroll
        for (int ai = 0; ai < 2; ++ai)
#pragma unroll
            for (int m = 0; m < 4; ++m) {
                bf16_t* rowp = HID + (size_t)(aux + ai * HALF + wr * 64 + m * 16 + fr) * EFF + u.pn * 128 + wc * 16 + fq * 4;
#pragma unroll
                for (int bj = 0; bj < 2; ++bj) {
                    const f32x4 v0 = acc[ai][bj][m][0], v1 = acc[ai][bj][m][1];
                    unsigned w0 = cvt_pk_bf16(silu_f(v0[0]) * v1[0], silu_f(v0[1]) * v1[1]), w1 = cvt_pk_bf16(silu_f(v0[2]) * v1[2], silu_f(v0[3]) * v1[3]);
                    typedef unsigned u32x2 __attribute__((ext_vector_type(2)));
                    *(u32x2*)(rowp + bj * 64) = (u32x2){w0, w1};
                }
            }
    }
};
struct EpiBase {
    static constexpr bool PERM = true, AFTER_DRAIN = false;
    bf16_t* H1;
    __device__ __forceinline__ void operator()(const f32x4 (&acc)[2][2][4][2], const Unit& u, int wr, int wc, int fr, int fq) const {
#pragma unroll
        for (int ai = 0; ai < 2; ++ai)
#pragma unroll
            for (int m = 0; m < 4; ++m) {
                bf16_t* rowp = H1 + (size_t)(u.pm * BM + ai * HALF + wr * 64 + m * 16 + fr) * DM + u.pn * BM + wc * 32 + 8 * fq;
#pragma unroll
                for (int bj = 0; bj < 2; ++bj) {
                    const u32x4 xn = *(const u32x4*)(rowp + bj * HALF);
                    const f32x4 v0 = acc[ai][bj][m][0], v1 = acc[ai][bj][m][1];
                    u32x4 w;
                    w.x = cvt_pk_bf16(v0[0] + ALPHA * __uint_as_float(xn.x << 16), v0[1] + ALPHA * __uint_as_float(xn.x & 0xffff0000u)); w.y = cvt_pk_bf16(v0[2] + ALPHA * __uint_as_float(xn.y << 16), v0[3] + ALPHA * __uint_as_float(xn.y & 0xffff0000u));
                    w.z = cvt_pk_bf16(v1[0] + ALPHA * __uint_as_float(xn.z << 16), v1[1] + ALPHA * __uint_as_float(xn.z & 0xffff0000u)); w.w = cvt_pk_bf16(v1[2] + ALPHA * __uint_as_float(xn.w << 16), v1[3] + ALPHA * __uint_as_float(xn.w & 0xffff0000u));
                    *(u32x4*)(rowp + bj * HALF) = w;
                }
            }
    }
};
struct EpiY {
    static constexpr bool PERM = true, AFTER_DRAIN = false;
    unsigned char* Y; const PG8_LAS int* ul;
    __device__ __forceinline__ void operator()(const f32x4 (&acc)[2][2][4][2], const Unit& u, int wr, int wc, int fr, int fq) const {
        const PG8_LAS int* p = ul + 6 * u.idx; const int aux2 = p[4], nv = p[5];
        typedef unsigned u32x2 __attribute__((ext_vector_type(2)));
#pragma unroll
        for (int ai = 0; ai < 2; ++ai)
#pragma unroll
            for (int m = 0; m < 4; ++m) {
                const int rl = ai * HALF + wr * 64 + m * 16 + fr;
                if (rl < nv) {
                    unsigned char* rowp = Y + (size_t)(aux2 + rl) * DM + u.pn * BM + wc * 32 + 8 * fq;
#pragma unroll
                    for (int bj = 0; bj < 2; ++bj) {
                        f32x4 v0 = acc[ai][bj][m][0] * 64.f, v1 = acc[ai][bj][m][1] * 64.f;
#pragma unroll
                        for (int q = 0; q < 4; ++q) { v0[q] = __builtin_fminf(__builtin_fmaxf(v0[q], -448.f), 448.f); v1[q] = __builtin_fminf(__builtin_fmaxf(v1[q], -448.f), 448.f); }
                        int w0 = __builtin_amdgcn_cvt_pk_fp8_f32(v0[0], v0[1], 0, false); w0 = __builtin_amdgcn_cvt_pk_fp8_f32(v0[2], v0[3], w0, true);
                        int w1 = __builtin_amdgcn_cvt_pk_fp8_f32(v1[0], v1[1], 0, false); w1 = __builtin_amdgcn_cvt_pk_fp8_f32(v1[2], v1[3], w1, true);
                        *(u32x2*)(rowp + bj * HALF) = (u32x2){(unsigned)w0, (unsigned)w1};
                    }
                }
            }
    }
};
struct EpiRouter {
    static constexpr bool PERM = true, AFTER_DRAIN = true;
    const float* rbias; int* cnt; int* TOKL; float* GATEL; int* ASG;
    __device__ __forceinline__ void fused(f32x4 (&acc)[2][2][4][2], const Unit& u, int wr, int wc, int fr, int fq, PG8_LAS unsigned char* lds, int wid, int lane) const {
        PG8_LAS float* L = (PG8_LAS float*)lds;
        PG8_LAS float* rb = L + 256 * 65; PG8_LAS int* lcnt = (PG8_LAS int*)(rb + 64); PG8_LAS int* base = lcnt + 64;
        const int tid = wid * 64 + lane;
        if (tid < 64) { rb[tid] = rbias[tid]; lcnt[tid] = 0; }
        if (wc < 2) {
#pragma unroll
            for (int ai = 0; ai < 2; ++ai)
#pragma unroll
                for (int m = 0; m < 4; ++m)
#pragma unroll
                    for (int n = 0; n < 2; ++n) { const int rl = ai * HALF + wr * 64 + m * 16 + fr, e0 = wc * 32 + fq * 8 + n * 4; const f32x4 v = acc[ai][0][m][n];
#pragma unroll
                        for (int q = 0; q < 4; ++q) L[rl * 65 + e0 + q] = 1.f / (1.f + expf(-v[q])); }
        }
        __syncthreads();
        int sel[6]; int lr[6]; float gv[6]; float scale = 0.f;
        if (tid < 256) {
            const PG8_LAS float* my = L + tid * 65;
            float gs[8];
#pragma unroll
            for (int g = 0; g < 8; ++g) {
                float m1 = -3e38f, m2 = -3e38f;
#pragma unroll
                for (int j = 0; j < 8; ++j) { const float v = my[g * 8 + j] + rb[g * 8 + j]; if (v > m1) { m2 = m1; m1 = v; } else if (v > m2) m2 = v; }
                gs[g] = m1 + m2;
            }
            unsigned gmask = 0;
#pragma unroll
            for (int r = 0; r < 4; ++r) {
                float best = -3e38f; int bi = 0;
#pragma unroll
                for (int g = 0; g < 8; ++g) { const bool take = !((gmask >> g) & 1u) && gs[g] > best; if (take) { best = gs[g]; bi = g; } }
                gmask |= 1u << bi;
            }
            unsigned long long chosen = 0ull; float gsum = 0.f;
#pragma unroll
            for (int r = 0; r < 6; ++r) {
                float best = -3e38f; int bi = 0;
                for (int e = 0; e < 64; ++e) { if (((gmask >> (e >> 3)) & 1u) && !((chosen >> e) & 1ull)) { const float v = my[e] + rb[e]; if (v > best) { best = v; bi = e; } } }
                chosen |= 1ull << bi; sel[r] = bi; gv[r] = my[bi]; gsum += gv[r];
                lr[r] = __hip_atomic_fetch_add(lcnt + bi, 1, __ATOMIC_RELAXED, __HIP_MEMORY_SCOPE_WORKGROUP);
            }
            scale = ROUTED_SCALE / gsum;
        }
        __syncthreads();
        if (tid < 64) base[tid] = atomicAdd(cnt + tid, lcnt[tid]);
        __syncthreads();
        if (tid < 256) {
            const int tok = u.pm * BM + tid;
#pragma unroll
            for (int r = 0; r < 6; ++r) { const int e = sel[r], rank = base[e] + lr[r]; TOKL[(size_t)e * CAP + rank] = tok; GATEL[(size_t)e * CAP + rank] = gv[r] * scale; ASG[(size_t)tok * 6 + r] = (e << 16) | rank; }
        }
        __syncthreads();
    }
};
struct EpiInproj {
    static constexpr bool PERM = true, AFTER_DRAIN = false;
    bf16_t* bufs; const PG8_LAS float* tab;
    __device__ __forceinline__ void operator()(const f32x4 (&acc)[2][2][4][2], const Unit& u, int wr, int wc, int fr, int fq) const {
        const int g = u.pn >> 1;
        bf16_t* base = bufs + (size_t)g * BUFE;
        const int ccb = (u.pn & 1) * 256 + wc * 32 + 8 * fq;
        float ihi[4], ilo[4];
#pragma unroll
        for (int jj = 0; jj < 4; ++jj) { ihi[jj] = 0.f; ilo[jj] = 0.f; }
        if (g < 2) {
#pragma unroll
            for (int jj = 0; jj < 4; ++jj) { const int j = 16 * wc + 4 * fq + jj; ihi[jj] = tab[2 * j]; ilo[jj] = tab[2 * j + 1]; }
        }
#pragma unroll
        for (int ai = 0; ai < 2; ++ai)
#pragma unroll
            for (int m = 0; m < 4; ++m) {
                const int row = u.pm * BM + ai * HALF + wr * 64 + m * 16 + fr; const int b = row >> 12, i = row & 4095;
                bf16_t* rowp = base + ((size_t)b * LT + XPOS0 + i) * 512 + ccb;
                float cs[4], sn[4];
                if (g < 2) {
                    const float t = (float)(NMETA + i);
#pragma unroll
                    for (int jj = 0; jj < 4; ++jj) { const float p = t * ihi[jj]; const float e = __builtin_fmaf(t, ihi[jj], -p) + t * ilo[jj]; const float f = (p - __builtin_floorf(p)) + e;
                        sn[jj] = __builtin_amdgcn_sinf(f); cs[jj] = __builtin_amdgcn_cosf(f); }
                }
#pragma unroll
                for (int bj = 0; bj < 2; ++bj) {
                    f32x4 v0 = acc[ai][bj][m][0], v1 = acc[ai][bj][m][1];
                    if (g < 2) {
                        f32x4 r0, r1;
                        r0[0] = v0[0] * cs[0] - v0[1] * sn[0]; r0[1] = v0[1] * cs[0] + v0[0] * sn[0]; r0[2] = v0[2] * cs[1] - v0[3] * sn[1]; r0[3] = v0[3] * cs[1] + v0[2] * sn[1];
                        r1[0] = v1[0] * cs[2] - v1[1] * sn[2]; r1[1] = v1[1] * cs[2] + v1[0] * sn[2]; r1[2] = v1[2] * cs[3] - v1[3] * sn[3]; r1[3] = v1[3] * cs[3] + v1[2] * sn[3];
                        const float sc = (g == 1) ? RK_SCALE : 1.f; v0 = r0 * sc; v1 = r1 * sc;
                    } else if (g == 3) {
#pragma unroll
                        for (int q = 0; q < 4; ++q) { v0[q] = v0[q] / (1.f + __expf(-v0[q])); v1[q] = v1[q] / (1.f + __expf(-v1[q])); }
                    } else if (g == 4) { v0 = v0 * C2; v1 = v1 * C2; }
                    u32x4 w; w.x = cvt_pk_bf16(v0[0], v0[1]); w.y = cvt_pk_bf16(v0[2], v0[3]); w.z = cvt_pk_bf16(v1[0], v1[1]); w.w = cvt_pk_bf16(v1[2], v1[3]);
                    *(u32x4*)(rowp + bj * HALF) = w;
                }
            }
    }
};
template <class Epi, class Sched, bool ALIGN_EPI = false, bool SP2 = false>
__device__ __forceinline__ void gemm_phase(PG8_LAS unsigned char* lds, const Gemm g, const Sched& S, const Epi& E) {
    const int tid = threadIdx.x, wid = __builtin_amdgcn_readfirstlane(tid >> 6), lane = tid & 63, wr = wid >> 2, wc = wid & 3, fr = lane & 15, fq = lane >> 4;
    const int K = g.K, nt = K / BK;
    unsigned voffB[2];
#pragma unroll
    for (int i = 0; i < 2; ++i) { int R, C; stage_rc(tid * 16 + i * 8192, R, C); const int Rb = Epi::PERM ? ((R & ~31) + perm32(R & 31)) : R;
        voffB[i] = (unsigned)(Rb * K + C) * 2u; }
    const size_t kstep = (size_t)(BK * 2);
    const size_t hstep = (size_t)HALF * K * 2;
    const unsigned ldsw = (unsigned)wid * 1024u;
    const int aoff = lds_byte(wr * 64 + fr, fq * 8), boff = lds_byte(wc * 32 + fr, fq * 8);
#define PG8_SA(b, h) (((b) * 2 + (h)) * HTB)
#define PG8_SB(b, h) ((4 + (b) * 2 + (h)) * HTB)
#define PG8_STAGE(bufoff, gbase, voff) do { _Pragma("unroll") for (int _i = 0; _i < 2; ++_i) \
        __builtin_amdgcn_global_load_lds((const unsigned*)((const char*)(gbase) + (voff)[_i]), (PG8_LAS unsigned*)(lds + (bufoff) + ldsw + _i * 8192), 16, 0, 0); } while (0)
#define PG8_STAGEA(bufoff, VO, h, kofs) do { _Pragma("unroll") for (int _i = 0; _i < 2; ++_i) \
        __builtin_amdgcn_global_load_lds((const unsigned*)(Ab + (size_t)(VO)[h][_i] + (size_t)(kofs)), (PG8_LAS unsigned*)(lds + (bufoff) + ldsw + _i * 8192), 16, 0, 0); } while (0)
#define PG8_LDA(dst, b, h) do { _Pragma("unroll") for (int m = 0; m < 4; ++m) _Pragma("unroll") for (int k = 0; k < 2; ++k) dst[m][k] = *(const PG8_LAS bf16x8*)(lds + PG8_SA(b, h) + aoff + m * 2048 + k * 1024); } while (0)
#define PG8_LDB(dst, b, h) do { _Pragma("unroll") for (int n = 0; n < 2; ++n) _Pragma("unroll") for (int k = 0; k < 2; ++k) dst[n][k] = *(const PG8_LAS bf16x8*)(lds + PG8_SB(b, h) + boff + n * 2048 + k * 1024); } while (0)
#define PG8_MMA(ai, bj, At, Bt) do { __builtin_amdgcn_s_setprio(1); _Pragma("unroll") for (int m = 0; m < 4; ++m) _Pragma("unroll") for (int n = 0; n < 2; ++n) _Pragma("unroll") for (int k = 0; k < 2; ++k) \
        acc[ai][bj][m][n] = __builtin_amdgcn_mfma_f32_16x16x32_bf16(Bt[n][k], At[m][k], acc[ai][bj][m][n], 0, 0, 0); __builtin_amdgcn_s_setprio(0); } while (0)
#define PG8_WAIT_V(n) asm volatile("s_waitcnt vmcnt(" #n ")" ::: "memory")
#define PG8_WAIT_L(n) asm volatile("s_waitcnt lgkmcnt(" #n ")" ::: "memory")
#define PG8_BAR __builtin_amdgcn_s_barrier()
#define PG8_SCHED __builtin_amdgcn_sched_barrier(0)
    Unit cur, nxt; int ui = 0;
    if (!S.next(0, cur)) return;
    f32x4 acc[2][2][4][2];
#pragma unroll
    for (int a = 0; a < 2; ++a)
#pragma unroll
        for (int b = 0; b < 2; ++b)
#pragma unroll
            for (int m = 0; m < 4; ++m)
#pragma unroll
                for (int n = 0; n < 2; ++n) acc[a][b][m][n] = (f32x4){0.f, 0.f, 0.f, 0.f};
    bf16x8 At[4][2], B0[2][2], B1[2][2];
    const char* Ab = (const char*)g.A; const char* cB = S.b_base(g, cur);
    unsigned VA[2][2], VN[2][2];
    S.a_offs(g, cur, tid, VA);
    S.a_ready(cur);
    if constexpr (SP2) {
        PG8_STAGE(PG8_SB(0, 0), cB, voffB); PG8_STAGE(PG8_SB(0, 1), cB + hstep, voffB); PG8_STAGEA(PG8_SA(0, 0), VA, 0, 0); PG8_STAGEA(PG8_SA(0, 1), VA, 1, 0);
        if (wr == 1) PG8_BAR;
        PG8_WAIT_V(2); PG8_BAR;
        PG8_STAGE(PG8_SB(1, 0), cB + kstep, voffB); PG8_STAGEA(PG8_SA(1, 0), VA, 0, kstep); PG8_STAGE(PG8_SB(1, 1), cB + hstep + kstep, voffB);
        PG8_WAIT_V(6); PG8_BAR;
    } else { static_assert(SP2, "only the SP2 loop is kept in this file"); }
    for (;;) {
        const bool has_next = S.next(ui + 1, nxt);
        const char* nB = has_next ? S.b_base(g, nxt) : cB;
        if (has_next) S.a_offs(g, nxt, tid, VN);
        else {
#pragma unroll
            for (int h = 0; h < 2; ++h)
#pragma unroll
                for (int i = 0; i < 2; ++i) VN[h][i] = VA[h][i]; }
#pragma unroll 1
        for (int t = 0; t < nt; t += 2) {
            const bool last = (t == nt - 2);
            const size_t k1 = (size_t)(t + 1) * kstep, k2 = last ? (size_t)0 : (size_t)(t + 2) * kstep;
            const char* b2 = last ? nB : cB + (size_t)(t + 2) * kstep; const char* b3 = b2 + kstep;
            if (last && has_next) S.a_ready(nxt);
            if constexpr (SP2) {
            PG8_LDB(B0, 0, 0); PG8_LDB(B1, 0, 1); PG8_SCHED; PG8_LDA(At, 0, 0); PG8_STAGEA(PG8_SA(1, 1), VA, 1, k1);
            if (last) {
#pragma unroll
                for (int h = 0; h < 2; ++h)
#pragma unroll
                    for (int i = 0; i < 2; ++i) VA[h][i] = VN[h][i]; }
            PG8_WAIT_V(8); PG8_WAIT_L(0); PG8_BAR; PG8_MMA(0, 0, At, B0); PG8_MMA(0, 1, At, B1); PG8_BAR; PG8_SCHED;
            PG8_LDA(At, 0, 1); PG8_STAGE(PG8_SB(0, 0), b2, voffB); PG8_STAGE(PG8_SB(0, 1), b2 + hstep, voffB); PG8_STAGEA(PG8_SA(0, 0), VA, 0, k2);
            PG8_WAIT_V(8); PG8_WAIT_L(0); PG8_BAR; PG8_MMA(1, 0, At, B0); PG8_MMA(1, 1, At, B1); PG8_BAR; PG8_SCHED;
            PG8_LDB(B0, 1, 0); PG8_LDB(B1, 1, 1); PG8_SCHED; PG8_LDA(At, 1, 0); PG8_STAGEA(PG8_SA(0, 1), VA, 1, k2);
            PG8_WAIT_V(8); PG8_WAIT_L(0); PG8_BAR; PG8_MMA(0, 0, At, B0); PG8_MMA(0, 1, At, B1); PG8_BAR; PG8_SCHED;
            PG8_LDA(At, 1, 1); PG8_STAGE(PG8_SB(1, 0), b3, voffB); PG8_STAGE(PG8_SB(1, 1), b3 + hstep, voffB); PG8_STAGEA(PG8_SA(1, 0), VA, 0, k2 + kstep);
            PG8_WAIT_V(8); PG8_WAIT_L(0); PG8_BAR; PG8_MMA(1, 0, At, B0); PG8_MMA(1, 1, At, B1); PG8_BAR; PG8_SCHED;
            }
        }
        if constexpr (ALIGN_EPI) { if (wr == 0) PG8_BAR; }
        if constexpr (!Epi::AFTER_DRAIN) { E(acc, cur, wr, wc, fr, fq); S.done(cur); }
        if (!has_next) break;
#pragma unroll
        for (int a = 0; a < 2; ++a)
#pragma unroll
            for (int b = 0; b < 2; ++b)
#pragma unroll
                for (int m = 0; m < 4; ++m)
#pragma unroll
                    for (int n = 0; n < 2; ++n) acc[a][b][m][n] = (f32x4){0.f, 0.f, 0.f, 0.f};
        cur = nxt; cB = nB; ++ui;
        if constexpr (ALIGN_EPI) { if (wr == 1) PG8_BAR; }
    }
    PG8_WAIT_V(0);
    if constexpr (!ALIGN_EPI) { if (wr == 0) PG8_BAR; }
    PG8_BAR;
    if constexpr (Epi::AFTER_DRAIN) { E.fused(acc, cur, wr, wc, fr, fq, lds, wid, lane); S.done(cur); }
#undef PG8_SA
#undef PG8_SB
#undef PG8_STAGE
#undef PG8_STAGEA
#undef PG8_LDA
#undef PG8_LDB
#undef PG8_MMA
#undef PG8_WAIT_V
#undef PG8_WAIT_L
#undef PG8_BAR
#undef PG8_SCHED
}
}

#include <hip/hip_bf16.h>
namespace attn_body {
using bf16=__hip_bfloat16;
using bf16x8=__attribute__((ext_vector_type(8)))short;
using s16x4=__attribute__((ext_vector_type(4)))short;
using f32x16=__attribute__((ext_vector_type(16)))float;
using u32x4=__attribute__((ext_vector_type(4)))unsigned;
constexpr int BATCH=8,NHEAD=8,SEQ=4352,D=64,DM=512,OPITCH=1024,OCOL0=512,T0=2,XROWS=4096;
constexpr int NW=8,QBLK=32,QB=QBLK*NW,KVBLK=64,NQB=SEQ/QB;
constexpr int ATTN_PITCH=DM, ATTN_UNIT_ROWS=QB;
__device__ __forceinline__ int crow(int r,int hi){return (r&3)+8*(r>>2)+4*hi;}
#define SBAR() __builtin_amdgcn_sched_barrier(0)
__device__ __forceinline__ void cmask(f32x16&p0,f32x16&p1,int jb,int qrel,int hi){
  const float NEG=-INFINITY; int kb=64*jb+4*hi;
  #pragma unroll
  for(int r=0;r<16;++r){int kv=kb+(r&3)+8*(r>>2); if(kv>qrel)p0[r]=NEG; if(kv+32>qrel)p1[r]=NEG;}
}

constexpr int NSLOT=3, SLOTB=8192;
constexpr int LDS_K=0, LDS_V=NSLOT*SLOTB, LDS_WS=2*NSLOT*SLOTB, LDS_OST=LDS_WS+NW*64*4, LDS_BIAS=LDS_OST+NW*4096, LDS_BYTES=LDS_BIAS+SEQ*4;
constexpr float C2=0.125f*1.4426950408889634f;
__device__ __forceinline__ void glds16(const void*gsrc,unsigned lds_dst){unsigned keep;
  asm volatile("s_mov_b32 %0, m0\n\ts_mov_b32 m0, %2\n\ts_nop 0\n\tglobal_load_lds_dwordx4 %1, off\n\ts_mov_b32 m0, %0":"=&s"(keep):"v"(gsrc),"s"(lds_dst):"memory");}
__device__ __forceinline__ float max3f(float a,float b,float c){float r;asm("v_max3_f32 %0, %1, %2, %3":"=v"(r):"v"(a),"v"(b),"v"(c));return r;}
__device__ __forceinline__ float max2f(float a,float b){float r;asm("v_max_f32_e32 %0, %1, %2":"=v"(r):"v"(a),"v"(b));return r;}
__device__ __forceinline__ float fadd_s(float a,float b){float r;asm("v_add_f32_e32 %0, %1, %2":"=v"(r):"v"(a),"v"(b));return r;}
__device__ __forceinline__ float fsub_s(float a,float b){float r;asm("v_sub_f32_e32 %0, %1, %2":"=v"(r):"v"(a),"v"(b));return r;}
typedef float f32x2_t __attribute__((ext_vector_type(2))); typedef __bf16 bf16x2_t __attribute__((ext_vector_type(2)));
__device__ __forceinline__ unsigned cvtpk_s(float lo,float hi){f32x2_t v={lo,hi};bf16x2_t b=__builtin_convertvector(v,bf16x2_t);return __builtin_bit_cast(unsigned,b);}
#define WAIT_BAR(N) asm volatile("s_waitcnt vmcnt(" #N ") lgkmcnt(0)\n\ts_barrier":::"memory")

__device__ __forceinline__ void qkt(f32x16&p0,f32x16&p1,const char*Kslot,const bf16x8*qr,const f32x16 c0in,const f32x16 c1in,int r32,int hi){
  const char*kb=Kslot+hi*1024+r32*16;
  #pragma unroll
  for(int d0=0;d0<4;++d0){
    const bf16x8 b0=*reinterpret_cast<const bf16x8*>(kb+d0*2048);
    const bf16x8 b1=*reinterpret_cast<const bf16x8*>(kb+d0*2048+512);
    if(d0==0){p0=__builtin_amdgcn_mfma_f32_32x32x16_bf16(b0,qr[0],c0in,0,0,0);p1=__builtin_amdgcn_mfma_f32_32x32x16_bf16(b1,qr[0],c1in,0,0,0);}
    else{p0=__builtin_amdgcn_mfma_f32_32x32x16_bf16(b0,qr[d0],p0,0,0,0);p1=__builtin_amdgcn_mfma_f32_32x32x16_bf16(b1,qr[d0],p1,0,0,0);}}
}
typedef __attribute__((address_space(3))) const char* lds_cptr;
typedef short v4i16_t __attribute__((ext_vector_type(4)));
__device__ __forceinline__ void kload8(bf16x8*kf,lds_cptr kp){
  kf[0]=*(const __attribute__((address_space(3))) bf16x8*)(kp);      kf[1]=*(const __attribute__((address_space(3))) bf16x8*)(kp+512);
  kf[2]=*(const __attribute__((address_space(3))) bf16x8*)(kp+2048); kf[3]=*(const __attribute__((address_space(3))) bf16x8*)(kp+2560);
  kf[4]=*(const __attribute__((address_space(3))) bf16x8*)(kp+4096); kf[5]=*(const __attribute__((address_space(3))) bf16x8*)(kp+4608);
  kf[6]=*(const __attribute__((address_space(3))) bf16x8*)(kp+6144); kf[7]=*(const __attribute__((address_space(3))) bf16x8*)(kp+6656);
}
__device__ __forceinline__ void kload2(bf16x8*kf,lds_cptr kp,int j){ kf[2*j]=*(const __attribute__((address_space(3))) bf16x8*)(kp+j*2048); kf[2*j+1]=*(const __attribute__((address_space(3))) bf16x8*)(kp+j*2048+512); }
__device__ __forceinline__ s16x4 vtr(lds_cptr p){ return __builtin_bit_cast(s16x4,__builtin_amdgcn_ds_read_tr16_b64_v4i16((__attribute__((address_space(3))) v4i16_t*)p)); }
__device__ __forceinline__ float rowmax(const f32x16&p0,const f32x16&p1){
  float a=max3f(p0[0],p0[1],p1[0]),b=max3f(p0[2],p0[3],p1[1]);a=max3f(a,p1[2],p1[3]);
  #pragma unroll
  for(int r=4;r<16;r+=4){a=max3f(a,p0[r],p0[r+1]);b=max3f(b,p0[r+2],p0[r+3]);a=max3f(a,p1[r],p1[r+1]);b=max3f(b,p1[r+2],p1[r+3]);}
  const float m=max2f(a,b);
  auto rr=__builtin_amdgcn_permlane32_swap(__float_as_uint(m),__float_as_uint(m),false,false);
  return max2f(__uint_as_float(rr[0]),__uint_as_float(rr[1]));
}
__device__ __forceinline__ void pv(f32x16*o,int vb,bf16x8 pa0,bf16x8 pa1,bf16x8 pa2,bf16x8 pa3){
  #pragma unroll
  for(int d0=0;d0<2;++d0){s16x4 lo[4],hi[4];
    #pragma unroll
    for(int ks=0;ks<4;++ks){
      asm volatile("ds_read_b64_tr_b16 %0,%1 offset:%c2":"=&v"(lo[ks]):"v"(vb),"i"(d0*4096+ks*1024):"memory");
      asm volatile("ds_read_b64_tr_b16 %0,%1 offset:%c2":"=&v"(hi[ks]):"v"(vb),"i"(d0*4096+ks*1024+512):"memory");}
    asm volatile("s_waitcnt lgkmcnt(0)":::"memory");SBAR();
    #define PK(k) (bf16x8){lo[k][0],lo[k][1],lo[k][2],lo[k][3],hi[k][0],hi[k][1],hi[k][2],hi[k][3]}
    o[d0]=__builtin_amdgcn_mfma_f32_32x32x16_bf16(pa0,PK(0),o[d0],0,0,0);
    o[d0]=__builtin_amdgcn_mfma_f32_32x32x16_bf16(pa1,PK(1),o[d0],0,0,0);
    o[d0]=__builtin_amdgcn_mfma_f32_32x32x16_bf16(pa2,PK(2),o[d0],0,0,0);
    o[d0]=__builtin_amdgcn_mfma_f32_32x32x16_bf16(pa3,PK(3),o[d0],0,0,0);
    #undef PK
  }
}

#ifndef ATTN_STORE16
#define ATTN_STORE16(p,v) (*(u32x4*)(p)=(v))
#endif
typedef float f32x4v __attribute__((ext_vector_type(4)));
template<int THRL> __device__ __forceinline__ void attn_unit(int b,int h,int qb,unsigned char*ws,char*shm,int tid_in){
  const bf16*Q=(const bf16*)(ws+WS_RQ)+4*BUFE; const bf16*__restrict__ K=Q+BUFE; const bf16*__restrict__ V=Q+2*BUFE; const float*__restrict__ BIAS=(const float*)(ws+WS_BIAS); bf16*O=(bf16*)(ws+WS_MIXED);
  const int tid=tid_in,lane=tid&63,r32=lane&31,hi=lane>>5; const int wid=__builtin_amdgcn_readfirstlane(tid>>6);
  const long rowbase=(long)b*SEQ; const int q0=(qb+1)*QB;
  const bf16*Qw=Q+(rowbase+q0+wid*QBLK)*DM+h*D;
  const bf16*Kh=K+(rowbase+T0*KVBLK)*DM+h*D; const bf16*Vh=V+(rowbase+T0*KVBLK)*DM+h*D;
  int tskip=0; float sbound=0.f;
  int NT=(q0+QB)/KVBLK-T0;
  { const float*ba=BIAS+(long)(b*NHEAD+h)*SEQ; const unsigned*qk=(const unsigned*)(ws+WS_CTL)+CW_QK2+2*(b*NHEAD+h);
    sbound=sqrtf(__uint_as_float(qk[0])*__uint_as_float(qk[1])); const float thr=2.f*sbound+40.f; const float bq0=ba[q0];
    const int cand=2*lane; bool ok=false; if(cand>=2&&cand<=NT-4){int pe=T0*KVBLK+cand*KVBLK-1; if(pe<256)pe=143; ok=(bq0-ba[pe])>thr;}
    const unsigned long long mk=__ballot(ok); const int ts=__builtin_amdgcn_readfirstlane(mk?2*(63-__builtin_clzll(mk)):0);
    Kh+=(long)ts*KVBLK*DM; Vh+=(long)ts*KVBLK*DM; NT-=ts; tskip=ts; }
  const unsigned lds0=(unsigned)(uintptr_t)shm;
  float*wsf=(float*)(shm+LDS_WS)+wid*64;
  const bf16*ksrc=Kh+(long)lane*DM+wid*8;
  const bf16*vsrc=Vh+(long)(16*(wid&3)+(lane>>2))*DM+(wid>>2)*32+(lane&3)*8;
  const unsigned kdst=lds0+LDS_K+wid*1024, vdst=lds0+LDS_V+wid*1024;
  #define DMA_K(t,slot) glds16(ksrc+(long)(t)*KVBLK*DM,(unsigned)__builtin_amdgcn_readfirstlane(kdst+(slot)))
  #define DMA_V(t,slot) glds16(vsrc+(long)(t)*KVBLK*DM,(unsigned)__builtin_amdgcn_readfirstlane(vdst+(slot)))
  const int vb0=(int)(lds0+LDS_V)+((lane>>4)&1)*32+(lane&3)*8+(4*hi+((lane&15)>>2))*64;
  const char*Kbase=shm+LDS_K; bf16x8 kf[8];
  const lds_cptr shm3=(lds_cptr)shm; const lds_cptr kp0=shm3+LDS_K+hi*1024+r32*16; const lds_cptr vp0=shm3+LDS_V+((lane>>4)&1)*32+(lane&3)*8+(4*hi+((lane&15)>>2))*64;
  { const float*bsrc=BIAS+(long)(b*NHEAD+h)*SEQ+(T0+tskip)*KVBLK; float*bl=(float*)(shm+LDS_BIAS); const int nb=NT*KVBLK; for(int p=tid;p<nb;p+=NW*64)bl[p]=bsrc[p]; }
  const __attribute__((address_space(3))) float* bl3=(const __attribute__((address_space(3))) float*)((lds_cptr)shm+LDS_BIAS);
  #define BIASLD(C0,C1,t) do{ const __attribute__((address_space(3))) f32x4v* bp_=(const __attribute__((address_space(3))) f32x4v*)(bl3+(t)*KVBLK+4*hi); \
    _Pragma("unroll") for(int g_=0;g_<4;++g_){ const f32x4v x0_=bp_[2*g_],x1_=bp_[8+2*g_]; \
      C0[4*g_]=x0_[0]-mhat;C0[4*g_+1]=x0_[1]-mhat;C0[4*g_+2]=x0_[2]-mhat;C0[4*g_+3]=x0_[3]-mhat; C1[4*g_]=x1_[0]-mhat;C1[4*g_+1]=x1_[1]-mhat;C1[4*g_+2]=x1_[2]-mhat;C1[4*g_+3]=x1_[3]-mhat; } }while(0)
  DMA_K(0,0);DMA_V(0,0);DMA_K(1,SLOTB);
  bf16x8 qr[4];
  #pragma unroll
  for(int d0=0;d0<4;++d0)qr[d0]=*reinterpret_cast<const bf16x8*>(&Qw[(long)r32*DM+d0*16+hi*8]);
  float mhat=BIAS[(long)(b*NHEAD+h)*SEQ+q0+wid*QBLK+r32]+sbound,l_reg=0.f;f32x16 o[2];o[0]=f32x16{};o[1]=f32x16{};
  const int qrel=wid*QBLK+r32;
  #define CMASK(P0,P1,t) do{int jb_=(t)-(NT-4); if(jb_>=0)cmask(P0,P1,jb_,qrel,hi);}while(0)
  #define START(P0,P1) do{ _Pragma("unroll") for(int r=0;r<16;++r)P0[r]=__builtin_amdgcn_exp2f(P0[r]); }while(0)
  #define RESC() do{}while(0)
  f32x16 pA0,pA1,pB0,pB1;
  int sl_prev=0,sl_cur=0,sl_next=SLOTB;
  #define ROT() do{sl_prev=sl_cur;sl_cur=sl_next;sl_next=(sl_next==(NSLOT-1)*SLOTB)?0:sl_next+SLOTB;}while(0)
  DMA_K(2,2*SLOTB);
  WAIT_BAR(3);
  BIASLD(pA0,pA1,0);qkt(pA0,pA1,Kbase,qr,pA0,pA1,r32,hi);asm volatile("s_nop 15\n\ts_nop 7":"+v"(pA0),"+v"(pA1));CMASK(pA0,pA1,0);
  START(pA0,pA1);
  _Pragma("unroll") for(int r=0;r<16;++r)pA1[r]=__builtin_amdgcn_exp2f(pA1[r]);
  WAIT_BAR(0);
  DMA_K(3,0);DMA_V(1,SLOTB);
  ROT();
  kload8(kf,kp0+sl_cur);
  WAIT_BAR(2);
  s16x4 vlo[8],vhi[8]; u32x4 pw0,pw1,pw2,pw3;
  #define PKW(P,B) cvtpk_s(P[B],P[B+1])
  #define PAF(k) __builtin_bit_cast(bf16x8,pw##k)
  #define VFR(i) (bf16x8){vlo[i][0],vlo[i][1],vlo[i][2],vlo[i][3],vhi[i][0],vhi[i][1],vhi[i][2],vhi[i][3]}
  #define PIN(x) asm volatile("":"+v"(x))
  #define MX3(a,b,c) __builtin_fmaxf(__builtin_fmaxf((a),(b)),(c))
  #define GAPA(MF,A0,A1,A2,A3,W0,W1,PW) do{ MF; sacc+=A0; sacc+=A1; sacc+=A2; sacc+=A3; PIN(sacc); W0; W1; PIN(PW); SBAR(); }while(0)
  #define EX(v) __builtin_amdgcn_exp2f(v)
  #define GAPB(MF,X,B) do{ MF; X[B]=EX(X[B]); X[B+1]=EX(X[B+1]); X[B+2]=EX(X[B+2]); X[B+3]=EX(X[B+3]); PIN(X); SBAR(); }while(0)
  #define VRD(i) do{ vlo[i]=vtr(vp_+(((i)>>2)*4096+((i)&3)*1024)); vhi[i]=vtr(vp_+(((i)>>2)*4096+((i)&3)*1024+512)); }while(0)
  #define KRD(G,j) do{ if(G){ kload2(kf,kp0+sl_next,j); SBAR(); } }while(0)
  #define STEP(C0,C1,P0,P1,t,GK,GV,GL) do{ BIASLD(C0,C1,t); SBAR(); \
    const lds_cptr vp_=vp0+sl_prev; \
    VRD(0); SBAR(); float sacc=(P0[0]+P0[1]); \
    GAPA(C0=__builtin_amdgcn_mfma_f32_32x32x16_bf16(kf[0],qr[0],C0,0,0,0), P0[2],P0[3],P0[4],P0[5],     pw0[0]=PKW(P0,0), pw0[1]=PKW(P0,2), pw0); \
    VRD(4); SBAR(); GAPA(C1=__builtin_amdgcn_mfma_f32_32x32x16_bf16(kf[1],qr[0],C1,0,0,0), P0[6],P0[7],P0[8],P0[9],     pw0[2]=PKW(P0,4), pw0[3]=PKW(P0,6), pw0); \
    VRD(1); SBAR(); GAPA(C0=__builtin_amdgcn_mfma_f32_32x32x16_bf16(kf[2],qr[1],C0,0,0,0),   P0[10],P0[11],P0[12],P0[13], pw1[0]=PKW(P0,8), pw1[1]=PKW(P0,10), pw1); \
    VRD(5); SBAR(); GAPA(C1=__builtin_amdgcn_mfma_f32_32x32x16_bf16(kf[3],qr[1],C1,0,0,0),   P0[14],P0[15],P1[0],P1[1],   pw1[2]=PKW(P0,12),pw1[3]=PKW(P0,14), pw1); \
    VRD(2); SBAR(); GAPA(C0=__builtin_amdgcn_mfma_f32_32x32x16_bf16(kf[4],qr[2],C0,0,0,0),   P1[2],P1[3],P1[4],P1[5],     pw2[0]=PKW(P1,0), pw2[1]=PKW(P1,2), pw2); \
    VRD(6); SBAR(); GAPA(C1=__builtin_amdgcn_mfma_f32_32x32x16_bf16(kf[5],qr[2],C1,0,0,0),   P1[6],P1[7],P1[8],P1[9],     pw2[2]=PKW(P1,4), pw2[3]=PKW(P1,6), pw2); \
    VRD(3); SBAR(); GAPA(C0=__builtin_amdgcn_mfma_f32_32x32x16_bf16(kf[6],qr[3],C0,0,0,0),   P1[10],P1[11],P1[12],P1[13], pw3[0]=PKW(P1,8), pw3[1]=PKW(P1,10), pw3); \
    VRD(7); SBAR(); GAPA(C1=__builtin_amdgcn_mfma_f32_32x32x16_bf16(kf[7],qr[3],C1,0,0,0),   P1[14],P1[15],0.f,0.f,       pw3[2]=PKW(P1,12),pw3[3]=PKW(P1,14), pw3); \
    l_reg+=sacc; \
    if(GK){DMA_K((t)+3,sl_cur);} if(GV){DMA_V((t)+1,sl_next);} \
    CMASK(C0,C1,t); \
    SBAR(); \
    GAPB(o[0]=__builtin_amdgcn_mfma_f32_32x32x16_bf16(PAF(0),VFR(0),o[0],0,0,0), C0,0); \
    GAPB(o[1]=__builtin_amdgcn_mfma_f32_32x32x16_bf16(PAF(0),VFR(4),o[1],0,0,0), C0,4); \
    KRD(GL,0); GAPB(o[0]=__builtin_amdgcn_mfma_f32_32x32x16_bf16(PAF(1),VFR(1),o[0],0,0,0), C0,8); \
    KRD(GL,1); GAPB(o[1]=__builtin_amdgcn_mfma_f32_32x32x16_bf16(PAF(1),VFR(5),o[1],0,0,0), C0,12); \
    KRD(GL,2); GAPB(o[0]=__builtin_amdgcn_mfma_f32_32x32x16_bf16(PAF(2),VFR(2),o[0],0,0,0), C1,0); \
    KRD(GL,3); GAPB(o[1]=__builtin_amdgcn_mfma_f32_32x32x16_bf16(PAF(2),VFR(6),o[1],0,0,0), C1,4); \
    GAPB(o[0]=__builtin_amdgcn_mfma_f32_32x32x16_bf16(PAF(3),VFR(3),o[0],0,0,0), C1,8); \
    GAPB(o[1]=__builtin_amdgcn_mfma_f32_32x32x16_bf16(PAF(3),VFR(7),o[1],0,0,0), C1,12); \
    }while(0)
  int t=1;
  #undef CMASK
  #define CMASK(P0,P1,t) do{}while(0)
  for(;t+5<NT;t+=2){
    STEP(pB0,pB1,pA0,pA1,t,true,true,true);     WAIT_BAR(2); RESC(); ROT();
    STEP(pA0,pA1,pB0,pB1,t+1,true,true,true);   WAIT_BAR(2); RESC(); ROT();
  }
  #undef CMASK
  #define CMASK(P0,P1,t) do{int jb_=(t)-(NT-4); if(jb_>=0)cmask(P0,P1,jb_,qrel,hi);}while(0)
  #define ENDW(tt) do{ if((tt)+3<NT){WAIT_BAR(2);} else if((tt)+2<NT){WAIT_BAR(1);} else {WAIT_BAR(0);} }while(0)
  for(;t+1<NT;t+=2){
    STEP(pB0,pB1,pA0,pA1,t,(t+3<NT),(t+1<NT),(t+1<NT));       ENDW(t);   RESC(); ROT();
    STEP(pA0,pA1,pB0,pB1,t+1,(t+4<NT),(t+2<NT),(t+2<NT));     ENDW(t+1); RESC(); ROT();
  }
  STEP(pB0,pB1,pA0,pA1,NT-1,false,false,false); RESC();
  { float sacc=pB0[0]+pB0[1]; _Pragma("unroll") for(int r=2;r<16;++r)sacc+=pB0[r]; _Pragma("unroll") for(int r=0;r<16;++r)sacc+=pB1[r]; l_reg+=sacc;
    pw0=(u32x4){PKW(pB0,0),PKW(pB0,2),PKW(pB0,4),PKW(pB0,6)};pw1=(u32x4){PKW(pB0,8),PKW(pB0,10),PKW(pB0,12),PKW(pB0,14)};pw2=(u32x4){PKW(pB1,0),PKW(pB1,2),PKW(pB1,4),PKW(pB1,6)};pw3=(u32x4){PKW(pB1,8),PKW(pB1,10),PKW(pB1,12),PKW(pB1,14)};
    SBAR(); pv(o,vb0+sl_cur,PAF(0),PAF(1),PAF(2),PAF(3)); }
  #undef PKW
  #undef PAF
  #undef VFR
  #undef PIN
  #undef MX3
  #undef GAPA
  #undef GAPB
  #undef EX
  #undef VRD
  #undef KRD
  #undef STEP
  #undef ENDW
  {auto rr=__builtin_amdgcn_permlane32_swap(__float_as_uint(l_reg),__float_as_uint(l_reg),false,false);l_reg=__uint_as_float(rr[0])+__uint_as_float(rr[1]);}
  if(hi==0)wsf[32+r32]=l_reg;asm volatile("s_waitcnt lgkmcnt(0)":::"memory");
  float rli[16];
  #pragma unroll
  for(int r=0;r<16;++r)rli[r]=__builtin_amdgcn_rcpf(wsf[32+crow(r,hi)]);
  bf16*Ow=O+((long)b*XROWS+qb*QB+wid*QBLK)*OPITCH+OCOL0+h*D;
  { bf16*stg=(bf16*)(shm+LDS_OST)+wid*2048;
    #pragma unroll
    for(int r=0;r<16;++r){const int orow=crow(r,hi);
      #pragma unroll
      for(int d0=0;d0<2;++d0)stg[orow*64+d0*32+r32]=__float2bfloat16(o[d0][r]*rli[r]);}
    asm volatile("s_waitcnt lgkmcnt(0)":::"memory");
    #pragma unroll
    for(int i=0;i<4;++i){const int row=i*8+(lane>>3),ch=lane&7; const u32x4 v=*(const u32x4*)(stg+row*64+ch*8); ATTN_STORE16(Ow+(long)row*OPITCH+ch*8,v);} }
  asm volatile("s_waitcnt lgkmcnt(0)\n\ts_barrier":::"memory");
  #undef DMA_K
  #undef DMA_V
  #undef CMASK
  #undef BIASLD
  #undef START
  #undef RESC
  #undef ROT
}
constexpr int ATTN_LDS_BYTES=LDS_BYTES;
struct AttnTensors { const bf16* Q; const bf16* K; const bf16* V; const float* BIAS; bf16* O; };
struct AttnUnit { int bh; int qb; };
struct StaticOrder {
  int vcu, grid;
  __device__ __forceinline__ explicit StaticOrder(int grid_,int block):vcu((grid_%8==0)?(block%8)*(grid_/8)+block/8:block),grid(grid_){}
  __device__ __forceinline__ bool next(int i,AttnUnit&u)const{
    if(grid==256){ if(i>=4)return false; const int s=vcu&3; u.bh=vcu>>2; u.qb=(i==0)?15-s:(i==1)?8+s:(i==2)?7-s:s; return true; }
    const int L=i*grid+vcu; if(L>=BATCH*NHEAD*16)return false; u.bh=L>>4; u.qb=15-(L&15); return true; }
  __device__ __forceinline__ void a_ready(const AttnUnit&)const{}
  __device__ __forceinline__ void done(const AttnUnit&)const{}
};
template<class Sched,int THRL=8> __device__ __forceinline__ void attn_phase(char*lds,const AttnTensors&T,const Sched&S){
  AttnUnit u;
  for(int i=0;S.next(i,u);++i){ S.a_ready(u); attn_unit<THRL>(u.bh/NHEAD,u.bh%NHEAD,u.qb,(unsigned char*)T.O,lds,(int)threadIdx.x);    S.done(u); }
}
#undef SBAR
#undef WAIT_BAR
}


namespace ret_body {
typedef __attribute__((address_space(3))) const char* lds_cptr;
using bf16x8 = __attribute__((ext_vector_type(8))) short;
using s16x4 = __attribute__((ext_vector_type(4))) short;
using f32x16 = __attribute__((ext_vector_type(16))) float;
using u32x4 = __attribute__((ext_vector_type(4))) unsigned;
using u32x2 = __attribute__((ext_vector_type(2))) unsigned;
typedef short v4i16_t __attribute__((ext_vector_type(4)));
#define RLAS __attribute__((address_space(3)))
constexpr int TQ = 0, TK = 32768, TV = 65536, TS = 98304;
__device__ __forceinline__ unsigned off_b(unsigned row, unsigned ch) { return 256u * row + 16u * (ch ^ (((row & 3u) << 2) | ((row >> 2) & 3u))); }
__device__ __forceinline__ int crow(int r, int hi) { return (r & 3) + 8 * (r >> 2) + 4 * hi; }
__device__ __forceinline__ bf16x8 ldrow(lds_cptr tile, unsigned row, unsigned ch) { return *(const RLAS bf16x8*)(tile + off_b(row, ch)); }
__device__ __forceinline__ s16x4 ldtr(lds_cptr p) { return __builtin_bit_cast(s16x4, __builtin_amdgcn_ds_read_tr16_b64_v4i16((RLAS v4i16_t*)p)); }
__device__ __forceinline__ bf16x8 trfrag_nat(lds_cptr tile, unsigned lane, unsigned c, unsigned row0) {
    const unsigned h = lane >> 5, blk = (lane >> 4) & 1, q = (lane & 15) >> 2, p = lane & 3, ch = 4 * c + 2 * blk + (p >> 1), ob = 8 * (p & 1);
    const s16x4 lo = ldtr(tile + off_b(row0 + 8 * h + q, ch) + ob), hi = ldtr(tile + off_b(row0 + 8 * h + 4 + q, ch) + ob);
    return (bf16x8){lo[0], lo[1], lo[2], lo[3], hi[0], hi[1], hi[2], hi[3]};
}
__device__ __forceinline__ bf16x8 trfrag_acc(lds_cptr tile, unsigned lane, unsigned c, unsigned row0) {
    const unsigned h = lane >> 5, blk = (lane >> 4) & 1, q = (lane & 15) >> 2, p = lane & 3, ch = 4 * c + 2 * blk + (p >> 1), ob = 8 * (p & 1);
    const s16x4 lo = ldtr(tile + off_b(row0 + 4 * h + q, ch) + ob), hi = ldtr(tile + off_b(row0 + 8 + 4 * h + q, ch) + ob);
    return (bf16x8){lo[0], lo[1], lo[2], lo[3], hi[0], hi[1], hi[2], hi[3]};
}
typedef float f32x2_t __attribute__((ext_vector_type(2))); typedef __bf16 bf16x2_t __attribute__((ext_vector_type(2)));
__device__ __forceinline__ unsigned cvtpk(float lo, float hi) { f32x2_t v = {lo, hi}; bf16x2_t b = __builtin_convertvector(v, bf16x2_t); return __builtin_bit_cast(unsigned, b); }
__device__ __forceinline__ float bflo(unsigned u) { return __uint_as_float(u << 16); }
__device__ __forceinline__ float bfhi(unsigned u) { return __uint_as_float(u & 0xffff0000u); }
#define RMFMA(a, b, c) __builtin_amdgcn_mfma_f32_32x32x16_bf16(a, b, c, 0, 0, 0)

__device__ __forceinline__ void ret_unit(int b, int h, unsigned char* ws, char* shm, int tid_in) {
    const unsigned short* __restrict__ RQ = (const unsigned short*)(ws + WS_RQ); const unsigned short* __restrict__ RK = RQ + BUFE; const unsigned short* __restrict__ RV = RQ + 2 * BUFE; const unsigned short* __restrict__ RG = RQ + 3 * BUFE;
    unsigned short* MIXED = (unsigned short*)(ws + WS_MIXED); float* xch = (float*)(shm + 131072 + 1024);
    int tid = tid_in; const int wid = __builtin_amdgcn_readfirstlane(tid >> 6); const int ib = wid >> 1, ep = wid & 1;
    const lds_cptr s3 = (lds_cptr)shm; const lds_cptr Qt = s3 + TQ, Kt = s3 + TK, Vt = s3 + TV, St = s3 + TS;
    RLAS char* w3 = (RLAS char*)shm;
    const float lg = log2f(1.f - exp2f(-5.f - (float)h));
    const float g128 = exp2f(128.f * lg);
    f32x16 st0 = {}, st1 = {};
    const size_t rowbase = (size_t)b * LT;
    for (int i = tid; i < 2048; i += 512) *(RLAS u32x4*)(w3 + TS + 16 * i) = (u32x4){0u, 0u, 0u, 0u};
    for (int c = 1; c <= 33; ++c) {
        asm volatile("" : "+v"(tid));
        const int lane = tid & 63, r32 = lane & 31, hi = lane >> 5;
        const float xi = __builtin_amdgcn_exp2f((float)(32 * ib + r32 + 1) * lg);
#pragma unroll
        for (int i = 0; i < 4; ++i) {
            const int n = tid + 512 * i, row = n >> 4, ch = n & 15; const size_t go = (rowbase + 128 * c + row) * 512 + h * 128 + 8 * ch;
            u32x4 q = *(const u32x4*)(RQ + go), k = *(const u32x4*)(RK + go), v = *(const u32x4*)(RV + go);
            if (c == 1 && row < 112) { k = (u32x4){0u, 0u, 0u, 0u}; v = k; q = k; }
            const unsigned o = off_b(row, ch);
            *(RLAS u32x4*)(w3 + TQ + o) = q; *(RLAS u32x4*)(w3 + TK + o) = k; *(RLAS u32x4*)(w3 + TV + o) = v;
        }
        __syncthreads();
        bf16x8 qf[8];
#pragma unroll
        for (int s = 0; s < 8; ++s) qf[s] = ldrow(Qt, 32 * ib + r32, 2 * s + hi);
        f32x16 o0 = {}, o1 = {};
        if (c > 1) {
#pragma unroll
            for (int s = 0; s < 8; ++s) { const bf16x8 a0 = ldrow(St, 64 * ep + r32, 2 * s + hi), a1 = ldrow(St, 64 * ep + 32 + r32, 2 * s + hi); o0 = RMFMA(a0, qf[s], o0); o1 = RMFMA(a1, qf[s], o1); if (s & 1) __builtin_amdgcn_sched_barrier(0); }
        }
        for (int jb = 0; jb <= ib; ++jb) {
            f32x16 S = {};
#pragma unroll
            for (int s = 0; s < 8; ++s) { const bf16x8 kf = ldrow(Kt, 32 * jb + r32, 2 * s + hi); S = RMFMA(kf, qf[s], S); if ((s & 3) == 3) __builtin_amdgcn_sched_barrier(0); }
#pragma unroll
            for (int r = 0; r < 16; ++r) { float pv = S[r] * __builtin_amdgcn_exp2f(-(float)(32 * jb + crow(r, hi) + 1) * lg); if (jb == ib && crow(r, hi) > r32) pv = 0.f; S[r] = pv; }
            const u32x4 w0 = {cvtpk(S[0], S[1]), cvtpk(S[2], S[3]), cvtpk(S[4], S[5]), cvtpk(S[6], S[7])}, w1 = {cvtpk(S[8], S[9]), cvtpk(S[10], S[11]), cvtpk(S[12], S[13]), cvtpk(S[14], S[15])};
            const bf16x8 p0 = __builtin_bit_cast(bf16x8, w0), p1 = __builtin_bit_cast(bf16x8, w1);
            __builtin_amdgcn_sched_barrier(0);
            { const bf16x8 a0 = trfrag_acc(Vt, lane, 2 * ep, 32 * jb), a1 = trfrag_acc(Vt, lane, 2 * ep, 32 * jb + 16); o0 = RMFMA(a0, p0, o0); o0 = RMFMA(a1, p1, o0); }
            { const bf16x8 a0 = trfrag_acc(Vt, lane, 2 * ep + 1, 32 * jb), a1 = trfrag_acc(Vt, lane, 2 * ep + 1, 32 * jb + 16); o1 = RMFMA(a0, p0, o1); o1 = RMFMA(a1, p1, o1); }
            __builtin_amdgcn_sched_barrier(0);
        }
        float s1 = 0.f, s2 = 0.f;
#pragma unroll
        for (int r = 0; r < 16; ++r) { o0[r] *= xi; o1[r] *= xi; s1 += o0[r] + o1[r]; s2 += o0[r] * o0[r] + o1[r] * o1[r]; }
        s1 += __shfl_xor(s1, 32); s2 += __shfl_xor(s2, 32);
        if (hi == 0) { xch[(wid * 32 + r32) * 2] = s1; xch[(wid * 32 + r32) * 2 + 1] = s2; }
#pragma unroll
        for (int r = 0; r < 16; ++r) { st0[r] *= g128; st1[r] *= g128; }
#pragma unroll
        for (int ks = 0; ks < 8; ++ks) {
            const bf16x8 kr = trfrag_nat(Kt, lane, ib, 16 * ks);
            const float zx = (float)(127 - 16 * ks - 8 * hi) * lg;
#define ZF(j) __builtin_amdgcn_exp2f(zx - (float)(j) * lg)
            const u32x4 ku = __builtin_bit_cast(u32x4, kr);
            const u32x4 kz = {cvtpk(bflo(ku[0]) * ZF(0), bfhi(ku[0]) * ZF(1)), cvtpk(bflo(ku[1]) * ZF(2), bfhi(ku[1]) * ZF(3)),
                              cvtpk(bflo(ku[2]) * ZF(4), bfhi(ku[2]) * ZF(5)), cvtpk(bflo(ku[3]) * ZF(6), bfhi(ku[3]) * ZF(7))};
#undef ZF
            const bf16x8 ka = __builtin_bit_cast(bf16x8, kz);
            const bf16x8 v0 = trfrag_nat(Vt, lane, 2 * ep, 16 * ks), v1 = trfrag_nat(Vt, lane, 2 * ep + 1, 16 * ks);
            st0 = RMFMA(ka, v0, st0); st1 = RMFMA(ka, v1, st1);
            __builtin_amdgcn_sched_barrier(0);
        }
        __syncthreads();
        { const float* xp = xch + ((wid ^ 1) * 32 + r32) * 2; s1 += xp[0]; s2 += xp[1]; }
        const float mean = s1 * (1.f / 128.f), var = fmaxf(s2 * (1.f / 128.f) - mean * mean, 0.f), rstd = 1.f / sqrtf(var + LN_EPS);
        if (c >= 2) {
            const size_t grow = (rowbase + 128 * c + 32 * ib + r32) * 512 + h * 128, orow = ((size_t)b * SEQ + 128 * (c - 2) + 32 * ib + r32) * DM + h * 128;
#pragma unroll
            for (int g = 0; g < 4; ++g) {
                { const int e0 = 64 * ep + 8 * g + 4 * hi; const u32x2 gg = *(const u32x2*)(RG + grow + e0);
                  u32x2 w; w[0] = cvtpk((o0[4 * g] - mean) * rstd * bflo(gg[0]), (o0[4 * g + 1] - mean) * rstd * bfhi(gg[0])); w[1] = cvtpk((o0[4 * g + 2] - mean) * rstd * bflo(gg[1]), (o0[4 * g + 3] - mean) * rstd * bfhi(gg[1]));
                  *(u32x2*)(MIXED + orow + e0) = w; }
                { const int e0 = 64 * ep + 32 + 8 * g + 4 * hi; const u32x2 gg = *(const u32x2*)(RG + grow + e0);
                  u32x2 w; w[0] = cvtpk((o1[4 * g] - mean) * rstd * bflo(gg[0]), (o1[4 * g + 1] - mean) * rstd * bfhi(gg[0])); w[1] = cvtpk((o1[4 * g + 2] - mean) * rstd * bflo(gg[1]), (o1[4 * g + 3] - mean) * rstd * bfhi(gg[1]));
                  *(u32x2*)(MIXED + orow + e0) = w; }
            }
        }
#pragma unroll
        for (int g = 0; g < 4; ++g) {
            *(RLAS u32x2*)(w3 + TS + off_b(64 * ep + r32, 4 * ib + g) + 8 * hi) = (u32x2){cvtpk(st0[4 * g], st0[4 * g + 1]), cvtpk(st0[4 * g + 2], st0[4 * g + 3])};
            *(RLAS u32x2*)(w3 + TS + off_b(64 * ep + 32 + r32, 4 * ib + g) + 8 * hi) = (u32x2){cvtpk(st1[4 * g], st1[4 * g + 1]), cvtpk(st1[4 * g + 2], st1[4 * g + 3])};
        }
    }
    __syncthreads();
}

__device__ __forceinline__ void ret_kv_unit(int bh, int c, unsigned char* ws, float* KV, char* shm, int tid_in) {
    const unsigned short* __restrict__ RK = (const unsigned short*)(ws + WS_RQ) + BUFE; const unsigned short* __restrict__ RV = RK + BUFE;
    int tid = tid_in; asm volatile("" : "+v"(tid));
    const int lane = tid & 63, r32 = lane & 31, hi = lane >> 5; const int wid = __builtin_amdgcn_readfirstlane(tid >> 6); const int ib = wid >> 1, ep = wid & 1;
    const int b = bh >> 2, h = bh & 3;
    const lds_cptr s3 = (lds_cptr)shm; const lds_cptr Kt = s3 + TK, Vt = s3 + TV;
    RLAS char* w3 = (RLAS char*)shm;
    const float lg = log2f(1.f - exp2f(-5.f - (float)h));
    const size_t rowbase = (size_t)b * LT;
#pragma unroll
    for (int i = 0; i < 4; ++i) {
        const int n = tid + 512 * i, row = n >> 4, ch = n & 15; const size_t go = (rowbase + 128 * c + row) * 512 + h * 128 + 8 * ch;
        u32x4 k = *(const u32x4*)(RK + go), v = *(const u32x4*)(RV + go);
        if (c == 1 && row < 112) { k = (u32x4){0u, 0u, 0u, 0u}; v = k; }
        const unsigned o = off_b(row, ch);
        *(RLAS u32x4*)(w3 + TK + o) = k; *(RLAS u32x4*)(w3 + TV + o) = v;
    }
    __syncthreads();
    f32x16 st0 = {}, st1 = {};
#pragma unroll
    for (int ks = 0; ks < 8; ++ks) {
        const bf16x8 kr = trfrag_nat(Kt, lane, ib, 16 * ks);
        const float zx = (float)(127 - 16 * ks - 8 * hi) * lg;
#define ZF(j) __builtin_amdgcn_exp2f(zx - (float)(j) * lg)
        const u32x4 ku = __builtin_bit_cast(u32x4, kr);
        const u32x4 kz = {cvtpk(bflo(ku[0]) * ZF(0), bfhi(ku[0]) * ZF(1)), cvtpk(bflo(ku[1]) * ZF(2), bfhi(ku[1]) * ZF(3)),
                          cvtpk(bflo(ku[2]) * ZF(4), bfhi(ku[2]) * ZF(5)), cvtpk(bflo(ku[3]) * ZF(6), bfhi(ku[3]) * ZF(7))};
#undef ZF
        const bf16x8 ka = __builtin_bit_cast(bf16x8, kz);
        const bf16x8 v0 = trfrag_nat(Vt, lane, 2 * ep, 16 * ks), v1 = trfrag_nat(Vt, lane, 2 * ep + 1, 16 * ks);
        st0 = RMFMA(ka, v0, st0); st1 = RMFMA(ka, v1, st1);
        __builtin_amdgcn_sched_barrier(0);
    }
    float* dst = KV + ((size_t)(bh * 33 + c) << 14);
    typedef float f32x4s __attribute__((ext_vector_type(4)));
#pragma unroll
    for (int g = 0; g < 4; ++g) {
        *(f32x4s*)(dst + (64 * ep + r32) * 128 + 32 * ib + 8 * g + 4 * hi) = (f32x4s){st0[4 * g], st0[4 * g + 1], st0[4 * g + 2], st0[4 * g + 3]};
        *(f32x4s*)(dst + (64 * ep + 32 + r32) * 128 + 32 * ib + 8 * g + 4 * hi) = (f32x4s){st1[4 * g], st1[4 * g + 1], st1[4 * g + 2], st1[4 * g + 3]};
    }
    __syncthreads();
}
__device__ __forceinline__ void ret_scan(const float* KV, unsigned short* PREV, int gtid, int nthreads) {
    typedef float f32x4s __attribute__((ext_vector_type(4)));
    for (int grp = gtid; grp < 32 * 4096; grp += nthreads) {
        const int bh = grp >> 12, idx4 = (grp & 4095) * 4, h = bh & 3;
        const float g128 = exp2f(128.f * log2f(1.f - exp2f(-5.f - (float)h)));
        f32x4s sacc = {0.f, 0.f, 0.f, 0.f};
#pragma unroll 4
        for (int c = 1; c <= 32; ++c) {
            const f32x4s kv = *(const f32x4s*)(KV + ((size_t)(bh * 33 + c) << 14) + idx4);
            sacc = sacc * g128 + kv;
            *(u32x2*)(PREV + ((size_t)(bh * 33 + c + 1) << 14) + idx4) = (u32x2){cvtpk(sacc[0], sacc[1]), cvtpk(sacc[2], sacc[3])};
        }
    }
}
__device__ __forceinline__ void ret_out_unit(int bh, int c, unsigned char* ws, const unsigned short* PREV, char* shm, int tid_in) {
    const unsigned short* __restrict__ RQ = (const unsigned short*)(ws + WS_RQ); const unsigned short* __restrict__ RK = RQ + BUFE; const unsigned short* __restrict__ RV = RQ + 2 * BUFE; const unsigned short* __restrict__ RG = RQ + 3 * BUFE;
    unsigned short* MIXED = (unsigned short*)(ws + WS_MIXED); float* xch = (float*)(shm + 131072 + 1024);
    int tid = tid_in; asm volatile("" : "+v"(tid));
    const int lane = tid & 63, r32 = lane & 31, hi = lane >> 5; const int wid = __builtin_amdgcn_readfirstlane(tid >> 6); const int ib = wid >> 1, ep = wid & 1;
    const int b = bh >> 2, h = bh & 3;
    const lds_cptr s3 = (lds_cptr)shm; const lds_cptr Qt = s3 + TQ, Kt = s3 + TK, Vt = s3 + TV, St = s3 + TS;
    RLAS char* w3 = (RLAS char*)shm;
    const float lg = log2f(1.f - exp2f(-5.f - (float)h));
    const size_t rowbase = (size_t)b * LT;
    const unsigned short* pv_ = PREV + ((size_t)(bh * 33 + c) << 14);
#pragma unroll
    for (int i = 0; i < 4; ++i) {
        const int n = tid + 512 * i, row = n >> 4, ch = n & 15; const size_t go = (rowbase + 128 * c + row) * 512 + h * 128 + 8 * ch;
        const u32x4 q = *(const u32x4*)(RQ + go), k = *(const u32x4*)(RK + go), v = *(const u32x4*)(RV + go), p = *(const u32x4*)(pv_ + row * 128 + 8 * ch);
        const unsigned o = off_b(row, ch);
        *(RLAS u32x4*)(w3 + TQ + o) = q; *(RLAS u32x4*)(w3 + TK + o) = k; *(RLAS u32x4*)(w3 + TV + o) = v; *(RLAS u32x4*)(w3 + TS + o) = p;
    }
    __syncthreads();
    const float xi = __builtin_amdgcn_exp2f((float)(32 * ib + r32 + 1) * lg);
    bf16x8 qf[8];
#pragma unroll
    for (int s = 0; s < 8; ++s) qf[s] = ldrow(Qt, 32 * ib + r32, 2 * s + hi);
    f32x16 o0 = {}, o1 = {};
#pragma unroll
    for (int s = 0; s < 8; ++s) { const bf16x8 a0 = ldrow(St, 64 * ep + r32, 2 * s + hi), a1 = ldrow(St, 64 * ep + 32 + r32, 2 * s + hi); o0 = RMFMA(a0, qf[s], o0); o1 = RMFMA(a1, qf[s], o1); if (s & 1) __builtin_amdgcn_sched_barrier(0); }
    for (int jb = 0; jb <= ib; ++jb) {
        f32x16 S = {};
#pragma unroll
        for (int s = 0; s < 8; ++s) { const bf16x8 kf = ldrow(Kt, 32 * jb + r32, 2 * s + hi); S = RMFMA(kf, qf[s], S); if ((s & 3) == 3) __builtin_amdgcn_sched_barrier(0); }
#pragma unroll
        for (int r = 0; r < 16; ++r) { float pv = S[r] * __builtin_amdgcn_exp2f(-(float)(32 * jb + crow(r, hi) + 1) * lg); if (jb == ib && crow(r, hi) > r32) pv = 0.f; S[r] = pv; }
        const u32x4 w0 = {cvtpk(S[0], S[1]), cvtpk(S[2], S[3]), cvtpk(S[4], S[5]), cvtpk(S[6], S[7])}, w1 = {cvtpk(S[8], S[9]), cvtpk(S[10], S[11]), cvtpk(S[12], S[13]), cvtpk(S[14], S[15])};
        const bf16x8 p0 = __builtin_bit_cast(bf16x8, w0), p1 = __builtin_bit_cast(bf16x8, w1);
        __builtin_amdgcn_sched_barrier(0);
        { const bf16x8 a0 = trfrag_acc(Vt, lane, 2 * ep, 32 * jb), a1 = trfrag_acc(Vt, lane, 2 * ep, 32 * jb + 16); o0 = RMFMA(a0, p0, o0); o0 = RMFMA(a1, p1, o0); }
        { const bf16x8 a0 = trfrag_acc(Vt, lane, 2 * ep + 1, 32 * jb), a1 = trfrag_acc(Vt, lane, 2 * ep + 1, 32 * jb + 16); o1 = RMFMA(a0, p0, o1); o1 = RMFMA(a1, p1, o1); }
        __builtin_amdgcn_sched_barrier(0);
    }
    float s1 = 0.f, s2 = 0.f;
#pragma unroll
    for (int r = 0; r < 16; ++r) { o0[r] *= xi; o1[r] *= xi; s1 += o0[r] + o1[r]; s2 += o0[r] * o0[r] + o1[r] * o1[r]; }
    s1 += __shfl_xor(s1, 32); s2 += __shfl_xor(s2, 32);
    if (hi == 0) { xch[(wid * 32 + r32) * 2] = s1; xch[(wid * 32 + r32) * 2 + 1] = s2; }
    __syncthreads();
    { const float* xp = xch + ((wid ^ 1) * 32 + r32) * 2; s1 += xp[0]; s2 += xp[1]; }
    const float mean = s1 * (1.f / 128.f), var = fmaxf(s2 * (1.f / 128.f) - mean * mean, 0.f), rstd = 1.f / sqrtf(var + LN_EPS);
    const size_t grow = (rowbase + 128 * c + 32 * ib + r32) * 512 + h * 128, orow = ((size_t)b * SEQ + 128 * (c - 2) + 32 * ib + r32) * DM + h * 128;
#pragma unroll
    for (int g = 0; g < 4; ++g) {
        { const int e0 = 64 * ep + 8 * g + 4 * hi; const u32x2 gg = *(const u32x2*)(RG + grow + e0);
          u32x2 w; w[0] = cvtpk((o0[4 * g] - mean) * rstd * bflo(gg[0]), (o0[4 * g + 1] - mean) * rstd * bfhi(gg[0])); w[1] = cvtpk((o0[4 * g + 2] - mean) * rstd * bflo(gg[1]), (o0[4 * g + 3] - mean) * rstd * bfhi(gg[1]));
          *(u32x2*)(MIXED + orow + e0) = w; }
        { const int e0 = 64 * ep + 32 + 8 * g + 4 * hi; const u32x2 gg = *(const u32x2*)(RG + grow + e0);
          u32x2 w; w[0] = cvtpk((o1[4 * g] - mean) * rstd * bflo(gg[0]), (o1[4 * g + 1] - mean) * rstd * bfhi(gg[0])); w[1] = cvtpk((o1[4 * g + 2] - mean) * rstd * bflo(gg[1]), (o1[4 * g + 3] - mean) * rstd * bfhi(gg[1]));
          *(u32x2*)(MIXED + orow + e0) = w; }
    }
    __syncthreads();
}
#undef RLAS
#undef RMFMA
}

constexpr int NWAVES = 8;
constexpr int RING_OFF = 0, RING_BYTES = 131072;
constexpr int LDSCTL_OFF = RING_BYTES, MISC_OFF = LDSCTL_OFF + 320;
constexpr int LDS_BYTES = 163840;
constexpr int CW_BAR = 4096;
#define GAS __attribute__((address_space(1)))
#define LAS __attribute__((address_space(3)))
typedef unsigned short bf16;
typedef unsigned v4u __attribute__((ext_vector_type(4)));
typedef float f32x4 __attribute__((ext_vector_type(4)));
typedef short bf16x8 __attribute__((ext_vector_type(8)));
typedef GAS unsigned gu32;
typedef GAS unsigned long long gu64;
#define RLX_AGENT __ATOMIC_RELAXED, __HIP_MEMORY_SCOPE_AGENT
#define LDS_WAIT() asm volatile("s_waitcnt lgkmcnt(0)" ::: "memory")
#define VM_WAIT() asm volatile("s_waitcnt vmcnt(0)" ::: "memory")
__device__ __forceinline__ unsigned long long rt() { return __builtin_amdgcn_s_memrealtime(); }
__device__ __forceinline__ unsigned pk2(float lo, float hi) { return f2bf(lo) | (f2bf(hi) << 16); }

#define XB_TMO      128
#define XB_XCNT(j)  (256  + 64 * (j))
#define XB_XSUB(j)  (1280 + 64 * (j))
#define XB_XGEN(j)  (2304 + 64 * (j))
#define XB_TOP      3328
#define XB_TOPGEN   3392
#define XCD_BAR_WORDS 3456
#define XB_SPIN_CAP (1u << 18)

__device__ __forceinline__ unsigned xb_ld(unsigned* p)              { return __hip_atomic_load(p, __ATOMIC_RELAXED, __HIP_MEMORY_SCOPE_AGENT); }
__device__ __forceinline__ unsigned xb_add(unsigned* p, unsigned v) { return __hip_atomic_fetch_add(p, v, __ATOMIC_RELAXED, __HIP_MEMORY_SCOPE_AGENT); }
__device__ __forceinline__ unsigned xb_xcc_id() { return (unsigned)__builtin_amdgcn_s_getreg((3 << 11) | 20) & 0xFu; }
#define XB_SPIN(cond, bar) do { unsigned _sp = 0; while (cond) { __builtin_amdgcn_s_sleep(1); \
    if ((++_sp & 255u) == 0u) { if (xb_ld(&(bar)[XB_TMO])) break; if (_sp > XB_SPIN_CAP) { atomicAdd(&(bar)[XB_TMO], 1u); break; } } } } while (0)

struct XcdBarrier {
    unsigned* bar; unsigned x;
    volatile LAS unsigned* st;
};

__device__ __forceinline__ XcdBarrier xcd_barrier_post(unsigned* bar, volatile LAS unsigned* st) {
    XcdBarrier b; b.bar = bar; b.x = xb_xcc_id(); b.st = st;
    if (threadIdx.x == 0) (void)xb_add(&bar[XB_XCNT(b.x)], 1u);
    return b;
}
__device__ __forceinline__ void xcd_barrier_complete(unsigned* bar, unsigned x, unsigned& nloc, unsigned& nx) {
    const unsigned G = gridDim.x * gridDim.y * gridDim.z;
    unsigned sum, cnt, mine, sp = 0u;
    for (;;) {
        sum = 0u; cnt = 0u; mine = 0u;
#pragma unroll
        for (unsigned j = 0; j < 16; ++j) { const unsigned c = xb_ld(&bar[XB_XCNT(j)]); sum += c; cnt += (c > 0u) ? 1u : 0u; mine = (j == x) ? c : mine; }
        if (sum == G) break;
        __builtin_amdgcn_s_sleep(1);
        if ((++sp & 255u) == 0u) { if (xb_ld(&bar[XB_TMO])) break; if (sp > XB_SPIN_CAP) { atomicAdd(&bar[XB_TMO], 1u); break; } }
    }
    nloc = mine > 0u ? mine : 1u; nx = cnt > 0u ? cnt : 1u;
}

__device__ __forceinline__ void xcd_barrier(const XcdBarrier& b) {
    asm volatile("s_waitcnt vmcnt(0)" ::: "memory");
    __syncthreads();
    if (threadIdx.x == 0) {
        unsigned* bar = b.bar;
        __builtin_amdgcn_s_waitcnt(0);
        unsigned nloc = b.st[0], nx = b.st[1];
        if (nloc == 0u) { xcd_barrier_complete(bar, b.x, nloc, nx); b.st[0] = nloc; b.st[1] = nx; }
        const unsigned old = xb_add(&bar[XB_XSUB(b.x)], 1u);
        const unsigned gen = old / nloc;
        if (old + 1u == (gen + 1u) * nloc) {
            __builtin_amdgcn_fence(__ATOMIC_RELEASE, "agent");
            asm volatile("s_waitcnt vmcnt(0)" ::: "memory");
            const unsigned og = xb_add(&bar[XB_TOP], 1u);
            const unsigned tg = og / nx;
            if (og + 1u == (tg + 1u) * nx) xb_add(&bar[XB_TOPGEN], 1u);
            else XB_SPIN(xb_ld(&bar[XB_TOPGEN]) == tg, bar);
            __builtin_amdgcn_fence(__ATOMIC_ACQUIRE, "agent");
            xb_add(&bar[XB_XGEN(b.x)], 1u);
            asm volatile("s_waitcnt vmcnt(0)" ::: "memory");
        } else {
            XB_SPIN(xb_ld(&bar[XB_XGEN(b.x)]) == gen, bar);
            __builtin_amdgcn_fence(__ATOMIC_ACQUIRE, "agent");
            asm volatile("s_waitcnt vmcnt(0)" ::: "memory");
        }
    }
    __syncthreads();
}

template <class SrcF>
__device__ __forceinline__ void transpose_item(const SrcF& src, int K, bf16* WT, LAS float* scr, int kb, int nb, int lane) {
    const int k0 = 64 * kb, n0 = 32 * nb;
#pragma unroll 8
    for (int i = 0; i < 32; ++i) { const int kk = 2 * i + (lane >> 5); scr[kk * 33 + (lane & 31)] = src(k0 + kk, n0 + (lane & 31)); }
    LDS_WAIT(); asm volatile("" ::: "memory");
    const int c = lane & 7;
#pragma unroll
    for (int j = 0; j < 4; ++j) { const int n = (lane >> 3) + 8 * j; const LAS float* s = scr + (8 * c) * 33 + n;
        v4u o; o.x = pk2(s[0 * 33], s[1 * 33]); o.y = pk2(s[2 * 33], s[3 * 33]); o.z = pk2(s[4 * 33], s[5 * 33]); o.w = pk2(s[6 * 33], s[7 * 33]);
        *(GAS v4u*)(WT + (size_t)(n0 + n) * K + k0 + 8 * c) = o; }
    LDS_WAIT(); asm volatile("" ::: "memory");
}
template <class SrcF>
__device__ __forceinline__ void transpose_item4(const SrcF& src, int K, bf16* WT, LAS float* scr, int kb, int nb, int lane) {
    const int k0 = 64 * kb, n0 = 32 * nb;
    f32x4 v[8];
#pragma unroll
    for (int i = 0; i < 8; ++i) v[i] = src(k0 + 8 * i + (lane >> 3), n0 + 4 * (lane & 7));
#pragma unroll
    for (int i = 0; i < 8; ++i) *(LAS f32x4*)(scr + (8 * i + (lane >> 3)) * 36 + 4 * (lane & 7)) = v[i];
    LDS_WAIT(); asm volatile("" ::: "memory");
    const int c = lane & 7;
#pragma unroll
    for (int j = 0; j < 4; ++j) { const int n = (lane >> 3) + 8 * j; const LAS float* sp = scr + (8 * c) * 36 + n;
        v4u o; o.x = pk2(sp[0 * 36], sp[1 * 36]); o.y = pk2(sp[2 * 36], sp[3 * 36]); o.z = pk2(sp[4 * 36], sp[5 * 36]); o.w = pk2(sp[6 * 36], sp[7 * 36]);
        *(GAS v4u*)(WT + (size_t)(n0 + n) * K + k0 + 8 * c) = o; }
    LDS_WAIT(); asm volatile("" ::: "memory");
}
struct Src4Plain { const float* w; int ld; __device__ __forceinline__ f32x4 operator()(int k, int n) const { return *(const f32x4*)(w + (size_t)k * ld + n); } };
struct Src4GU { const float* wg; const float* wu; __device__ __forceinline__ f32x4 operator()(int k, int n) const { const long long d = (long long)(wu - wg); return *(const f32x4*)(wg + (long long)((n >> 2) & 1) * d + (long long)k * EFF + 4 * (n >> 3)); } };
struct SrcWin { const float* w; __device__ __forceinline__ float operator()(int k, int n) const { int col = n; if (n < 1024) { const int cp = n & 127; col = (n & ~127) + (cp & 1) * 64 + (cp >> 1); } return w[(size_t)k * INC + col]; } };
struct SrcPlain { const float* w; int ld; __device__ __forceinline__ float operator()(int k, int n) const { return w[(size_t)k * ld + n]; } };
struct SrcGU { const float* wg; const float* wu; __device__ __forceinline__ float operator()(int k, int n) const { const long long d = (long long)(wu - wg); return wg[(long long)(n & 1) * d + (long long)k * EFF + (n >> 1)]; } };

struct Args {
    const float* in[19]; float* out; unsigned char* ws; int ph_lo, ph_hi;
};

__device__ __forceinline__ void ln0_row(const float* src, const float* g, const float* bta, const LAS float* wf, const float* b_forget, bf16* xn_row, float* logf_row, int lane) {
    float4 v[4]; float s = 0.f;
#pragma unroll
    for (int j = 0; j < 4; ++j) { v[j] = ((const float4*)src)[lane + 64 * j]; s += (v[j].x + v[j].y) + (v[j].z + v[j].w); }
    const float mean = wave_sum(s) * (1.f / DM);
    float s2 = 0.f;
#pragma unroll
    for (int j = 0; j < 4; ++j) { v[j].x -= mean; v[j].y -= mean; v[j].z -= mean; v[j].w -= mean; s2 += (v[j].x * v[j].x + v[j].y * v[j].y) + (v[j].z * v[j].z + v[j].w * v[j].w); }
    const float rstd = 1.f / sqrtf(wave_sum(s2) * (1.f / DM) + LN_EPS);
    float f[8];
#pragma unroll
    for (int h = 0; h < 8; ++h) f[h] = 0.f;
#pragma unroll
    for (int j = 0; j < 4; ++j) {
        const float4 gg = ((const float4*)g)[lane + 64 * j], bb = ((const float4*)bta)[lane + 64 * j];
        const float y0 = v[j].x * rstd * gg.x + bb.x, y1 = v[j].y * rstd * gg.y + bb.y, y2 = v[j].z * rstd * gg.z + bb.z, y3 = v[j].w * rstd * gg.w + bb.w;
        uint2 o; o.x = pk2(y0, y1); o.y = pk2(y2, y3);
        ((uint2*)xn_row)[lane + 64 * j] = o;
        const LAS float* wp = wf + 32 * (lane + 64 * j);
#pragma unroll
        for (int h = 0; h < 8; ++h) f[h] += y0 * wp[h] + y1 * wp[8 + h] + y2 * wp[16 + h] + y3 * wp[24 + h];
    }
    float z = 0.f;
#pragma unroll
    for (int h = 0; h < 8; ++h) { const float t = wave_sum(f[h]); if (lane == h) z = t; }
    if (lane < 8) { z += b_forget[lane]; logf_row[lane] = fminf(z, 0.f) - log1pf(expf(-fabsf(z))); }
}

__device__ __forceinline__ void metaproj_item(const Args& a, LAS unsigned char* lds, int item, int tid, int lane, int wave) {
    const int g = item >> 2, qt = item & 3;
    LAS float* xm = (LAS float*)lds;
    LAS float* T = (LAS float*)(lds + 65536);
    const float* meta = a.in[1]; const float* g0 = a.in[2]; const float* b0 = a.in[3]; const float* w_in = a.in[4];
#pragma unroll
    for (int rr = 0; rr < 2; ++rr) {
        const int m = wave * 2 + rr; const float* src = meta + (size_t)m * DM;
        float4 v[4]; float s = 0.f;
#pragma unroll
        for (int j = 0; j < 4; ++j) { v[j] = ((const float4*)src)[lane + 64 * j]; s += (v[j].x + v[j].y) + (v[j].z + v[j].w); }
        const float mean = wave_sum(s) * (1.f / DM);
        float s2 = 0.f;
#pragma unroll
        for (int j = 0; j < 4; ++j) { v[j].x -= mean; v[j].y -= mean; v[j].z -= mean; v[j].w -= mean; s2 += (v[j].x * v[j].x + v[j].y * v[j].y) + (v[j].z * v[j].z + v[j].w * v[j].w); }
        const float rstd = 1.f / sqrtf(wave_sum(s2) * (1.f / DM) + LN_EPS);
#pragma unroll
        for (int j = 0; j < 4; ++j) {
            const float4 gg = ((const float4*)g0)[lane + 64 * j], bb = ((const float4*)b0)[lane + 64 * j]; const int k0 = 4 * (lane + 64 * j);
            xm[(k0 + 0) * 16 + m] = __uint_as_float(f2bf(v[j].x * rstd * gg.x + bb.x) << 16); xm[(k0 + 1) * 16 + m] = __uint_as_float(f2bf(v[j].y * rstd * gg.y + bb.y) << 16);
            xm[(k0 + 2) * 16 + m] = __uint_as_float(f2bf(v[j].z * rstd * gg.z + bb.z) << 16); xm[(k0 + 3) * 16 + m] = __uint_as_float(f2bf(v[j].w * rstd * gg.w + bb.w) << 16);
        }
    }
    __syncthreads();
    const int cb = g * 512 + qt * 128;
    float acc[16][2];
#pragma unroll
    for (int m = 0; m < 16; ++m) { acc[m][0] = 0.f; acc[m][1] = 0.f; }
    const float* wc = w_in + cb + 2 * lane;
#pragma unroll 4
    for (int kk = 0; kk < 128; ++kk) {
        const int k = wave * 128 + kk;
        const float2 w = *(const float2*)(wc + (size_t)k * INC);
        const f32x4 x0 = *(const LAS f32x4*)(xm + k * 16), x1 = *(const LAS f32x4*)(xm + k * 16 + 4), x2 = *(const LAS f32x4*)(xm + k * 16 + 8), x3 = *(const LAS f32x4*)(xm + k * 16 + 12);
#pragma unroll
        for (int q = 0; q < 4; ++q) { acc[q][0] += w.x * x0[q]; acc[q][1] += w.y * x0[q]; acc[4 + q][0] += w.x * x1[q]; acc[4 + q][1] += w.y * x1[q];
                                      acc[8 + q][0] += w.x * x2[q]; acc[8 + q][1] += w.y * x2[q]; acc[12 + q][0] += w.x * x3[q]; acc[12 + q][1] += w.y * x3[q]; }
    }
    for (int r = 0; r < NWAVES; ++r) {
        if (wave == r) {
#pragma unroll
            for (int m = 0; m < 16; ++m) { LAS float* tp = T + m * 128 + 2 * lane; if (r == 0) { tp[0] = acc[m][0]; tp[1] = acc[m][1]; } else { tp[0] += acc[m][0]; tp[1] += acc[m][1]; } }
        }
        __syncthreads();
    }
    bf16* base = (bf16*)(a.ws + WS_RQ) + (size_t)g * BUFE;
    const int m = tid >> 5, t5 = tid & 31;
    if (g < 2) {
        const float sc = (g == 1) ? RK_SCALE : 1.f; unsigned o[2];
#pragma unroll
        for (int jj = 0; jj < 2; ++jj) { const int j = 2 * t5 + jj;
            const double rr = exp2(-(double)j * (13.287712379549449 / 64.0)) * 0.15915494309189535;
            double rv = (double)m * rr; rv -= floor(rv); const float fr = (float)rv, sn = __builtin_amdgcn_sinf(fr), cs = __builtin_amdgcn_cosf(fr);
            const float x1 = T[m * 128 + j], x2 = T[m * 128 + 64 + j];
            o[jj] = pk2((x1 * cs - x2 * sn) * sc, (x2 * cs + x1 * sn) * sc); }
        for (int b = 0; b < NB; ++b) *(uint2*)(base + ((size_t)b * LT + RMETA0 + m) * 512 + qt * 128 + 4 * t5) = make_uint2(o[0], o[1]);
    } else {
        const int pos0 = (g < 4) ? RMETA0 : FMETA0; float v[4];
#pragma unroll
        for (int q = 0; q < 4; ++q) { v[q] = T[m * 128 + 4 * t5 + q]; if (g == 3) v[q] = v[q] / (1.f + __expf(-v[q])); else if (g == 4) v[q] *= C2; }
        const uint2 o = make_uint2(pk2(v[0], v[1]), pk2(v[2], v[3]));
        for (int b = 0; b < NB; ++b) *(uint2*)(base + ((size_t)b * LT + pos0 + m) * 512 + qt * 128 + 4 * t5) = o;
    }
    __syncthreads();
}

__device__ __forceinline__ void unpack8f(const uint4 u, float* d) {
    d[0] = __uint_as_float(u.x << 16); d[1] = __uint_as_float(u.x & 0xffff0000u); d[2] = __uint_as_float(u.y << 16); d[3] = __uint_as_float(u.y & 0xffff0000u);
    d[4] = __uint_as_float(u.z << 16); d[5] = __uint_as_float(u.z & 0xffff0000u); d[6] = __uint_as_float(u.w << 16); d[7] = __uint_as_float(u.w & 0xffff0000u);
}
__device__ __forceinline__ void qk_norms(unsigned char* ws, int gw, int NGW, int lane) {
    const bf16* FQ = (const bf16*)(ws + WS_RQ) + 4 * BUFE; const bf16* FK = FQ + BUFE;
    unsigned* qk = (unsigned*)(ws + WS_CTL) + CW_QK2;
    constexpr int RB = NMETA + SEQ, NR = NB * RB;
    const int rpw = (NR + NGW - 1) / NGW, r0 = gw * rpw, r1 = (r0 + rpw < NR) ? r0 + rpw : NR;
    int curb = -1; float mq = 0.f, mk = 0.f;
    for (int r = r0; r < r1; ++r) {
        const int b = r / RB, t = r - b * RB, pos = t < NMETA ? FMETA0 + t : XPOS0 + t - NMETA;
        if (b != curb) { if (curb >= 0 && (lane & 7) == 0) { atomicMax(qk + 2 * (curb * 8 + (lane >> 3)), __float_as_uint(mq)); atomicMax(qk + 2 * (curb * 8 + (lane >> 3)) + 1, __float_as_uint(mk)); } curb = b; mq = 0.f; mk = 0.f; }
        const size_t o = ((size_t)b * LT + pos) * 512 + lane * 8;
        float a[8], c[8]; unpack8f(*(const uint4*)(FQ + o), a); unpack8f(*(const uint4*)(FK + o), c);
        float sq = 0.f, sk = 0.f;
#pragma unroll
        for (int j = 0; j < 8; ++j) { sq += a[j] * a[j]; sk += c[j] * c[j]; }
        sq += __shfl_xor(sq, 1); sq += __shfl_xor(sq, 2); sq += __shfl_xor(sq, 4); sk += __shfl_xor(sk, 1); sk += __shfl_xor(sk, 2); sk += __shfl_xor(sk, 4);
        mq = fmaxf(mq, sq); mk = fmaxf(mk, sk);
    }
    if (curb >= 0 && (lane & 7) == 0) { atomicMax(qk + 2 * (curb * 8 + (lane >> 3)), __float_as_uint(mq)); atomicMax(qk + 2 * (curb * 8 + (lane >> 3)) + 1, __float_as_uint(mk)); }
}
__device__ __forceinline__ void bias_scan(const float* LOGF, float* BIAS, int bh, int lane) {
    const int b = bh >> 3, h = bh & 7;
    float* out = BIAS + (size_t)bh * LT;
    for (int p = lane; p < XPOS0; p += 64) if (p < FMETA0 || p >= FMETA0 + NMETA) out[p] = -1e30f;
    float carry = 0.f;
    for (int t0 = 0; t0 < NMETA + SEQ; t0 += 64) {
        const int t = t0 + lane; float v = 0.f;
        if (t < NMETA + SEQ) { const int row = t < NMETA ? NX + t : b * SEQ + t - NMETA; v = LOGF[(size_t)row * 8 + h]; }
#pragma unroll
        for (int o = 1; o < 64; o <<= 1) { const float u = __shfl_up(v, o); if (lane >= o) v += u; }
        v += carry;
        if (t < NMETA + SEQ) { const int pos = t < NMETA ? FMETA0 + t : XPOS0 + t - NMETA; out[pos] = -v * LOG2E; }
        carry = __shfl(v, 63);
    }
}
__device__ __forceinline__ void ln_row_f32_to_bf16(const float* src, const float* g, const float* bta, bf16* dst, int lane) {
    float4 v[4]; float s = 0.f;
#pragma unroll
    for (int j = 0; j < 4; ++j) { v[j] = ((const float4*)src)[lane + 64 * j]; const uint2 h = ((const uint2*)dst)[lane + 64 * j];
        v[j].x += ALPHA * __uint_as_float(h.x << 16); v[j].y += ALPHA * __uint_as_float(h.x & 0xffff0000u); v[j].z += ALPHA * __uint_as_float(h.y << 16); v[j].w += ALPHA * __uint_as_float(h.y & 0xffff0000u);
        s += (v[j].x + v[j].y) + (v[j].z + v[j].w); }
    const float mean = wave_sum(s) * (1.f / DM);
    float s2 = 0.f;
#pragma unroll
    for (int j = 0; j < 4; ++j) { v[j].x -= mean; v[j].y -= mean; v[j].z -= mean; v[j].w -= mean; s2 += (v[j].x * v[j].x + v[j].y * v[j].y) + (v[j].z * v[j].z + v[j].w * v[j].w); }
    const float rstd = 1.f / sqrtf(wave_sum(s2) * (1.f / DM) + LN_EPS);
#pragma unroll
    for (int j = 0; j < 4; ++j) {
        const float4 gg = ((const float4*)g)[lane + 64 * j], bb = ((const float4*)bta)[lane + 64 * j];
        uint2 o; o.x = pk2(v[j].x * rstd * gg.x + bb.x, v[j].y * rstd * gg.y + bb.y); o.y = pk2(v[j].z * rstd * gg.z + bb.z, v[j].w * rstd * gg.w + bb.w);
        ((uint2*)dst)[lane + 64 * j] = o;
    }
}
__device__ __forceinline__ void final_row(const bf16* BASE, const unsigned char* Y, const int* ASG, const float* GATEL, const LAS int* ys, const float* g, const float* bta, float* out, int tok, int lane) {
    float v[16];
    { const bf16* src = BASE + (size_t)tok * DM + 16 * lane; unpack8f(((const uint4*)src)[0], v); unpack8f(((const uint4*)src)[1], v + 8); }
    typedef float f32x2v __attribute__((ext_vector_type(2)));
#pragma unroll
    for (int r = 0; r < 6; ++r) {
        const int a = ASG[(size_t)tok * 6 + r]; const int e = a >> 16, rank = a & 0xffff;
        const uint4 w = *(const uint4*)(Y + (size_t)(ys[e] + rank) * DM + 16 * lane); const float gt = GATEL[(size_t)e * CAP + rank] * (1.f / 64.f);
        const unsigned ww[4] = {w.x, w.y, w.z, w.w};
#pragma unroll
        for (int q = 0; q < 4; ++q) { const f32x2v lo = __builtin_amdgcn_cvt_pk_f32_fp8((int)ww[q], false), hi = __builtin_amdgcn_cvt_pk_f32_fp8((int)ww[q], true);
            v[4 * q] += gt * lo[0]; v[4 * q + 1] += gt * lo[1]; v[4 * q + 2] += gt * hi[0]; v[4 * q + 3] += gt * hi[1]; }
    }
    float s = 0.f;
#pragma unroll
    for (int q = 0; q < 16; ++q) s += v[q];
    const float mean = wave_sum(s) * (1.f / DM);
    float s2 = 0.f;
#pragma unroll
    for (int q = 0; q < 16; ++q) { v[q] -= mean; s2 += v[q] * v[q]; }
    const float rstd = 1.f / sqrtf(wave_sum(s2) * (1.f / DM) + LN_EPS);
    const int c0 = 16 * lane;
#pragma unroll
    for (int j = 0; j < 4; ++j) {
        const float4 gg = *(const float4*)(g + c0 + 4 * j), bb = *(const float4*)(bta + c0 + 4 * j);
        float4 o; o.x = v[4 * j] * rstd * gg.x + bb.x; o.y = v[4 * j + 1] * rstd * gg.y + bb.y; o.z = v[4 * j + 2] * rstd * gg.z + bb.z; o.w = v[4 * j + 3] * rstd * gg.w + bb.w;
        *(float4*)(out + (size_t)tok * DM + c0 + 4 * j) = o;
    }
}
__global__ void __launch_bounds__(NWAVES * 64, 2) mega(Args args) {
    extern __shared__ __attribute__((aligned(16))) unsigned char lds_raw[];
    LAS unsigned char* lds = (LAS unsigned char*)lds_raw;
    volatile LAS unsigned* MISC = (volatile LAS unsigned*)(lds + MISC_OFF);
    const int tid = threadIdx.x, lane = tid & 63, wave = __builtin_amdgcn_readfirstlane(tid >> 6);
    const int G = gridDim.x; const int bx = blockIdx.x; const int vcu = (G % 8 == 0) ? (bx % 8) * (G / 8) + bx / 8 : bx;
    unsigned char* ws = args.ws;
    gu32* ctl = (gu32*)(ws + WS_CTL);
    for (int u = tid; u < (LDS_BYTES - LDSCTL_OFF) / 4; u += NWAVES * 64) ((LAS unsigned*)(lds + LDSCTL_OFF))[u] = 0u;
    __syncthreads();
    XcdBarrier bar = xcd_barrier_post((unsigned*)(ctl + CW_BAR), MISC + 8);
    const int lo = args.ph_lo, hi = args.ph_hi;
#ifndef PROBE_PHASE
#define PROBE_PHASE -1
#endif
#define REP(k) for (int rep_ = 0; rep_ < ((PROBE_PHASE == (k)) ? 2 : 1); ++rep_)
#define IN(k) (lo <= (k) && (k) < hi)
#define BOTH(k) (IN(k) && IN((k) + 1))
    bf16* XN = (bf16*)(ws + WS_XN); float* LOGF = (float*)(ws + WS_LOGF); float* TAB = (float*)(ws + WS_TAB);
    bf16* WIN_T = (bf16*)(ws + WS_WIN_T); bf16* WOUT_T = (bf16*)(ws + WS_WOUT_T); bf16* WGU_T = (bf16*)(ws + WS_WGU_T); bf16* WSD_T = (bf16*)(ws + WS_WSD_T); bf16* WR_T = (bf16*)(ws + WS_WR_T); bf16* WD_T = (bf16*)(ws + WS_WD_T);

    if (IN(0)) REP(0) {
        for (int it = vcu; it < 28; it += G) metaproj_item(args, lds, it, tid, lane, wave);
        {
            const int gw = vcu * NWAVES + wave, NGW = G * NWAVES;
            LAS float* scr = (LAS float*)(lds + wave * 9216);
            LAS float* wf = (LAS float*)(lds + 98304);
            const float* w_in = args.in[4];
            for (int i = tid; i < 1024 * 8; i += NWAVES * 64) { const int k = i >> 3, h = i & 7; wf[i] = w_in[(size_t)k * INC + 3584 + h]; }
            __syncthreads();
            if (gw == 0) { const double rr = exp2(-(double)lane * (13.287712379549449 / 64.0)) * 0.15915494309189535; const float h = (float)rr; TAB[2 * lane] = h; TAB[2 * lane + 1] = (float)(rr - (double)h); }
            for (int row = gw; row < NX + NMETA; row += NGW) {
                const float* src = row < NX ? args.in[0] + (size_t)row * DM : args.in[1] + (size_t)(row - NX) * DM;
                ln0_row(src, args.in[2], args.in[3], wf, args.in[5], XN + (size_t)row * DM, LOGF + (size_t)row * 8, lane);
            }
            constexpr int I0 = 16 * 112, I1 = 16 * 32, I2 = 16 * 2, I3 = 16 * 16, I4 = 4 * 32, ITOT = I0 + I1 + I2 + I3 + I4;
            for (int it = gw; it < ITOT; it += NGW) {
                int r = it;
                if (r < I0) { transpose_item(SrcWin{w_in}, DM, WIN_T, scr, r / 112, r % 112, lane); continue; } r -= I0;
                if (r < I1) { transpose_item4(Src4Plain{args.in[6], DM}, DM, WOUT_T, scr, r / 32, r % 32, lane); continue; } r -= I1;
                if (r < I2) { transpose_item(SrcPlain{args.in[9], NEXP}, DM, WR_T, scr, r / 2, r % 2, lane); continue; } r -= I2;
                if (r < I3) { transpose_item4(Src4GU{args.in[14], args.in[15]}, DM, WGU_T + (size_t)64 * 512 * DM, scr, r / 16, r % 16, lane); continue; } r -= I3;
                { transpose_item4(Src4Plain{args.in[16], DM}, EFF, WSD_T, scr, r / 32, r % 32, lane); }
            }
        }
        if (BOTH(0)) xcd_barrier(bar);
    }
    if (IN(1)) REP(1) {
        if (vcu < 64 && wave == 0) bias_scan(LOGF, (float*)(ws + WS_BIAS), vcu, lane);
        pg8::Gemm g{(const pg8::bf16_t*)XN, (const pg8::bf16_t*)WIN_T, NX, 3584, DM}; pg8::StaticOrder S; S.init(NX, 3584, G, (int)blockIdx.x);
        LAS float* tabl = (LAS float*)(lds + LDSCTL_OFF + 3072);
        if (tid < 128) tabl[tid] = TAB[tid];
        __syncthreads();
        pg8::EpiInproj E{(pg8::bf16_t*)(ws + WS_RQ), (const LAS float*)tabl};
        pg8::gemm_phase<pg8::EpiInproj, pg8::StaticOrder, true, true>(lds + RING_OFF, g, S, E);
        if (BOTH(1)) xcd_barrier(bar);
    }
    if (IN(2)) {
        static_assert(attn_body::ATTN_LDS_BYTES <= RING_BYTES, "attention LDS");
        float* KV = (float*)args.out;
        unsigned short* PREV = (unsigned short*)((unsigned char*)args.out + 66 * MiB);
        for (int uu = vcu; uu < 1024; uu += G) { int tid_o = tid; asm volatile("" : "+v"(tid_o)); ret_body::ret_kv_unit(uu >> 5, 1 + (uu & 31), ws, KV, (char*)lds_raw + RING_OFF, tid_o); }
        xcd_barrier(bar);
        ret_body::ret_scan(KV, PREV, vcu * (NWAVES * 64) + tid, G * NWAVES * 64);
        qk_norms(ws, vcu * NWAVES + wave, G * NWAVES, lane);
        xcd_barrier(bar);
        REP(2) {
        const int qid = bx & 7;
        for (int dq = 0; dq < 8; ++dq) {
            const int q = (qid + dq) & 7;
            for (;;) {
                if (tid == 0) MISC[0] = __hip_atomic_fetch_add(ctl + CW_Q2 + 64 * q + 512 * rep_, 1u, RLX_AGENT);
                __syncthreads();
                const int it = (int)MISC[0];
                __syncthreads();
                if (it >= 640) break;
                int tid_o = tid; asm volatile("" : "+v"(tid_o));
                if (it < 512) {
                    const int grp = it >> 2, sub = it & 3;
                    if (sub == 0) { const int qb = 15 - (grp >> 3), bh = 8 * q + (grp & 7); attn_body::attn_unit<8>(bh >> 3, bh & 7, qb, ws, (char*)lds_raw + RING_OFF, tid_o); }
                    else {
                        LAS float* scr = (LAS float*)(lds + wave * 9216);
                        const int ci = (q * 384 + grp * 3 + (sub - 1)) * 8 + wave;
                        if (ci < 16384) { const int e = ci >> 8, qq = ci & 255; transpose_item4(Src4GU{args.in[11] + (size_t)e * DM * EFF, args.in[12] + (size_t)e * DM * EFF}, DM, WGU_T + (size_t)e * 512 * DM, scr, qq / 16, qq % 16, lane); }
                        else { const int r = ci - 16384, e = r >> 7, qq = r & 127; transpose_item4(Src4Plain{args.in[13] + (size_t)e * EFF * DM, DM}, EFF, WD_T + (size_t)e * DM * EFF, scr, qq / 32, qq % 32, lane); }
                        __syncthreads();
                    }
                } else { const int r = it - 512; ret_body::ret_out_unit(4 * q + (r >> 5), 2 + (r & 31), ws, PREV, (char*)lds_raw + RING_OFF, tid_o); }
            }
        }
        }
        if (BOTH(2)) xcd_barrier(bar);
    }
    if (IN(3)) REP(3) {
        pg8::Gemm g{(const pg8::bf16_t*)(ws + WS_MIXED), (const pg8::bf16_t*)WOUT_T, NX, DM, DM}; pg8::StaticOrder S; S.init(NX, DM, G, (int)blockIdx.x);
        pg8::EpiOutproj E{args.out};
        pg8::gemm_phase<pg8::EpiOutproj, pg8::StaticOrder, true, true>(lds + RING_OFF, g, S, E);
        if (BOTH(3)) xcd_barrier(bar);
    }
    if (IN(4)) REP(4) {
        const int gw = vcu * NWAVES + wave, NGW = G * NWAVES;
        for (int row = gw; row < NX; row += NGW) ln_row_f32_to_bf16(args.out + (size_t)row * DM, args.in[7], args.in[8], XN + (size_t)row * DM, lane);
        if (BOTH(4)) xcd_barrier(bar);
    }
    int* cnt = (int*)(ws + WS_CTL) + CW_CNT; int* TOKL = (int*)(ws + WS_TOKL); float* GATEL = (float*)(ws + WS_GATEL); int* ASG = (int*)(ws + WS_ASG);
    bf16* HID = (bf16*)args.out;
    if (IN(5)) {
        for (int pm = vcu; pm < 128; pm += G) {
            pg8::Gemm g{(const pg8::bf16_t*)XN, (const pg8::bf16_t*)WR_T, NX, 256, DM}; pg8::SingleUnit S{pm, 0, 1};
            pg8::EpiRouter E{args.in[10], cnt, TOKL, GATEL, ASG};
            pg8::gemm_phase<pg8::EpiRouter, pg8::SingleUnit, false, true>(lds + RING_OFF, g, S, E);
        }
        REP(5) { pg8::Gemm g{(const pg8::bf16_t*)XN, (const pg8::bf16_t*)(WGU_T + (size_t)64 * 512 * DM), NX, 512, DM}; pg8::StaticOrder S; S.init(NX, 512, G, (int)blockIdx.x);
          pg8::EpiGU<false> E{(pg8::bf16_t*)(HID + (size_t)HID_S_ROW0 * EFF), nullptr};
          pg8::gemm_phase<pg8::EpiGU<false>, pg8::StaticOrder, true, true>(lds + RING_OFF, g, S, E); }
        if (BOTH(5)) xcd_barrier(bar);
    }
    LAS int* tabs = (LAS int*)(lds + LDSCTL_OFF + 4096);
    LAS int* ulist = (LAS int*)(lds + LDSCTL_OFF + 8192);
#define BUILD_UNITS(NPN, nunits_out) do { \
        __syncthreads(); \
        if (tid < 64) tabs[3 * 65 + tid] = cnt[tid]; \
        __syncthreads(); \
        if (tid == 0) { int us = 0, hs = 0, ys = 0; for (int e = 0; e < 64; ++e) { const int c = tabs[3 * 65 + e], nt = (c + 255) >> 8; tabs[e] = us; tabs[65 + e] = hs; tabs[130 + e] = ys; us += nt * (NPN); hs += nt << 8; ys += c; } tabs[64] = us; tabs[129] = hs; tabs[194] = ys; } \
        __syncthreads(); \
        if (tid < 32) { const int Lu = tid * G + vcu; int e = -1; if (Lu < tabs[64]) { int lo_ = 0, hi_ = 63; while (lo_ < hi_) { const int mid = (lo_ + hi_ + 1) >> 1; if (tabs[mid] <= Lu) lo_ = mid; else hi_ = mid - 1; } e = lo_; } \
            LAS int* q_ = ulist + 6 * tid; if (e >= 0) { const int loc = Lu - tabs[e], rt = loc / (NPN), pn = loc % (NPN); q_[0] = e; q_[1] = rt; q_[2] = pn; q_[3] = tabs[65 + e] + (rt << 8); q_[4] = tabs[130 + e] + (rt << 8); q_[5] = tabs[3 * 65 + e] - (rt << 8); } else q_[0] = -1; } \
        __syncthreads(); \
        { const int tot_ = tabs[64]; nunits_out = (tot_ > vcu) ? (tot_ - vcu + G - 1) / G : 0; if (nunits_out > 32) nunits_out = 32; } \
    } while (0)
    if (IN(6)) REP(6) {
        int nun; BUILD_UNITS(2, nun);
        LAS int* tokL = (LAS int*)(lds + LDSCTL_OFF + 16384);
        if (nun > 16) nun = 16;
        for (int i = 0; i < nun; ++i) if (tid < 256) { const LAS int* q_ = ulist + 6 * i; tokL[i * 256 + tid] = (tid < q_[5]) ? TOKL[(size_t)q_[0] * CAP + q_[1] * 256 + tid] : 0; }
        __syncthreads();
        pg8::Gemm g{(const pg8::bf16_t*)XN, (const pg8::bf16_t*)WGU_T, NX, 512, DM}; pg8::GroupOrder<true> S{(const LAS int*)ulist, nun, (const LAS int*)tokL, 512};
        pg8::EpiGU<true> E{(pg8::bf16_t*)HID, (const LAS int*)ulist};
        pg8::gemm_phase<pg8::EpiGU<true>, pg8::GroupOrder<true>, true, true>(lds + RING_OFF, g, S, E);
        if (BOTH(6)) xcd_barrier(bar);
    }
    if (IN(7)) {
        int nun; BUILD_UNITS(4, nun);
        REP(7) { pg8::Gemm g{(const pg8::bf16_t*)HID, (const pg8::bf16_t*)WD_T, NX, DM, EFF}; pg8::GroupOrder<false> S{(const LAS int*)ulist, nun, nullptr, DM};
          pg8::EpiY E{(unsigned char*)(ws + WS_Y), (const LAS int*)ulist};
          pg8::gemm_phase<pg8::EpiY, pg8::GroupOrder<false>, true, true>(lds + RING_OFF, g, S, E); }
        { pg8::Gemm g{(const pg8::bf16_t*)(HID + (size_t)HID_S_ROW0 * EFF), (const pg8::bf16_t*)WSD_T, NX, DM, EFF}; pg8::StaticOrder S; S.init(NX, DM, G, (int)blockIdx.x);
          pg8::EpiBase E{(pg8::bf16_t*)XN};
          pg8::gemm_phase<pg8::EpiBase, pg8::StaticOrder, true, true>(lds + RING_OFF, g, S, E); }
        if (BOTH(7)) xcd_barrier(bar);
    }
    if (IN(8)) REP(8) {
        __syncthreads();
        if (tid == 0) { int a = 0; for (int e = 0; e < 64; ++e) { tabs[e] = a; a += cnt[e]; } }
        __syncthreads();
        const int gw = vcu * NWAVES + wave, NGW = G * NWAVES;
        for (int tok = gw; tok < NX; tok += NGW) final_row(XN, (const unsigned char*)(ws + WS_Y), ASG, GATEL, (const LAS int*)tabs, args.in[17], args.in[18], args.out, tok, lane);
    }
#undef BUILD_UNITS
#undef REP
#undef IN
#undef BOTH
}

extern "C" void kernel_launch(void* const* d_in, const int* in_sizes, int n_in, void* d_out, int out_size, void* d_ws, size_t ws_size, hipStream_t stream) {
    if (n_in != 19 || ws_size < WS_END || out_size != NX * DM) { fprintf(stderr, "kernel_launch: unexpected sizes n_in=%d ws=%zu out=%d\n", n_in, ws_size, out_size); return; }
    static int grid = 0;
    if (grid == 0) {
        int dev = 0, cus = 0, per_cu = 0;
        if (hipGetDevice(&dev) != hipSuccess || hipDeviceGetAttribute(&cus, hipDeviceAttributeMultiprocessorCount, dev) != hipSuccess) { fprintf(stderr, "kernel_launch: device query failed\n"); grid = -1; return; }
        if (hipFuncSetAttribute((const void*)mega, hipFuncAttributeMaxDynamicSharedMemorySize, LDS_BYTES) != hipSuccess) { fprintf(stderr, "kernel_launch: hipFuncSetAttribute failed\n"); grid = -1; return; }
        if (hipOccupancyMaxActiveBlocksPerMultiprocessor(&per_cu, (const void*)mega, NWAVES * 64, LDS_BYTES) != hipSuccess || per_cu < 1) { fprintf(stderr, "kernel_launch: occupancy query says %d blocks per CU\n", per_cu); grid = -1; return; }
        (void)hipGetLastError();
        grid = cus;
    }
    if (grid < 0) return;
    const float* x = (const float*)d_in[0];
    const float* w_out = (const float*)d_in[6];
    const float* ln1_g = (const float*)d_in[7]; const float* ln1_b = (const float*)d_in[8]; const float* w_router = (const float*)d_in[9]; const float* router_bias = (const float*)d_in[10];
    const float* we_gate = (const float*)d_in[11]; const float* we_up = (const float*)d_in[12]; const float* we_down = (const float*)d_in[13];
    const float* ws_gate = (const float*)d_in[14]; const float* ws_up = (const float*)d_in[15]; const float* ws_down = (const float*)d_in[16];
    const float* ln2_g = (const float*)d_in[17]; const float* ln2_b = (const float*)d_in[18];
    (void)x;
    unsigned char* ws = (unsigned char*)d_ws; float* out = (float*)d_out;
    int* cnt = (int*)(ws + WS_CTL) + CW_CNT;
    float* LOGF = (float*)(ws + WS_LOGF); float* BIAS = (float*)(ws + WS_BIAS); int* ASG = (int*)(ws + WS_ASG); int* TOKL = (int*)(ws + WS_TOKL); float* GATEL = (float*)(ws + WS_GATEL);
    float* LOGITS = (float*)(ws + WS_LOGITS); bf16_t* XN = (bf16_t*)(ws + WS_XN); bf16_t* H1 = XN;
    bf16_t* RQ = (bf16_t*)(ws + WS_RQ); bf16_t* RK = RQ + BUFE; bf16_t* RV = RQ + 2 * BUFE; bf16_t* RG = RQ + 3 * BUFE; bf16_t* FQ = RQ + 4 * BUFE; bf16_t* FK = RQ + 5 * BUFE; bf16_t* FV = RQ + 6 * BUFE;
    bf16_t* MIXED = (bf16_t*)(ws + WS_MIXED); bf16_t* Y = (bf16_t*)(ws + WS_Y);
    float* yb = out;
    bf16_t* HID = (bf16_t*)d_out;

    (void)hipMemsetAsync(ws + WS_CTL, 0, 1 * MiB, stream);
    Args a{};
    for (int i = 0; i < 19; ++i) a.in[i] = (const float*)d_in[i];
#if defined(PROBE_HOST)
    a.out = out; a.ws = ws; a.ph_lo = 0; a.ph_hi = PROBE_HOST + 1;
    { void* kargs[] = {&a}; (void)hipLaunchCooperativeKernel((const void*)mega, dim3(grid), dim3(NWAVES * 64), kargs, LDS_BYTES, stream); }
    (void)hipMemsetAsync(ws + WS_CTL, 0, 1 * MiB, stream);
#endif
    a.out = out; a.ws = ws; a.ph_lo = 0; a.ph_hi = 9;
    { void* kargs[] = {&a}; hipError_t e = hipLaunchCooperativeKernel((const void*)mega, dim3(grid), dim3(NWAVES * 64), kargs, LDS_BYTES, stream);
      if (e != hipSuccess) fprintf(stderr, "kernel_launch: cooperative launch failed: %s\n", hipGetErrorString(e)); }
}
```

```cpp
#include <hip/hip_runtime.h>
#include <stdint.h>
#include <cstdio>

typedef unsigned short bf16_t;

constexpr int NB = 8, SEQ = 4096, DM = 1024, NMETA = 16, NX = NB * SEQ;
constexpr int LT = 4352;
constexpr int XPOS0 = 256;
constexpr int RMETA0 = 240;
constexpr int FMETA0 = 128;
constexpr int INC = 3592, NEXP = 64, TOPK = 6, EFF = 256;
constexpr int CAP = 32768;
constexpr float LN_EPS = 1e-5f;
constexpr float ALPHA = 1.189207115002721f;
constexpr float LOG2E = 1.4426950408889634f;
constexpr float C2 = 0.125f * LOG2E;
constexpr float RK_SCALE = 0.08838834764831845f;
constexpr float ROUTED_SCALE = 2.5f;

constexpr size_t MiB = 1u << 20;
constexpr size_t WS_CTL = 0;
constexpr size_t WS_LOGF = 1 * MiB;
constexpr size_t WS_BIAS = 3 * MiB;
constexpr size_t WS_ASG = 5 * MiB;
constexpr size_t WS_TOKL = 6 * MiB;
constexpr size_t WS_GATEL = 14 * MiB;
constexpr size_t WS_LOGITS = 22 * MiB;
constexpr size_t WS_XN = 30 * MiB;
constexpr size_t WS_A = 96 * MiB;
constexpr size_t BUFE = (size_t)NB * LT * 512;
constexpr size_t WS_RQ = WS_A;
constexpr size_t WS_MIXED = WS_A + 7 * BUFE * 2;
constexpr size_t WS_Y = WS_A;
constexpr size_t WS_WIN_T = 398 * MiB;
constexpr size_t WS_WOUT_T = 405 * MiB;
constexpr size_t WS_WGU_T = 407 * MiB;
constexpr size_t WS_WSD_T = 94 * MiB + 512 * 1024;
constexpr size_t WS_WR_T = 95 * MiB;
constexpr size_t WS_TAB = 95 * MiB + 512 * 1024;
constexpr size_t WS_WD_T = 480 * MiB;
constexpr size_t WS_BASE2 = 288 * MiB;
constexpr size_t WS_END = 512 * MiB;
constexpr size_t HID_S_ROW0 = 212992;
constexpr int CW_CNT = 1024;
constexpr int CW_Q2 = 2048;
constexpr int CW_QK2 = 3584;

__device__ __forceinline__ float bf2f(bf16_t v) { return __uint_as_float(((unsigned)v) << 16); }
__device__ __forceinline__ unsigned f2bf(float f) { unsigned u = __float_as_uint(f); return (u + 0x7fffu + ((u >> 16) & 1u)) >> 16; }
__device__ __forceinline__ float wave_sum(float v) {
#pragma unroll
    for (int o = 1; o < 64; o <<= 1) v += __shfl_xor(v, o);
    return v;
}

__global__ void __launch_bounds__(256) k_ln0(const float* __restrict__ x, const float* __restrict__ meta, const float* __restrict__ g, const float* __restrict__ bta,
                                            const float* __restrict__ w_in, const float* __restrict__ b_forget, bf16_t* XN, float* LOGF) {
    __shared__ float wf[1024 * 8];
    for (int i = threadIdx.x; i < 1024 * 8; i += 256) { int k = i >> 3, h = i & 7; wf[i] = w_in[(size_t)k * INC + 3584 + h]; }
    __syncthreads();
    const int lane = threadIdx.x & 63, wave = threadIdx.x >> 6;
    const int gw = blockIdx.x * 4 + wave, ngw = gridDim.x * 4;
    for (int row = gw; row < NX + NMETA; row += ngw) {
        const float* src = row < NX ? x + (size_t)row * DM : meta + (size_t)(row - NX) * DM;
        float4 v[4]; float s = 0.f;
#pragma unroll
        for (int j = 0; j < 4; ++j) { v[j] = ((const float4*)src)[lane + 64 * j]; s += (v[j].x + v[j].y) + (v[j].z + v[j].w); }
        const float mean = wave_sum(s) * (1.f / DM);
        float s2 = 0.f;
#pragma unroll
        for (int j = 0; j < 4; ++j) { v[j].x -= mean; v[j].y -= mean; v[j].z -= mean; v[j].w -= mean; s2 += (v[j].x * v[j].x + v[j].y * v[j].y) + (v[j].z * v[j].z + v[j].w * v[j].w); }
        const float rstd = 1.f / sqrtf(wave_sum(s2) * (1.f / DM) + LN_EPS);
        float f[8];
#pragma unroll
        for (int h = 0; h < 8; ++h) f[h] = 0.f;
#pragma unroll
        for (int j = 0; j < 4; ++j) {
            const float4 gg = ((const float4*)g)[lane + 64 * j], bb = ((const float4*)bta)[lane + 64 * j];
            float y0 = v[j].x * rstd * gg.x + bb.x, y1 = v[j].y * rstd * gg.y + bb.y, y2 = v[j].z * rstd * gg.z + bb.z, y3 = v[j].w * rstd * gg.w + bb.w;
            uint2 o; o.x = (unsigned)f2bf(y0) | ((unsigned)f2bf(y1) << 16); o.y = (unsigned)f2bf(y2) | ((unsigned)f2bf(y3) << 16);
            ((uint2*)(XN + (size_t)row * DM))[lane + 64 * j] = o;
            const int k0 = 4 * (lane + 64 * j);
#pragma unroll
            for (int h = 0; h < 8; ++h) f[h] += y0 * wf[(k0 + 0) * 8 + h] + y1 * wf[(k0 + 1) * 8 + h] + y2 * wf[(k0 + 2) * 8 + h] + y3 * wf[(k0 + 3) * 8 + h];
        }
        float z = 0.f;
#pragma unroll
        for (int h = 0; h < 8; ++h) { const float t = wave_sum(f[h]); if (lane == h) z = t; }
        if (lane < 8) { z += b_forget[lane]; LOGF[(size_t)row * 8 + lane] = fminf(z, 0.f) - log1pf(expf(-fabsf(z))); }
    }
}

__global__ void __launch_bounds__(64) k_bias(const float* __restrict__ LOGF, float* BIAS) {
    const int bh = blockIdx.x, b = bh >> 3, h = bh & 7, lane = threadIdx.x;
    float* out = BIAS + (size_t)bh * LT;
    for (int p = lane; p < XPOS0; p += 64) if (p < FMETA0 || p >= FMETA0 + NMETA) out[p] = -1e30f;
    float carry = 0.f;
    for (int t0 = 0; t0 < NMETA + SEQ; t0 += 64) {
        const int t = t0 + lane; float v = 0.f;
        if (t < NMETA + SEQ) { const int row = t < NMETA ? NX + t : b * SEQ + t - NMETA; v = LOGF[(size_t)row * 8 + h]; }
#pragma unroll
        for (int o = 1; o < 64; o <<= 1) { const float u = __shfl_up(v, o); if (lane >= o) v += u; }
        v += carry;
        if (t < NMETA + SEQ) { const int pos = t < NMETA ? FMETA0 + t : XPOS0 + t - NMETA; out[pos] = -v * LOG2E; }
        carry = __shfl(v, 63);
    }
}

template <class AF, class BF, class EF>
__global__ void __launch_bounds__(256) naive_gemm(int M, int N, int K, int padarg, AF af, BF bf, EF ef) {
    __shared__ float As[16][65];
    __shared__ float Bs[16][65];
    const int tx = threadIdx.x & 15, ty = threadIdx.x >> 4;
    const int m0 = blockIdx.y * 64, n0 = blockIdx.x * 64;
    float acc[4][4];
#pragma unroll
    for (int i = 0; i < 4; ++i)
#pragma unroll
        for (int j = 0; j < 4; ++j) acc[i][j] = 0.f;
    for (int k0 = 0; k0 < K; k0 += 16) {
        for (int i = threadIdx.x; i < 1024; i += 256) { const int m = i >> 4, k = i & 15; As[k][m] = (m0 + m < M) ? af(m0 + m, k0 + k) : 0.f; }
        for (int i = threadIdx.x; i < 1024; i += 256) { const int k = i >> 6, n = i & 63; Bs[k][n] = (n0 + n < N) ? bf(k0 + k, n0 + n) : 0.f; }
        __syncthreads();
#pragma unroll
        for (int k = 0; k < 16; ++k) {
            float a[4], b[4];
#pragma unroll
            for (int i = 0; i < 4; ++i) { a[i] = As[k][ty * 4 + i]; b[i] = Bs[k][tx * 4 + i]; }
#pragma unroll
            for (int i = 0; i < 4; ++i)
#pragma unroll
                for (int j = 0; j < 4; ++j) acc[i][j] += a[i] * b[j];
        }
        __syncthreads();
    }
#pragma unroll
    for (int i = 0; i < 4; ++i)
#pragma unroll
        for (int j = 0; j < 4; ++j) { const int m = m0 + ty * 4 + i, n = n0 + tx * 4 + j; if (m < M && n < N) ef(m, n, acc[i][j]); }
}
struct AF_bf16 { const bf16_t* p; int ld; int pad; __device__ float operator()(int m, int k) const { return bf2f(p[(size_t)m * ld + k]); } };
struct BF_f32 { const float* p; int ld; int pad; __device__ float operator()(int k, int n) const { return p[(size_t)k * ld + n]; } };
struct EF_inproj {
    bf16_t* bufs;
    __device__ void operator()(int row, int col, float v) const {
        const int g = col >> 9, cc = col & 511;
        if (g == 1) v *= RK_SCALE; else if (g == 3) v = v / (1.f + __expf(-v)); else if (g == 4) v *= C2;
        const bf16_t o = f2bf(v);
        bf16_t* base = bufs + (size_t)g * BUFE;
        if (row < NX) { const int b = row >> 12, i = row & 4095; base[((size_t)b * LT + XPOS0 + i) * 512 + cc] = o; }
        else { const int pos = (g < 4 ? RMETA0 : FMETA0) + (row - NX); for (int b = 0; b < NB; ++b) base[((size_t)b * LT + pos) * 512 + cc] = o; }
    }
};
struct EF_outproj { float* y; const bf16_t* XN; __device__ void operator()(int row, int col, float v) const { const size_t o = (size_t)row * DM + col; y[o] = v + ALPHA * bf2f(XN[o]); } };
struct EF_store { float* p; int ld; int pad; __device__ void operator()(int row, int col, float v) const { p[(size_t)row * ld + col] = v; } };

__global__ void __launch_bounds__(256) k_rotary(bf16_t* RQ, bf16_t* RK) {
    const size_t idx = (size_t)blockIdx.x * 256 + threadIdx.x;
    if (idx >= (size_t)NB * (NMETA + SEQ) * 256) return;
    const int j = (int)(idx & 63), h = (int)((idx >> 6) & 3); const size_t r = idx >> 8; const int t = (int)(r % (NMETA + SEQ)), b = (int)(r / (NMETA + SEQ));
    const int pos = RMETA0 + t;
    const double inv = exp2(-(double)j * (13.287712379549449 / 64.0));
    double rv = (double)t * inv * 0.15915494309189535; rv -= floor(rv);
    const float fr = (float)rv, s = __builtin_amdgcn_sinf(fr), c = __builtin_amdgcn_cosf(fr);
    bf16_t* p = RQ + ((size_t)b * LT + pos) * 512 + h * 128 + j;
    float x1 = bf2f(p[0]), x2 = bf2f(p[64]); p[0] = f2bf(x1 * c - x2 * s); p[64] = f2bf(x2 * c + x1 * s);
    p = RK + ((size_t)b * LT + pos) * 512 + h * 128 + j;
    x1 = bf2f(p[0]); x2 = bf2f(p[64]); p[0] = f2bf(x1 * c - x2 * s); p[64] = f2bf(x2 * c + x1 * s);
}

__device__ __forceinline__ void unpack8(const uint4 u, float* d) {
    d[0] = __uint_as_float(u.x << 16); d[1] = __uint_as_float(u.x & 0xffff0000u); d[2] = __uint_as_float(u.y << 16); d[3] = __uint_as_float(u.y & 0xffff0000u);
    d[4] = __uint_as_float(u.z << 16); d[5] = __uint_as_float(u.z & 0xffff0000u); d[6] = __uint_as_float(u.w << 16); d[7] = __uint_as_float(u.w & 0xffff0000u);
}

__global__ void __launch_bounds__(64) k_ret_naive(const bf16_t* __restrict__ RQ, const bf16_t* __restrict__ RK, const bf16_t* __restrict__ RV, const bf16_t* __restrict__ RG, bf16_t* MIXED) {
    __shared__ float Ks[64 * 128];
    __shared__ float Vs[64 * 128];
    const int blk = blockIdx.x, qt = blk & 63, h = (blk >> 6) & 3, b = blk >> 8, lane = threadIdx.x;
    const int i = qt * 64 + lane, qpos = XPOS0 + i;
    const float lg2g = log2f(1.f - exp2f(-5.f - (float)h));
    float q[128], o[128];
    const bf16_t* qp = RQ + ((size_t)b * LT + qpos) * 512 + h * 128;
#pragma unroll
    for (int d = 0; d < 128; d += 8) unpack8(*(const uint4*)(qp + d), q + d);
#pragma unroll
    for (int e = 0; e < 128; ++e) o[e] = 0.f;
    const int last_pos = XPOS0 + qt * 64 + 63;
    for (int kp0 = 192; kp0 <= last_pos; kp0 += 64) {
        __syncthreads();
        for (int c = lane; c < 1024; c += 64) {
            const int key = c >> 4, d8 = (c & 15) * 8; const size_t off = ((size_t)b * LT + kp0 + key) * 512 + h * 128 + d8;
            unpack8(*(const uint4*)(RK + off), Ks + key * 128 + d8); unpack8(*(const uint4*)(RV + off), Vs + key * 128 + d8);
        }
        __syncthreads();
        for (int s = 0; s < 64; ++s) {
            const int kpos = kp0 + s;
            if (kpos < RMETA0) continue;
            float sc = 0.f;
#pragma unroll
            for (int d = 0; d < 128; d += 4) { const float4 kk = *(const float4*)(Ks + s * 128 + d); sc += q[d] * kk.x + q[d + 1] * kk.y + q[d + 2] * kk.z + q[d + 3] * kk.w; }
            const float w = (kpos <= qpos) ? sc * exp2f((float)(qpos - kpos) * lg2g) : 0.f;
#pragma unroll
            for (int e = 0; e < 128; e += 4) { const float4 vv = *(const float4*)(Vs + s * 128 + e); o[e] += w * vv.x; o[e + 1] += w * vv.y; o[e + 2] += w * vv.z; o[e + 3] += w * vv.w; }
        }
    }
    float mean = 0.f;
#pragma unroll
    for (int e = 0; e < 128; ++e) mean += o[e];
    mean *= (1.f / 128.f);
    float var = 0.f;
#pragma unroll
    for (int e = 0; e < 128; ++e) { o[e] -= mean; var += o[e] * o[e]; }
    const float rstd = 1.f / sqrtf(var * (1.f / 128.f) + LN_EPS);
    const bf16_t* gp = RG + ((size_t)b * LT + qpos) * 512 + h * 128;
    bf16_t* op = MIXED + ((size_t)b * SEQ + i) * DM + h * 128;
#pragma unroll
    for (int e = 0; e < 128; e += 8) {
        float gg[8]; unpack8(*(const uint4*)(gp + e), gg);
        uint4 w;
        w.x = (unsigned)f2bf(o[e] * rstd * gg[0]) | ((unsigned)f2bf(o[e + 1] * rstd * gg[1]) << 16);
        w.y = (unsigned)f2bf(o[e + 2] * rstd * gg[2]) | ((unsigned)f2bf(o[e + 3] * rstd * gg[3]) << 16);
        w.z = (unsigned)f2bf(o[e + 4] * rstd * gg[4]) | ((unsigned)f2bf(o[e + 5] * rstd * gg[5]) << 16);
        w.w = (unsigned)f2bf(o[e + 6] * rstd * gg[6]) | ((unsigned)f2bf(o[e + 7] * rstd * gg[7]) << 16);
        *(uint4*)(op + e) = w;
    }
}

__global__ void __launch_bounds__(64) k_fox_naive(const bf16_t* __restrict__ FQ, const bf16_t* __restrict__ FK, const bf16_t* __restrict__ FV, const float* __restrict__ BIAS, bf16_t* MIXED) {
    __shared__ float Ks[64 * 64];
    __shared__ float Vs[64 * 64];
    __shared__ float Bsh[64];
    const int blk = blockIdx.x, qt = blk & 63, h = (blk >> 6) & 7, b = blk >> 9, lane = threadIdx.x;
    const int i = qt * 64 + lane, qpos = XPOS0 + i;
    float q[64], o[64];
    const bf16_t* qp = FQ + ((size_t)b * LT + qpos) * 512 + h * 64;
#pragma unroll
    for (int d = 0; d < 64; d += 8) unpack8(*(const uint4*)(qp + d), q + d);
#pragma unroll
    for (int e = 0; e < 64; ++e) o[e] = 0.f;
    float m = -1e30f, l = 0.f;
    const int last_pos = XPOS0 + qt * 64 + 63;
    for (int kp0 = FMETA0; kp0 <= last_pos; kp0 += 64) {
        __syncthreads();
        for (int c = lane; c < 512; c += 64) {
            const int key = c >> 3, d8 = (c & 7) * 8; const size_t off = ((size_t)b * LT + kp0 + key) * 512 + h * 64 + d8;
            unpack8(*(const uint4*)(FK + off), Ks + key * 64 + d8); unpack8(*(const uint4*)(FV + off), Vs + key * 64 + d8);
        }
        Bsh[lane] = BIAS[(size_t)(b * 8 + h) * LT + kp0 + lane];
        __syncthreads();
        for (int s = 0; s < 64; ++s) {
            float sc = Bsh[s];
#pragma unroll
            for (int d = 0; d < 64; d += 4) { const float4 kk = *(const float4*)(Ks + s * 64 + d); sc += q[d] * kk.x + q[d + 1] * kk.y + q[d + 2] * kk.z + q[d + 3] * kk.w; }
            if (kp0 + s > qpos) sc = -1e30f;
            const float mn = fmaxf(m, sc), f = exp2f(m - mn), p = exp2f(sc - mn);
            m = mn; l = l * f + p;
#pragma unroll
            for (int e = 0; e < 64; e += 4) { const float4 vv = *(const float4*)(Vs + s * 64 + e); o[e] = o[e] * f + p * vv.x; o[e + 1] = o[e + 1] * f + p * vv.y; o[e + 2] = o[e + 2] * f + p * vv.z; o[e + 3] = o[e + 3] * f + p * vv.w; }
        }
    }
    const float rl = 1.f / l;
    bf16_t* op = MIXED + ((size_t)b * SEQ + i) * DM + 512 + h * 64;
#pragma unroll
    for (int e = 0; e < 64; e += 8) {
        uint4 w;
        w.x = (unsigned)f2bf(o[e] * rl) | ((unsigned)f2bf(o[e + 1] * rl) << 16); w.y = (unsigned)f2bf(o[e + 2] * rl) | ((unsigned)f2bf(o[e + 3] * rl) << 16);
        w.z = (unsigned)f2bf(o[e + 4] * rl) | ((unsigned)f2bf(o[e + 5] * rl) << 16); w.w = (unsigned)f2bf(o[e + 6] * rl) | ((unsigned)f2bf(o[e + 7] * rl) << 16);
        *(uint4*)(op + e) = w;
    }
}

__global__ void __launch_bounds__(256) k_ln_rows(const float* __restrict__ y, const float* __restrict__ g, const float* __restrict__ bta, bf16_t* H) {
    const int lane = threadIdx.x & 63, wave = threadIdx.x >> 6;
    const int gw = blockIdx.x * 4 + wave, ngw = gridDim.x * 4;
    for (int row = gw; row < NX; row += ngw) {
        const float* src = y + (size_t)row * DM;
        float4 v[4]; float s = 0.f;
#pragma unroll
        for (int j = 0; j < 4; ++j) { v[j] = ((const float4*)src)[lane + 64 * j]; s += (v[j].x + v[j].y) + (v[j].z + v[j].w); }
        const float mean = wave_sum(s) * (1.f / DM);
        float s2 = 0.f;
#pragma unroll
        for (int j = 0; j < 4; ++j) { v[j].x -= mean; v[j].y -= mean; v[j].z -= mean; v[j].w -= mean; s2 += (v[j].x * v[j].x + v[j].y * v[j].y) + (v[j].z * v[j].z + v[j].w * v[j].w); }
        const float rstd = 1.f / sqrtf(wave_sum(s2) * (1.f / DM) + LN_EPS);
#pragma unroll
        for (int j = 0; j < 4; ++j) {
            const float4 gg = ((const float4*)g)[lane + 64 * j], bb = ((const float4*)bta)[lane + 64 * j];
            uint2 o; o.x = (unsigned)f2bf(v[j].x * rstd * gg.x + bb.x) | ((unsigned)f2bf(v[j].y * rstd * gg.y + bb.y) << 16);
            o.y = (unsigned)f2bf(v[j].z * rstd * gg.z + bb.z) | ((unsigned)f2bf(v[j].w * rstd * gg.w + bb.w) << 16);
            ((uint2*)(H + (size_t)row * DM))[lane + 64 * j] = o;
        }
    }
}

__global__ void __launch_bounds__(256) k_route(const float* __restrict__ LOGITS, const float* __restrict__ rbias, int* cnt, int* TOKL, float* GATEL, int* ASG) {
    __shared__ float sc[256 * 65];
    __shared__ float rb[64];
    if (threadIdx.x < 64) rb[threadIdx.x] = rbias[threadIdx.x];
    const int tok0 = blockIdx.x * 256;
    for (int i = threadIdx.x; i < 256 * 64; i += 256) { const int t = i >> 6, e = i & 63; const float x = LOGITS[(size_t)(tok0 + t) * 64 + e]; sc[t * 65 + e] = 1.f / (1.f + expf(-x)); }
    __syncthreads();
    const int tok = tok0 + threadIdx.x;
    const float* my = sc + threadIdx.x * 65;
    float gs[8];
#pragma unroll
    for (int g = 0; g < 8; ++g) {
        float m1 = -3e38f, m2 = -3e38f;
#pragma unroll
        for (int j = 0; j < 8; ++j) { const float v = my[g * 8 + j] + rb[g * 8 + j]; if (v > m1) { m2 = m1; m1 = v; } else if (v > m2) m2 = v; }
        gs[g] = m1 + m2;
    }
    unsigned gmask = 0;
#pragma unroll
    for (int r = 0; r < 4; ++r) {
        float best = -3e38f; int bi = 0;
#pragma unroll
        for (int g = 0; g < 8; ++g) { const bool take = !((gmask >> g) & 1u) && gs[g] > best; if (take) { best = gs[g]; bi = g; } }
        gmask |= 1u << bi;
    }
    unsigned long long chosen = 0ull; int sel[6]; float gv[6]; float gsum = 0.f;
#pragma unroll
    for (int r = 0; r < 6; ++r) {
        float best = -3e38f; int bi = 0;
        for (int e = 0; e < 64; ++e) { if (((gmask >> (e >> 3)) & 1u) && !((chosen >> e) & 1ull)) { const float v = my[e] + rb[e]; if (v > best) { best = v; bi = e; } } }
        chosen |= 1ull << bi; sel[r] = bi; gv[r] = my[bi]; gsum += gv[r];
    }
    const float scale = ROUTED_SCALE / gsum;
#pragma unroll
    for (int r = 0; r < 6; ++r) {
        const int e = sel[r]; const int rank = atomicAdd(&cnt[e], 1);
        TOKL[(size_t)e * CAP + rank] = tok; GATEL[(size_t)e * CAP + rank] = gv[r] * scale; ASG[(size_t)tok * 6 + r] = (e << 16) | rank;
    }
}

__global__ void __launch_bounds__(256) k_exp_up_naive(const bf16_t* __restrict__ H1, const float* __restrict__ we_gate, const float* __restrict__ we_up, const float* __restrict__ ws_gate, const float* __restrict__ ws_up,
                                                     const int* __restrict__ cnt, const int* __restrict__ TOKL, bf16_t* HID) {
    __shared__ float As[16][65];
    __shared__ float Bg[16][65];
    __shared__ float Bu[16][65];
    __shared__ int toks[64];
    __shared__ int hs_sh;
    const int e = blockIdx.z, n_e = e < 64 ? cnt[e] : NX, r0 = blockIdx.y * 64;
    if (r0 >= n_e) return;
    if (threadIdx.x == 0) { int hs = 0; for (int j = 0; j < e; ++j) hs += (cnt[j] + 255) & ~255; hs_sh = hs; }
    if (threadIdx.x < 64) { const int r = r0 + threadIdx.x; toks[threadIdx.x] = r < n_e ? (e < 64 ? TOKL[(size_t)e * CAP + r] : r) : -1; }
    __syncthreads();
    const float* Wg = e < 64 ? we_gate + (size_t)e * DM * EFF : ws_gate;
    const float* Wu = e < 64 ? we_up + (size_t)e * DM * EFF : ws_up;
    const int tx = threadIdx.x & 15, ty = threadIdx.x >> 4, n0 = blockIdx.x * 64;
    float ag[4][4], au[4][4];
#pragma unroll
    for (int i = 0; i < 4; ++i)
#pragma unroll
        for (int j = 0; j < 4; ++j) { ag[i][j] = 0.f; au[i][j] = 0.f; }
    for (int k0 = 0; k0 < DM; k0 += 16) {
        for (int i = threadIdx.x; i < 1024; i += 256) { const int m = i >> 4, k = i & 15; const int t = toks[m]; As[k][m] = t >= 0 ? bf2f(H1[(size_t)t * DM + k0 + k]) : 0.f; }
        for (int i = threadIdx.x; i < 1024; i += 256) { const int k = i >> 6, n = i & 63; Bg[k][n] = Wg[(size_t)(k0 + k) * EFF + n0 + n]; Bu[k][n] = Wu[(size_t)(k0 + k) * EFF + n0 + n]; }
        __syncthreads();
#pragma unroll
        for (int k = 0; k < 16; ++k) {
            float a[4], bg[4], bu[4];
#pragma unroll
            for (int i = 0; i < 4; ++i) { a[i] = As[k][ty * 4 + i]; bg[i] = Bg[k][tx * 4 + i]; bu[i] = Bu[k][tx * 4 + i]; }
#pragma unroll
            for (int i = 0; i < 4; ++i)
#pragma unroll
                for (int j = 0; j < 4; ++j) { ag[i][j] += a[i] * bg[j]; au[i][j] += a[i] * bu[j]; }
        }
        __syncthreads();
    }
    const int hs = hs_sh;
#pragma unroll
    for (int i = 0; i < 4; ++i)
#pragma unroll
        for (int j = 0; j < 4; ++j) { const int r = r0 + ty * 4 + i; if (r < n_e) { const float gq = ag[i][j]; HID[(size_t)(hs + r) * EFF + n0 + tx * 4 + j] = f2bf(gq / (1.f + __expf(-gq)) * au[i][j]); } }
}

__global__ void __launch_bounds__(256) k_exp_down_naive(const bf16_t* __restrict__ HID, const float* __restrict__ we_down, const float* __restrict__ ws_down, const int* __restrict__ cnt, const float* __restrict__ GATEL,
                                                       bf16_t* Y, bf16_t* H1) {
    __shared__ float As[16][65];
    __shared__ float Bs[16][65];
    __shared__ int hs_sh, ys_sh;
    const int e = blockIdx.z, n_e = e < 64 ? cnt[e] : NX, r0 = blockIdx.y * 64;
    if (r0 >= n_e) return;
    if (threadIdx.x == 0) { int hs = 0, ys = 0; for (int j = 0; j < e; ++j) { hs += (cnt[j] + 255) & ~255; ys += cnt[j]; } hs_sh = hs; ys_sh = ys; }
    __syncthreads();
    const int hs = hs_sh, ys = ys_sh;
    const float* Wd = e < 64 ? we_down + (size_t)e * EFF * DM : ws_down;
    const int tx = threadIdx.x & 15, ty = threadIdx.x >> 4, n0 = blockIdx.x * 64;
    float acc[4][4];
#pragma unroll
    for (int i = 0; i < 4; ++i)
#pragma unroll
        for (int j = 0; j < 4; ++j) acc[i][j] = 0.f;
    for (int k0 = 0; k0 < EFF; k0 += 16) {
        for (int i = threadIdx.x; i < 1024; i += 256) { const int m = i >> 4, k = i & 15; As[k][m] = (r0 + m < n_e) ? bf2f(HID[(size_t)(hs + r0 + m) * EFF + k0 + k]) : 0.f; }
        for (int i = threadIdx.x; i < 1024; i += 256) { const int k = i >> 6, n = i & 63; Bs[k][n] = Wd[(size_t)(k0 + k) * DM + n0 + n]; }
        __syncthreads();
#pragma unroll
        for (int k = 0; k < 16; ++k) {
            float a[4], b[4];
#pragma unroll
            for (int i = 0; i < 4; ++i) { a[i] = As[k][ty * 4 + i]; b[i] = Bs[k][tx * 4 + i]; }
#pragma unroll
            for (int i = 0; i < 4; ++i)
#pragma unroll
                for (int j = 0; j < 4; ++j) acc[i][j] += a[i] * b[j];
        }
        __syncthreads();
    }
#pragma unroll
    for (int i = 0; i < 4; ++i) {
        const int r = r0 + ty * 4 + i; if (r >= n_e) continue;
        if (e < 64) { const float gt = GATEL[(size_t)e * CAP + r];
#pragma unroll
            for (int j = 0; j < 4; ++j) Y[(size_t)(ys + r) * DM + n0 + tx * 4 + j] = f2bf(acc[i][j] * gt); }
        else {
#pragma unroll
            for (int j = 0; j < 4; ++j) { const size_t o = (size_t)r * DM + n0 + tx * 4 + j; H1[o] = f2bf(ALPHA * bf2f(H1[o]) + acc[i][j]); } }
    }
}

__global__ void __launch_bounds__(256) k_final(const bf16_t* __restrict__ BASE, const bf16_t* __restrict__ Y, const int* __restrict__ ASG, const int* __restrict__ cnt, const float* __restrict__ g, const float* __restrict__ bta, float* out) {
    __shared__ int ys[64];
    if (threadIdx.x == 0) { int a = 0; for (int j = 0; j < 64; ++j) { ys[j] = a; a += cnt[j]; } }
    __syncthreads();
    const int lane = threadIdx.x & 63, wave = threadIdx.x >> 6;
    const int gw = blockIdx.x * 4 + wave, ngw = gridDim.x * 4;
    for (int tok = gw; tok < NX; tok += ngw) {
        float v[16];
        { const bf16_t* src = BASE + (size_t)tok * DM;
#pragma unroll
          for (int j = 0; j < 2; ++j) unpack8(((const uint4*)src)[lane + 64 * j], v + 8 * j); }
#pragma unroll
        for (int r = 0; r < 6; ++r) {
            const int a = ASG[(size_t)tok * 6 + r]; const int e = a >> 16, rank = a & 0xffff;
            const bf16_t* src = Y + (size_t)(ys[e] + rank) * DM; float t[8];
#pragma unroll
            for (int j = 0; j < 2; ++j) { unpack8(((const uint4*)src)[lane + 64 * j], t);
#pragma unroll
                for (int q = 0; q < 8; ++q) v[8 * j + q] += t[q]; }
        }
        float s = 0.f;
#pragma unroll
        for (int q = 0; q < 16; ++q) s += v[q];
        const float mean = wave_sum(s) * (1.f / DM);
        float s2 = 0.f;
#pragma unroll
        for (int q = 0; q < 16; ++q) { v[q] -= mean; s2 += v[q] * v[q]; }
        const float rstd = 1.f / sqrtf(wave_sum(s2) * (1.f / DM) + LN_EPS);
#pragma unroll
        for (int j = 0; j < 2; ++j) {
            const int c0 = (lane + 64 * j) * 8;
            const float4 g0 = *(const float4*)(g + c0), g1 = *(const float4*)(g + c0 + 4), b0 = *(const float4*)(bta + c0), b1 = *(const float4*)(bta + c0 + 4);
            float4 o0, o1;
            o0.x = v[8 * j + 0] * rstd * g0.x + b0.x; o0.y = v[8 * j + 1] * rstd * g0.y + b0.y; o0.z = v[8 * j + 2] * rstd * g0.z + b0.z; o0.w = v[8 * j + 3] * rstd * g0.w + b0.w;
            o1.x = v[8 * j + 4] * rstd * g1.x + b1.x; o1.y = v[8 * j + 5] * rstd * g1.y + b1.y; o1.z = v[8 * j + 6] * rstd * g1.z + b1.z; o1.w = v[8 * j + 7] * rstd * g1.w + b1.w;
            *(float4*)(out + (size_t)tok * DM + c0) = o0; *(float4*)(out + (size_t)tok * DM + c0 + 4) = o1;
        }
    }
}


namespace pg8 {
#define PG8_LAS __attribute__((address_space(3)))
typedef unsigned short bf16_t;
typedef short bf16x8 __attribute__((ext_vector_type(8)));
typedef float f32x4 __attribute__((ext_vector_type(4)));
typedef unsigned u32x4 __attribute__((ext_vector_type(4)));
constexpr int BM = 256, BK = 64, HALF = 128, HTB = HALF * BK * 2  , STAGE_BYTES = 8 * HTB, NXCD = 8, WGM = 8;

__host__ __device__ __forceinline__ int lds_byte(int r, int c) { const int st = (r >> 4) * 2 + (c >> 5), rr = r & 15, cc = c & 31, ob = rr * 64 + cc * 2; return st * 1024 + (ob ^ (((ob >> 9) & 1) << 5)); }
__host__ __device__ __forceinline__ void stage_rc(int b, int& R, int& C) { const int st = b / 1024, sb = b % 1024, swz = sb ^ (((sb >> 9) & 1) << 5); R = (st >> 1) * 16 + swz / 64; C = (st & 1) * 32 + (swz % 64) / 2; }
__host__ __device__ __forceinline__ int perm32(int rho) { const int n = rho >> 4, i = rho & 15; return 8 * (i >> 2) + 4 * n + (i & 3); }

struct Unit { int pm, pn, idx; };
struct Gemm { const bf16_t* A; const bf16_t* Bt; int M, N, K; };

struct StaticOrder {
    int nM, nN, nwg, G, c;
    __host__ __device__ void init(int M, int N, int G_, int c_) { nM = M / BM; nN = N / BM; nwg = nM * nN; G = G_; c = c_; }
    __host__ __device__ bool next(int i, Unit& u) const {
        const long L = (long)i * G + c; if (L >= nwg) return false;
        int wgid = (int)L; { const int q = nwg / NXCD, r = nwg % NXCD, xcd = wgid % NXCD, off = wgid / NXCD; wgid = (xcd < r ? xcd * (q + 1) : r * (q + 1) + (xcd - r) * q) + off; }
        const int nig = WGM * nN, gid = wgid / nig, fm = gid * WGM, gsz = (nM - fm) < WGM ? (nM - fm) : WGM;
        u.pm = fm + ((wgid % nig) % gsz); u.pn = (wgid % nig) / gsz; return true;
    }
    __device__ __forceinline__ void a_ready(const Unit&) const {}
    __device__ __forceinline__ void done(const Unit&) const {}
    __device__ __forceinline__ const char* a_base(const Gemm& g, const Unit& u) const { return (const char*)g.A + (size_t)u.pm * ((size_t)BM * g.K * 2); }
    __device__ __forceinline__ const char* b_base(const Gemm& g, const Unit& u) const { return (const char*)g.Bt + (size_t)u.pn * ((size_t)BM * g.K * 2); }
    __device__ __forceinline__ void a_offs(const Gemm& g, const Unit& u, int tid, unsigned (&VO)[2][2]) const {
#pragma unroll
        for (int i = 0; i < 2; ++i) { int R, C; stage_rc(tid * 16 + i * 8192, R, C);
#pragma unroll
            for (int h = 0; h < 2; ++h) VO[h][i] = (unsigned)((u.pm * BM + h * HALF + R) * g.K + C) * 2u; } }
};

__device__ __forceinline__ unsigned cvt_pk_bf16(float lo, float hi) { unsigned r; asm volatile("v_cvt_pk_bf16_f32 %0, %1, %2" : "=v"(r) : "v"(lo), "v"(hi)); return r; }

struct EpiOutproj {
    static constexpr bool PERM = true, AFTER_DRAIN = false;
    bf16_t* y;
    __device__ __forceinline__ void operator()(const f32x4 (&acc)[2][2][4][2], const Unit& u, int wr, int wc, int fr, int fq) const {
#pragma unroll
        for (int ai = 0; ai < 2; ++ai)
#pragma unroll
            for (int m = 0; m < 4; ++m) {
                const size_t ro = (size_t)(u.pm * BM + ai * HALF + wr * 64 + m * 16 + fr) * DM + u.pn * BM + wc * 32 + 8 * fq;
#pragma unroll
                for (int bj = 0; bj < 2; ++bj) { const f32x4 v0 = acc[ai][bj][m][0], v1 = acc[ai][bj][m][1];
                    u32x4 w; w.x = cvt_pk_bf16(v0[0], v0[1]); w.y = cvt_pk_bf16(v0[2], v0[3]); w.z = cvt_pk_bf16(v1[0], v1[1]); w.w = cvt_pk_bf16(v1[2], v1[3]);
                    *(u32x4*)(y + ro + bj * HALF) = w; }
            }
    }
};
struct SingleUnit {
    int pm, pn, have;
    __device__ __forceinline__ bool next(int i, Unit& u) const { if (i > 0 || !have) return false; u.pm = pm; u.pn = pn; u.idx = 0; return true; }
    __device__ __forceinline__ void a_ready(const Unit&) const {}
    __device__ __forceinline__ void done(const Unit&) const {}
    __device__ __forceinline__ const char* b_base(const Gemm& g, const Unit& u) const { return (const char*)g.Bt + (size_t)u.pn * ((size_t)BM * g.K * 2); }
    __device__ __forceinline__ void a_offs(const Gemm& g, const Unit& u, int tid, unsigned (&VO)[2][2]) const {
#pragma unroll
        for (int i = 0; i < 2; ++i) { int R, C; stage_rc(tid * 16 + i * 8192, R, C);
#pragma unroll
            for (int h = 0; h < 2; ++h) VO[h][i] = (unsigned)((u.pm * BM + h * HALF + R) * g.K + C) * 2u; } }
};
struct PairOrder {
    int l0, l1, n, nN;
    __device__ __forceinline__ bool next(int i, Unit& u) const { if (i >= n) return false; const int L = i ? l1 : l0; u.pm = L / nN; u.pn = L % nN; u.idx = 0; return true; }
    __device__ __forceinline__ void a_ready(const Unit&) const {}
    __device__ __forceinline__ void done(const Unit&) const {}
    __device__ __forceinline__ const char* b_base(const Gemm& g, const Unit& u) const { return (const char*)g.Bt + (size_t)u.pn * ((size_t)BM * g.K * 2); }
    __device__ __forceinline__ void a_offs(const Gemm& g, const Unit& u, int tid, unsigned (&VO)[2][2]) const {
#pragma unroll
        for (int i = 0; i < 2; ++i) { int R, C; stage_rc(tid * 16 + i * 8192, R, C);
#pragma unroll
            for (int h = 0; h < 2; ++h) VO[h][i] = (unsigned)((u.pm * BM + h * HALF + R) * g.K + C) * 2u; } }
};
struct StrideOrder {
    int start, stride, total, nN;
    __device__ __forceinline__ bool next(int i, Unit& u) const { const int L = start + i * stride; if (start < 0 || L >= total) return false; u.pm = L / nN; u.pn = L % nN; u.idx = 0; return true; }
    __device__ __forceinline__ void a_ready(const Unit&) const {}
    __device__ __forceinline__ void done(const Unit&) const {}
    __device__ __forceinline__ const char* b_base(const Gemm& g, const Unit& u) const { return (const char*)g.Bt + (size_t)u.pn * ((size_t)BM * g.K * 2); }
    __device__ __forceinline__ void a_offs(const Gemm& g, const Unit& u, int tid, unsigned (&VO)[2][2]) const {
#pragma unroll
        for (int i = 0; i < 2; ++i) { int R, C; stage_rc(tid * 16 + i * 8192, R, C);
#pragma unroll
            for (int h = 0; h < 2; ++h) VO[h][i] = (unsigned)((u.pm * BM + h * HALF + R) * g.K + C) * 2u; } }
};
template <bool GATHER> struct GroupOrder {
    const PG8_LAS int* ul; int n; const PG8_LAS int* tokl; int b_rows;
    __device__ __forceinline__ bool next(int i, Unit& u) const { if (i >= n) return false; const PG8_LAS int* p = ul + 6 * i; u.pm = p[1]; u.pn = p[2]; u.idx = i; return true; }
    __device__ __forceinline__ void a_ready(const Unit&) const {}
    __device__ __forceinline__ void done(const Unit&) const {}
    __device__ __forceinline__ const char* b_base(const Gemm& g, const Unit& u) const { return (const char*)g.Bt + ((size_t)ul[6 * u.idx] * b_rows + (size_t)u.pn * BM) * ((size_t)g.K * 2); }
    __device__ __forceinline__ void a_offs(const Gemm& g, const Unit& u, int tid, unsigned (&VO)[2][2]) const {
        const PG8_LAS int* p = ul + 6 * u.idx; const int aux = p[3];
#pragma unroll
        for (int i = 0; i < 2; ++i) { int R, C; stage_rc(tid * 16 + i * 8192, R, C);
#pragma unroll
            for (int h = 0; h < 2; ++h) {
                const int rl = h * HALF + R; int row;
                if (GATHER) row = tokl[u.idx * BM + rl];
                else row = aux + rl;
                VO[h][i] = (unsigned)(row * g.K + C) * 2u; } }
    }
};
__device__ __forceinline__ float silu_f(float v) { return v / (1.f + __expf(-v)); }
template <bool LIST> struct EpiGU {
    static constexpr bool PERM = true, AFTER_DRAIN = false;
    bf16_t* HID; const PG8_LAS int* ul;
    __device__ __forceinline__ void operator()(const f32x4 (&acc)[2][2][4][2], const Unit& u, int wr, int wc, int fr, int fq) const {
        const int aux = LIST ? ul[6 * u.idx + 3] : u.pm * BM;
#pragma unroll
        for (int ai = 0; ai < 2; ++ai)
#pragma unroll
            for (int m = 0; m < 4; ++m) {
                bf16_t* rowp = HID + (size_t)(aux + ai * HALF + wr * 64 + m * 16 + fr) * EFF + u.pn * 128 + wc * 16 + fq * 4;
#pragma unroll
                for (int bj = 0; bj < 2; ++bj) {
                    const f32x4 v0 = acc[ai][bj][m][0], v1 = acc[ai][bj][m][1];
                    unsigned w0 = cvt_pk_bf16(silu_f(v0[0]) * v1[0], silu_f(v0[1]) * v1[1]), w1 = cvt_pk_bf16(silu_f(v0[2]) * v1[2], silu_f(v0[3]) * v1[3]);
                    typedef unsigned u32x2 __attribute__((ext_vector_type(2)));
                    *(u32x2*)(rowp + bj * 64) = (u32x2){w0, w1};
                }
            }
    }
};
struct EpiBase {
    static constexpr bool PERM = true, AFTER_DRAIN = false;
    const bf16_t* H1; bf16_t* OUT;
    __device__ __forceinline__ void operator()(const f32x4 (&acc)[2][2][4][2], const Unit& u, int wr, int wc, int fr, int fq) const {
#pragma unroll
        for (int ai = 0; ai < 2; ++ai)
#pragma unroll
            for (int m = 0; m < 4; ++m) {
                const size_t ro = (size_t)(u.pm * BM + ai * HALF + wr * 64 + m * 16 + fr) * DM + u.pn * BM + wc * 32 + 8 * fq; const bf16_t* rowp = H1 + ro; bf16_t* outp = OUT + ro;
#pragma unroll
                for (int bj = 0; bj < 2; ++bj) {
                    const u32x4 xn = *(const u32x4*)(rowp + bj * HALF);
                    const f32x4 v0 = acc[ai][bj][m][0], v1 = acc[ai][bj][m][1];
                    u32x4 w;
                    w.x = cvt_pk_bf16(v0[0] + ALPHA * __uint_as_float(xn.x << 16), v0[1] + ALPHA * __uint_as_float(xn.x & 0xffff0000u)); w.y = cvt_pk_bf16(v0[2] + ALPHA * __uint_as_float(xn.y << 16), v0[3] + ALPHA * __uint_as_float(xn.y & 0xffff0000u));
                    w.z = cvt_pk_bf16(v1[0] + ALPHA * __uint_as_float(xn.z << 16), v1[1] + ALPHA * __uint_as_float(xn.z & 0xffff0000u)); w.w = cvt_pk_bf16(v1[2] + ALPHA * __uint_as_float(xn.w << 16), v1[3] + ALPHA * __uint_as_float(xn.w & 0xffff0000u));
                    *(u32x4*)(outp + bj * HALF) = w;
                }
            }
    }
};
struct EpiY {
    static constexpr bool PERM = true, AFTER_DRAIN = false;
    unsigned char* Y; const PG8_LAS int* ul;
    __device__ __forceinline__ void operator()(const f32x4 (&acc)[2][2][4][2], const Unit& u, int wr, int wc, int fr, int fq) const {
        const PG8_LAS int* p = ul + 6 * u.idx; const int aux2 = p[4], nv = p[5];
        typedef unsigned u32x2 __attribute__((ext_vector_type(2)));
#pragma unroll
        for (int ai = 0; ai < 2; ++ai)
#pragma unroll
            for (int m = 0; m < 4; ++m) {
                const int rl = ai * HALF + wr * 64 + m * 16 + fr;
                if (rl < nv) {
                    unsigned char* rowp = Y + (size_t)(aux2 + rl) * DM + u.pn * BM + wc * 32 + 8 * fq;
#pragma unroll
                    for (int bj = 0; bj < 2; ++bj) {
                        f32x4 v0 = acc[ai][bj][m][0] * 64.f, v1 = acc[ai][bj][m][1] * 64.f;
#pragma unroll
                        for (int q = 0; q < 4; ++q) { v0[q] = __builtin_fminf(__builtin_fmaxf(v0[q], -448.f), 448.f); v1[q] = __builtin_fminf(__builtin_fmaxf(v1[q], -448.f), 448.f); }
                        int w0 = __builtin_amdgcn_cvt_pk_fp8_f32(v0[0], v0[1], 0, false); w0 = __builtin_amdgcn_cvt_pk_fp8_f32(v0[2], v0[3], w0, true);
                        int w1 = __builtin_amdgcn_cvt_pk_fp8_f32(v1[0], v1[1], 0, false); w1 = __builtin_amdgcn_cvt_pk_fp8_f32(v1[2], v1[3], w1, true);
                        *(u32x2*)(rowp + bj * HALF) = (u32x2){(unsigned)w0, (unsigned)w1};
                    }
                }
            }
    }
};
struct EpiRouter {
    static constexpr bool PERM = true, AFTER_DRAIN = true;
    const float* rbias; int* cnt; int* TOKL; float* GATEL; int* ASG;
    __device__ __forceinline__ void fused(f32x4 (&acc)[2][2][4][2], const Unit& u, int wr, int wc, int fr, int fq, PG8_LAS unsigned char* lds, int wid, int lane) const {
        PG8_LAS float* L = (PG8_LAS float*)lds;
        PG8_LAS float* rb = L + 256 * 65; PG8_LAS int* lcnt = (PG8_LAS int*)(rb + 64); PG8_LAS int* base = lcnt + 64;
        const int tid = wid * 64 + lane;
        if (tid < 64) { rb[tid] = rbias[tid]; lcnt[tid] = 0; }
        if (wc < 2) {
#pragma unroll
            for (int ai = 0; ai < 2; ++ai)
#pragma unroll
                for (int m = 0; m < 4; ++m)
#pragma unroll
                    for (int n = 0; n < 2; ++n) { const int rl = ai * HALF + wr * 64 + m * 16 + fr, e0 = wc * 32 + fq * 8 + n * 4; const f32x4 v = acc[ai][0][m][n];
#pragma unroll
                        for (int q = 0; q < 4; ++q) L[rl * 65 + e0 + q] = 1.f / (1.f + expf(-v[q])); }
        }
        __syncthreads();
        int sel[6]; int lr[6]; float gv[6]; float scale = 0.f;
        if (tid < 256) {
            const PG8_LAS float* my = L + tid * 65;
            float gs[8];
#pragma unroll
            for (int g = 0; g < 8; ++g) {
                float m1 = -3e38f, m2 = -3e38f;
#pragma unroll
                for (int j = 0; j < 8; ++j) { const float v = my[g * 8 + j] + rb[g * 8 + j]; if (v > m1) { m2 = m1; m1 = v; } else if (v > m2) m2 = v; }
                gs[g] = m1 + m2;
            }
            unsigned gmask = 0;
#pragma unroll
            for (int r = 0; r < 4; ++r) {
                float best = -3e38f; int bi = 0;
#pragma unroll
                for (int g = 0; g < 8; ++g) { const bool take = !((gmask >> g) & 1u) && gs[g] > best; if (take) { best = gs[g]; bi = g; } }
                gmask |= 1u << bi;
            }
            unsigned long long chosen = 0ull; float gsum = 0.f;
#pragma unroll
            for (int r = 0; r < 6; ++r) {
                float best = -3e38f; int bi = 0;
                for (int e = 0; e < 64; ++e) { if (((gmask >> (e >> 3)) & 1u) && !((chosen >> e) & 1ull)) { const float v = my[e] + rb[e]; if (v > best) { best = v; bi = e; } } }
                chosen |= 1ull << bi; sel[r] = bi; gv[r] = my[bi]; gsum += gv[r];
                lr[r] = __hip_atomic_fetch_add(lcnt + bi, 1, __ATOMIC_RELAXED, __HIP_MEMORY_SCOPE_WORKGROUP);
            }
            scale = ROUTED_SCALE / gsum;
        }
        __syncthreads();
        if (tid < 64) base[tid] = atomicAdd(cnt + tid, lcnt[tid]);
        __syncthreads();
        if (tid < 256) {
            const int tok = u.pm * BM + tid;
#pragma unroll
            for (int r = 0; r < 6; ++r) { const int e = sel[r], rank = base[e] + lr[r]; TOKL[(size_t)e * CAP + rank] = tok; GATEL[(size_t)e * CAP + rank] = gv[r] * scale; ASG[(size_t)tok * 6 + r] = (e << 16) | rank; }
        }
        __syncthreads();
    }
};
struct EpiInproj {
    static constexpr bool PERM = true, AFTER_DRAIN = false;
    bf16_t* bufs; const PG8_LAS float* tab;
    __device__ __forceinline__ void operator()(const f32x4 (&acc)[2][2][4][2], const Unit& u, int wr, int wc, int fr, int fq) const {
        const int g = u.pn >> 1;
        bf16_t* base = bufs + (size_t)g * BUFE;
        const int ccb = (u.pn & 1) * 256 + wc * 32 + 8 * fq;
        float ihi[4], ilo[4];
#pragma unroll
        for (int jj = 0; jj < 4; ++jj) { ihi[jj] = 0.f; ilo[jj] = 0.f; }
        if (g < 2) {
#pragma unroll
            for (int jj = 0; jj < 4; ++jj) { const int j = 16 * wc + 4 * fq + jj; ihi[jj] = tab[2 * j]; ilo[jj] = tab[2 * j + 1]; }
        }
#pragma unroll
        for (int ai = 0; ai < 2; ++ai)
#pragma unroll
            for (int m = 0; m < 4; ++m) {
                const int row = u.pm * BM + ai * HALF + wr * 64 + m * 16 + fr; const int b = row >> 12, i = row & 4095;
                bf16_t* rowp = base + ((size_t)b * LT + XPOS0 + i) * 512 + ccb;
                float cs[4], sn[4];
                if (g < 2) {
                    const float t = (float)(NMETA + i);
#pragma unroll
                    for (int jj = 0; jj < 4; ++jj) { const float p = t * ihi[jj]; const float e = __builtin_fmaf(t, ihi[jj], -p) + t * ilo[jj]; const float f = (p - __builtin_floorf(p)) + e;
                        sn[jj] = __builtin_amdgcn_sinf(f); cs[jj] = __builtin_amdgcn_cosf(f); }
                }
#pragma unroll
                for (int bj = 0; bj < 2; ++bj) {
                    f32x4 v0 = acc[ai][bj][m][0], v1 = acc[ai][bj][m][1];
                    if (g < 2) {
                        f32x4 r0, r1;
                        r0[0] = v0[0] * cs[0] - v0[1] * sn[0]; r0[1] = v0[1] * cs[0] + v0[0] * sn[0]; r0[2] = v0[2] * cs[1] - v0[3] * sn[1]; r0[3] = v0[3] * cs[1] + v0[2] * sn[1];
                        r1[0] = v1[0] * cs[2] - v1[1] * sn[2]; r1[1] = v1[1] * cs[2] + v1[0] * sn[2]; r1[2] = v1[2] * cs[3] - v1[3] * sn[3]; r1[3] = v1[3] * cs[3] + v1[2] * sn[3];
                        const float sc = (g == 1) ? RK_SCALE : 1.f; v0 = r0 * sc; v1 = r1 * sc;
                    } else if (g == 3) {
#pragma unroll
                        for (int q = 0; q < 4; ++q) { v0[q] = v0[q] / (1.f + __expf(-v0[q])); v1[q] = v1[q] / (1.f + __expf(-v1[q])); }
                    } else if (g == 4) { v0 = v0 * C2; v1 = v1 * C2; }
                    u32x4 w; w.x = cvt_pk_bf16(v0[0], v0[1]); w.y = cvt_pk_bf16(v0[2], v0[3]); w.z = cvt_pk_bf16(v1[0], v1[1]); w.w = cvt_pk_bf16(v1[2], v1[3]);
                    *(u32x4*)(rowp + bj * HALF) = w;
                }
            }
    }
};
template <class Epi, class Sched, bool ALIGN_EPI = false, bool SP2 = false>
__device__ __forceinline__ void gemm_phase(PG8_LAS unsigned char* lds, const Gemm g, const Sched& S, const Epi& E) {
    const int tid = threadIdx.x, wid = __builtin_amdgcn_readfirstlane(tid >> 6), lane = tid & 63, wr = wid >> 2, wc = wid & 3, fr = lane & 15, fq = lane >> 4;
    const int K = g.K, nt = K / BK;
    unsigned voffB[2];
#pragma unroll
    for (int i = 0; i < 2; ++i) { int R, C; stage_rc(tid * 16 + i * 8192, R, C); const int Rb = Epi::PERM ? ((R & ~31) + perm32(R & 31)) : R;
        voffB[i] = (unsigned)(Rb * K + C) * 2u; }
    const size_t kstep = (size_t)(BK * 2);
    const size_t hstep = (size_t)HALF * K * 2;
    const unsigned ldsw = (unsigned)wid * 1024u;
    const int aoff = lds_byte(wr * 64 + fr, fq * 8), boff = lds_byte(wc * 32 + fr, fq * 8);
#define PG8_SA(b, h) (((b) * 2 + (h)) * HTB)
#define PG8_SB(b, h) ((4 + (b) * 2 + (h)) * HTB)
#define PG8_STAGE(bufoff, gbase, voff) do { _Pragma("unroll") for (int _i = 0; _i < 2; ++_i) \
        __builtin_amdgcn_global_load_lds((const unsigned*)((const char*)(gbase) + (voff)[_i]), (PG8_LAS unsigned*)(lds + (bufoff) + ldsw + _i * 8192), 16, 0, 0); } while (0)
#define PG8_STAGEA(bufoff, VO, h, kofs) do { _Pragma("unroll") for (int _i = 0; _i < 2; ++_i) \
        __builtin_amdgcn_global_load_lds((const unsigned*)(Ab + (size_t)(VO)[h][_i] + (size_t)(kofs)), (PG8_LAS unsigned*)(lds + (bufoff) + ldsw + _i * 8192), 16, 0, 0); } while (0)
#define PG8_LDA(dst, b, h) do { _Pragma("unroll") for (int m = 0; m < 4; ++m) _Pragma("unroll") for (int k = 0; k < 2; ++k) dst[m][k] = *(const PG8_LAS bf16x8*)(lds + PG8_SA(b, h) + aoff + m * 2048 + k * 1024); } while (0)
#define PG8_LDB(dst, b, h) do { _Pragma("unroll") for (int n = 0; n < 2; ++n) _Pragma("unroll") for (int k = 0; k < 2; ++k) dst[n][k] = *(const PG8_LAS bf16x8*)(lds + PG8_SB(b, h) + boff + n * 2048 + k * 1024); } while (0)
#define PG8_MMA(ai, bj, At, Bt) do { __builtin_amdgcn_s_setprio(1); _Pragma("unroll") for (int m = 0; m < 4; ++m) _Pragma("unroll") for (int n = 0; n < 2; ++n) _Pragma("unroll") for (int k = 0; k < 2; ++k) \
        acc[ai][bj][m][n] = __builtin_amdgcn_mfma_f32_16x16x32_bf16(Bt[n][k], At[m][k], acc[ai][bj][m][n], 0, 0, 0); __builtin_amdgcn_s_setprio(0); } while (0)
#define PG8_WAIT_V(n) asm volatile("s_waitcnt vmcnt(" #n ")" ::: "memory")
#define PG8_WAIT_L(n) asm volatile("s_waitcnt lgkmcnt(" #n ")" ::: "memory")
#define PG8_BAR __builtin_amdgcn_s_barrier()
#define PG8_SCHED __builtin_amdgcn_sched_barrier(0)
    Unit cur, nxt; int ui = 0;
    if (!S.next(0, cur)) return;
    f32x4 acc[2][2][4][2];
#pragma unroll
    for (int a = 0; a < 2; ++a)
#pragma unroll
        for (int b = 0; b < 2; ++b)
#pragma unroll
            for (int m = 0; m < 4; ++m)
#pragma unroll
                for (int n = 0; n < 2; ++n) acc[a][b][m][n] = (f32x4){0.f, 0.f, 0.f, 0.f};
    bf16x8 At[4][2], B0[2][2], B1[2][2];
    const char* Ab = (const char*)g.A; const char* cB = S.b_base(g, cur);
    unsigned VA[2][2], VN[2][2];
    S.a_offs(g, cur, tid, VA);
    S.a_ready(cur);
    if constexpr (SP2) {
        PG8_STAGE(PG8_SB(0, 0), cB, voffB); PG8_STAGE(PG8_SB(0, 1), cB + hstep, voffB); PG8_STAGEA(PG8_SA(0, 0), VA, 0, 0); PG8_STAGEA(PG8_SA(0, 1), VA, 1, 0);
        if (wr == 1) PG8_BAR;
        PG8_WAIT_V(2); PG8_BAR;
        PG8_STAGE(PG8_SB(1, 0), cB + kstep, voffB); PG8_STAGEA(PG8_SA(1, 0), VA, 0, kstep); PG8_STAGE(PG8_SB(1, 1), cB + hstep + kstep, voffB);
        PG8_WAIT_V(6); PG8_BAR;
    } else { static_assert(SP2, "only the SP2 loop is kept in this file"); }
    for (;;) {
        const bool has_next = S.next(ui + 1, nxt);
        const char* nB = has_next ? S.b_base(g, nxt) : cB;
        if (has_next) S.a_offs(g, nxt, tid, VN);
        else {
#pragma unroll
            for (int h = 0; h < 2; ++h)
#pragma unroll
                for (int i = 0; i < 2; ++i) VN[h][i] = VA[h][i]; }
#pragma unroll 1
        for (int t = 0; t < nt; t += 2) {
            const bool last = (t == nt - 2);
            const size_t k1 = (size_t)(t + 1) * kstep, k2 = last ? (size_t)0 : (size_t)(t + 2) * kstep;
            const char* b2 = last ? nB : cB + (size_t)(t + 2) * kstep; const char* b3 = b2 + kstep;
            if (last && has_next) S.a_ready(nxt);
            if constexpr (SP2) {
            PG8_LDB(B0, 0, 0); PG8_LDB(B1, 0, 1); PG8_SCHED; PG8_LDA(At, 0, 0); PG8_STAGEA(PG8_SA(1, 1), VA, 1, k1);
            if (last) {
#pragma unroll
                for (int h = 0; h < 2; ++h)
#pragma unroll
                    for (int i = 0; i < 2; ++i) VA[h][i] = VN[h][i]; }
            PG8_WAIT_V(8); PG8_WAIT_L(0); PG8_BAR; PG8_MMA(0, 0, At, B0); PG8_MMA(0, 1, At, B1); PG8_BAR; PG8_SCHED;
            PG8_LDA(At, 0, 1); PG8_STAGE(PG8_SB(0, 0), b2, voffB); PG8_STAGE(PG8_SB(0, 1), b2 + hstep, voffB); PG8_STAGEA(PG8_SA(0, 0), VA, 0, k2);
            PG8_WAIT_V(8); PG8_WAIT_L(0); PG8_BAR; PG8_MMA(1, 0, At, B0); PG8_MMA(1, 1, At, B1); PG8_BAR; PG8_SCHED;
            PG8_LDB(B0, 1, 0); PG8_LDB(B1, 1, 1); PG8_SCHED; PG8_LDA(At, 1, 0); PG8_STAGEA(PG8_SA(0, 1), VA, 1, k2);
            PG8_WAIT_V(8); PG8_WAIT_L(0); PG8_BAR; PG8_MMA(0, 0, At, B0); PG8_MMA(0, 1, At, B1); PG8_BAR; PG8_SCHED;
            PG8_LDA(At, 1, 1); PG8_STAGE(PG8_SB(1, 0), b3, voffB); PG8_STAGE(PG8_SB(1, 1), b3 + hstep, voffB); PG8_STAGEA(PG8_SA(1, 0), VA, 0, k2 + kstep);
            PG8_WAIT_V(8); PG8_WAIT_L(0); PG8_BAR; PG8_MMA(1, 0, At, B0); PG8_MMA(1, 1, At, B1); PG8_BAR; PG8_SCHED;
            }
        }
        if constexpr (ALIGN_EPI) { if (wr == 0) PG8_BAR; }
        if constexpr (!Epi::AFTER_DRAIN) { E(acc, cur, wr, wc, fr, fq); S.done(cur); }
        if (!has_next) break;
#pragma unroll
        for (int a = 0; a < 2; ++a)
#pragma unroll
            for (int b = 0; b < 2; ++b)
#pragma unroll
                for (int m = 0; m < 4; ++m)
#pragma unroll
                    for (int n = 0; n < 2; ++n) acc[a][b][m][n] = (f32x4){0.f, 0.f, 0.f, 0.f};
        cur = nxt; cB = nB; ++ui;
        if constexpr (ALIGN_EPI) { if (wr == 1) PG8_BAR; }
    }
    PG8_WAIT_V(0);
    if constexpr (!ALIGN_EPI) { if (wr == 0) PG8_BAR; }
    PG8_BAR;
    if constexpr (Epi::AFTER_DRAIN) { E.fused(acc, cur, wr, wc, fr, fq, lds, wid, lane); S.done(cur); }
#undef PG8_SA
#undef PG8_SB
#undef PG8_STAGE
#undef PG8_STAGEA
#undef PG8_LDA
#undef PG8_LDB
#undef PG8_MMA
#undef PG8_WAIT_V
#undef PG8_WAIT_L
#undef PG8_BAR
#undef PG8_SCHED
}
}

#include <hip/hip_bf16.h>
namespace attn_body {
using bf16=__hip_bfloat16;
using bf16x8=__attribute__((ext_vector_type(8)))short;
using s16x4=__attribute__((ext_vector_type(4)))short;
using f32x16=__attribute__((ext_vector_type(16)))float;
using u32x4=__attribute__((ext_vector_type(4)))unsigned;
constexpr int BATCH=8,NHEAD=8,SEQ=4352,D=64,DM=512,OPITCH=1024,OCOL0=512,T0=2,XROWS=4096;
constexpr int NW=8,QBLK=32,QB=QBLK*NW,KVBLK=64,NQB=SEQ/QB;
constexpr int ATTN_PITCH=DM, ATTN_UNIT_ROWS=QB;
__device__ __forceinline__ int crow(int r,int hi){return (r&3)+8*(r>>2)+4*hi;}
#define SBAR() __builtin_amdgcn_sched_barrier(0)
__device__ __forceinline__ void cmask(f32x16&p0,f32x16&p1,int jb,int qrel,int hi){
  const float NEG=-INFINITY; int kb=64*jb+4*hi;
  #pragma unroll
  for(int r=0;r<16;++r){int kv=kb+(r&3)+8*(r>>2); if(kv>qrel)p0[r]=NEG; if(kv+32>qrel)p1[r]=NEG;}
}

constexpr int NSLOT=3, SLOTB=8192;
constexpr int LDS_K=0, LDS_V=NSLOT*SLOTB, LDS_WS=2*NSLOT*SLOTB, LDS_OST=LDS_WS+NW*64*4, LDS_BIAS=LDS_OST+NW*4096, LDS_BYTES=LDS_BIAS+SEQ*4;
constexpr float C2=0.125f*1.4426950408889634f;
__device__ __forceinline__ void glds16(const void*gsrc,unsigned lds_dst){unsigned keep;
  asm volatile("s_mov_b32 %0, m0\n\ts_mov_b32 m0, %2\n\ts_nop 0\n\tglobal_load_lds_dwordx4 %1, off\n\ts_mov_b32 m0, %0":"=&s"(keep):"v"(gsrc),"s"(lds_dst):"memory");}
__device__ __forceinline__ float max3f(float a,float b,float c){float r;asm("v_max3_f32 %0, %1, %2, %3":"=v"(r):"v"(a),"v"(b),"v"(c));return r;}
__device__ __forceinline__ float max2f(float a,float b){float r;asm("v_max_f32_e32 %0, %1, %2":"=v"(r):"v"(a),"v"(b));return r;}
__device__ __forceinline__ float fadd_s(float a,float b){float r;asm("v_add_f32_e32 %0, %1, %2":"=v"(r):"v"(a),"v"(b));return r;}
__device__ __forceinline__ float fsub_s(float a,float b){float r;asm("v_sub_f32_e32 %0, %1, %2":"=v"(r):"v"(a),"v"(b));return r;}
typedef float f32x2_t __attribute__((ext_vector_type(2))); typedef __bf16 bf16x2_t __attribute__((ext_vector_type(2)));
__device__ __forceinline__ unsigned cvtpk_s(float lo,float hi){f32x2_t v={lo,hi};bf16x2_t b=__builtin_convertvector(v,bf16x2_t);return __builtin_bit_cast(unsigned,b);}
#define WAIT_BAR(N) asm volatile("s_waitcnt vmcnt(" #N ") lgkmcnt(0)\n\ts_barrier":::"memory")

__device__ __forceinline__ void qkt(f32x16&p0,f32x16&p1,const char*Kslot,const bf16x8*qr,const f32x16 c0in,const f32x16 c1in,int r32,int hi){
  const char*kb=Kslot+hi*1024+r32*16;
  #pragma unroll
  for(int d0=0;d0<4;++d0){
    const bf16x8 b0=*reinterpret_cast<const bf16x8*>(kb+d0*2048);
    const bf16x8 b1=*reinterpret_cast<const bf16x8*>(kb+d0*2048+512);
    if(d0==0){p0=__builtin_amdgcn_mfma_f32_32x32x16_bf16(b0,qr[0],c0in,0,0,0);p1=__builtin_amdgcn_mfma_f32_32x32x16_bf16(b1,qr[0],c1in,0,0,0);}
    else{p0=__builtin_amdgcn_mfma_f32_32x32x16_bf16(b0,qr[d0],p0,0,0,0);p1=__builtin_amdgcn_mfma_f32_32x32x16_bf16(b1,qr[d0],p1,0,0,0);}}
}
typedef __attribute__((address_space(3))) const char* lds_cptr;
typedef short v4i16_t __attribute__((ext_vector_type(4)));
__device__ __forceinline__ void kload8(bf16x8*kf,lds_cptr kp){
  kf[0]=*(const __attribute__((address_space(3))) bf16x8*)(kp);      kf[1]=*(const __attribute__((address_space(3))) bf16x8*)(kp+512);
  kf[2]=*(const __attribute__((address_space(3))) bf16x8*)(kp+2048); kf[3]=*(const __attribute__((address_space(3))) bf16x8*)(kp+2560);
  kf[4]=*(const __attribute__((address_space(3))) bf16x8*)(kp+4096); kf[5]=*(const __attribute__((address_space(3))) bf16x8*)(kp+4608);
  kf[6]=*(const __attribute__((address_space(3))) bf16x8*)(kp+6144); kf[7]=*(const __attribute__((address_space(3))) bf16x8*)(kp+6656);
}
__device__ __forceinline__ void kload2(bf16x8*kf,lds_cptr kp,int j){ kf[2*j]=*(const __attribute__((address_space(3))) bf16x8*)(kp+j*2048); kf[2*j+1]=*(const __attribute__((address_space(3))) bf16x8*)(kp+j*2048+512); }
__device__ __forceinline__ s16x4 vtr(lds_cptr p){ return __builtin_bit_cast(s16x4,__builtin_amdgcn_ds_read_tr16_b64_v4i16((__attribute__((address_space(3))) v4i16_t*)p)); }
__device__ __forceinline__ float rowmax(const f32x16&p0,const f32x16&p1){
  float a=max3f(p0[0],p0[1],p1[0]),b=max3f(p0[2],p0[3],p1[1]);a=max3f(a,p1[2],p1[3]);
  #pragma unroll
  for(int r=4;r<16;r+=4){a=max3f(a,p0[r],p0[r+1]);b=max3f(b,p0[r+2],p0[r+3]);a=max3f(a,p1[r],p1[r+1]);b=max3f(b,p1[r+2],p1[r+3]);}
  const float m=max2f(a,b);
  auto rr=__builtin_amdgcn_permlane32_swap(__float_as_uint(m),__float_as_uint(m),false,false);
  return max2f(__uint_as_float(rr[0]),__uint_as_float(rr[1]));
}
__device__ __forceinline__ void pv(f32x16*o,int vb,bf16x8 pa0,bf16x8 pa1,bf16x8 pa2,bf16x8 pa3){
  #pragma unroll
  for(int d0=0;d0<2;++d0){s16x4 lo[4],hi[4];
    #pragma unroll
    for(int ks=0;ks<4;++ks){
      asm volatile("ds_read_b64_tr_b16 %0,%1 offset:%c2":"=&v"(lo[ks]):"v"(vb),"i"(d0*4096+ks*1024):"memory");
      asm volatile("ds_read_b64_tr_b16 %0,%1 offset:%c2":"=&v"(hi[ks]):"v"(vb),"i"(d0*4096+ks*1024+512):"memory");}
    asm volatile("s_waitcnt lgkmcnt(0)":::"memory");SBAR();
    #define PK(k) (bf16x8){lo[k][0],lo[k][1],lo[k][2],lo[k][3],hi[k][0],hi[k][1],hi[k][2],hi[k][3]}
    o[d0]=__builtin_amdgcn_mfma_f32_32x32x16_bf16(pa0,PK(0),o[d0],0,0,0);
    o[d0]=__builtin_amdgcn_mfma_f32_32x32x16_bf16(pa1,PK(1),o[d0],0,0,0);
    o[d0]=__builtin_amdgcn_mfma_f32_32x32x16_bf16(pa2,PK(2),o[d0],0,0,0);
    o[d0]=__builtin_amdgcn_mfma_f32_32x32x16_bf16(pa3,PK(3),o[d0],0,0,0);
    #undef PK
  }
}

#ifndef ATTN_STORE16
#define ATTN_STORE16(p,v) (*(u32x4*)(p)=(v))
#endif
typedef float f32x4v __attribute__((ext_vector_type(4)));
template<int THRL> __device__ __forceinline__ void attn_unit(int b,int h,int qb,unsigned char*ws,char*shm,int tid_in){
  const bf16*Q=(const bf16*)(ws+WS_RQ)+4*BUFE; const bf16*__restrict__ K=Q+BUFE; const bf16*__restrict__ V=Q+2*BUFE; const float*__restrict__ BIAS=(const float*)(ws+WS_BIAS); bf16*O=(bf16*)(ws+WS_MIXED);
  const int tid=tid_in,lane=tid&63,r32=lane&31,hi=lane>>5; const int wid=__builtin_amdgcn_readfirstlane(tid>>6);
  const long rowbase=(long)b*SEQ; const int q0=(qb+1)*QB;
  const bf16*Qw=Q+(rowbase+q0+wid*QBLK)*DM+h*D;
  const bf16*Kh=K+(rowbase+T0*KVBLK)*DM+h*D; const bf16*Vh=V+(rowbase+T0*KVBLK)*DM+h*D;
  int tskip=0; float sbound=0.f;
  int NT=(q0+QB)/KVBLK-T0;
  { const float*ba=BIAS+(long)(b*NHEAD+h)*SEQ; const unsigned*qk=(const unsigned*)(ws+WS_CTL)+CW_QK2+2*(b*NHEAD+h);
    sbound=sqrtf(__uint_as_float(qk[0])*__uint_as_float(qk[1])); const float thr=2.f*sbound+40.f; const float bq0=ba[q0];
    const int cand=2*lane; bool ok=false; if(cand>=2&&cand<=NT-4){int pe=T0*KVBLK+cand*KVBLK-1; if(pe<256)pe=143; ok=(bq0-ba[pe])>thr;}
    const unsigned long long mk=__ballot(ok); const int ts=__builtin_amdgcn_readfirstlane(mk?2*(63-__builtin_clzll(mk)):0);
    Kh+=(long)ts*KVBLK*DM; Vh+=(long)ts*KVBLK*DM; NT-=ts; tskip=ts; }
  const unsigned lds0=(unsigned)(uintptr_t)shm;
  float*wsf=(float*)(shm+LDS_WS)+wid*64;
  const bf16*ksrc=Kh+(long)lane*DM+wid*8;
  const bf16*vsrc=Vh+(long)(16*(wid&3)+(lane>>2))*DM+(wid>>2)*32+(lane&3)*8;
  const unsigned kdst=lds0+LDS_K+wid*1024, vdst=lds0+LDS_V+wid*1024;
  #define DMA_K(t,slot) glds16(ksrc+(long)(t)*KVBLK*DM,(unsigned)__builtin_amdgcn_readfirstlane(kdst+(slot)))
  #define DMA_V(t,slot) glds16(vsrc+(long)(t)*KVBLK*DM,(unsigned)__builtin_amdgcn_readfirstlane(vdst+(slot)))
  const int vb0=(int)(lds0+LDS_V)+((lane>>4)&1)*32+(lane&3)*8+(4*hi+((lane&15)>>2))*64;
  const char*Kbase=shm+LDS_K; bf16x8 kf[8];
  const lds_cptr shm3=(lds_cptr)shm; const lds_cptr kp0=shm3+LDS_K+hi*1024+r32*16; const lds_cptr vp0=shm3+LDS_V+((lane>>4)&1)*32+(lane&3)*8+(4*hi+((lane&15)>>2))*64;
  { const float*bsrc=BIAS+(long)(b*NHEAD+h)*SEQ+(T0+tskip)*KVBLK; float*bl=(float*)(shm+LDS_BIAS); const int nb=NT*KVBLK; for(int p=tid;p<nb;p+=NW*64)bl[p]=bsrc[p]; }
  const __attribute__((address_space(3))) float* bl3=(const __attribute__((address_space(3))) float*)((lds_cptr)shm+LDS_BIAS);
  #define BIASLD(C0,C1,t) do{ const __attribute__((address_space(3))) f32x4v* bp_=(const __attribute__((address_space(3))) f32x4v*)(bl3+(t)*KVBLK+4*hi); \
    _Pragma("unroll") for(int g_=0;g_<4;++g_){ const f32x4v x0_=bp_[2*g_],x1_=bp_[8+2*g_]; \
      C0[4*g_]=x0_[0]-mhat;C0[4*g_+1]=x0_[1]-mhat;C0[4*g_+2]=x0_[2]-mhat;C0[4*g_+3]=x0_[3]-mhat; C1[4*g_]=x1_[0]-mhat;C1[4*g_+1]=x1_[1]-mhat;C1[4*g_+2]=x1_[2]-mhat;C1[4*g_+3]=x1_[3]-mhat; } }while(0)
  DMA_K(0,0);DMA_V(0,0);DMA_K(1,SLOTB);
  bf16x8 qr[4];
  #pragma unroll
  for(int d0=0;d0<4;++d0)qr[d0]=*reinterpret_cast<const bf16x8*>(&Qw[(long)r32*DM+d0*16+hi*8]);
  float mhat=BIAS[(long)(b*NHEAD+h)*SEQ+q0+wid*QBLK+r32]+sbound,l_reg=0.f;f32x16 o[2];o[0]=f32x16{};o[1]=f32x16{};
  const int qrel=wid*QBLK+r32;
  #define CMASK(P0,P1,t) do{int jb_=(t)-(NT-4); if(jb_>=0)cmask(P0,P1,jb_,qrel,hi);}while(0)
  #define START(P0,P1) do{ _Pragma("unroll") for(int r=0;r<16;++r)P0[r]=__builtin_amdgcn_exp2f(P0[r]); }while(0)
  #define RESC() do{}while(0)
  f32x16 pA0,pA1,pB0,pB1;
  int sl_prev=0,sl_cur=0,sl_next=SLOTB;
  #define ROT() do{sl_prev=sl_cur;sl_cur=sl_next;sl_next=(sl_next==(NSLOT-1)*SLOTB)?0:sl_next+SLOTB;}while(0)
  DMA_K(2,2*SLOTB);
  WAIT_BAR(3);
  BIASLD(pA0,pA1,0);qkt(pA0,pA1,Kbase,qr,pA0,pA1,r32,hi);asm volatile("s_nop 15\n\ts_nop 7":"+v"(pA0),"+v"(pA1));CMASK(pA0,pA1,0);
  START(pA0,pA1);
  _Pragma("unroll") for(int r=0;r<16;++r)pA1[r]=__builtin_amdgcn_exp2f(pA1[r]);
  WAIT_BAR(0);
  DMA_K(3,0);DMA_V(1,SLOTB);
  ROT();
  kload8(kf,kp0+sl_cur);
  WAIT_BAR(2);
  s16x4 vlo[8],vhi[8]; u32x4 pw0,pw1,pw2,pw3;
  #define PKW(P,B) cvtpk_s(P[B],P[B+1])
  #define PAF(k) __builtin_bit_cast(bf16x8,pw##k)
  #define VFR(i) (bf16x8){vlo[i][0],vlo[i][1],vlo[i][2],vlo[i][3],vhi[i][0],vhi[i][1],vhi[i][2],vhi[i][3]}
  #define PIN(x) asm volatile("":"+v"(x))
  #define MX3(a,b,c) __builtin_fmaxf(__builtin_fmaxf((a),(b)),(c))
  #define GAPA(MF,A0,A1,A2,A3,W0,W1,PW) do{ MF; sacc+=A0; sacc+=A1; sacc+=A2; sacc+=A3; PIN(sacc); W0; W1; PIN(PW); SBAR(); }while(0)
  #define EX(v) __builtin_amdgcn_exp2f(v)
  #define GAPB(MF,X,B) do{ MF; X[B]=EX(X[B]); X[B+1]=EX(X[B+1]); X[B+2]=EX(X[B+2]); X[B+3]=EX(X[B+3]); PIN(X); SBAR(); }while(0)
  #define VRD(i) do{ vlo[i]=vtr(vp_+(((i)>>2)*4096+((i)&3)*1024)); vhi[i]=vtr(vp_+(((i)>>2)*4096+((i)&3)*1024+512)); }while(0)
  #define KRD(G,j) do{ if(G){ kload2(kf,kp0+sl_next,j); SBAR(); } }while(0)
  #define STEP(C0,C1,P0,P1,t,GK,GV,GL) do{ BIASLD(C0,C1,t); SBAR(); \
    const lds_cptr vp_=vp0+sl_prev; \
    VRD(0); SBAR(); float sacc=(P0[0]+P0[1]); \
    GAPA(C0=__builtin_amdgcn_mfma_f32_32x32x16_bf16(kf[0],qr[0],C0,0,0,0), P0[2],P0[3],P0[4],P0[5],     pw0[0]=PKW(P0,0), pw0[1]=PKW(P0,2), pw0); \
    VRD(4); SBAR(); GAPA(C1=__builtin_amdgcn_mfma_f32_32x32x16_bf16(kf[1],qr[0],C1,0,0,0), P0[6],P0[7],P0[8],P0[9],     pw0[2]=PKW(P0,4), pw0[3]=PKW(P0,6), pw0); \
    VRD(1); SBAR(); GAPA(C0=__builtin_amdgcn_mfma_f32_32x32x16_bf16(kf[2],qr[1],C0,0,0,0),   P0[10],P0[11],P0[12],P0[13], pw1[0]=PKW(P0,8), pw1[1]=PKW(P0,10), pw1); \
    VRD(5); SBAR(); GAPA(C1=__builtin_amdgcn_mfma_f32_32x32x16_bf16(kf[3],qr[1],C1,0,0,0),   P0[14],P0[15],P1[0],P1[1],   pw1[2]=PKW(P0,12),pw1[3]=PKW(P0,14), pw1); \
    VRD(2); SBAR(); GAPA(C0=__builtin_amdgcn_mfma_f32_32x32x16_bf16(kf[4],qr[2],C0,0,0,0),   P1[2],P1[3],P1[4],P1[5],     pw2[0]=PKW(P1,0), pw2[1]=PKW(P1,2), pw2); \
    VRD(6); SBAR(); GAPA(C1=__builtin_amdgcn_mfma_f32_32x32x16_bf16(kf[5],qr[2],C1,0,0,0),   P1[6],P1[7],P1[8],P1[9],     pw2[2]=PKW(P1,4), pw2[3]=PKW(P1,6), pw2); \
    VRD(3); SBAR(); GAPA(C0=__builtin_amdgcn_mfma_f32_32x32x16_bf16(kf[6],qr[3],C0,0,0,0),   P1[10],P1[11],P1[12],P1[13], pw3[0]=PKW(P1,8), pw3[1]=PKW(P1,10), pw3); \
    VRD(7); SBAR(); GAPA(C1=__builtin_amdgcn_mfma_f32_32x32x16_bf16(kf[7],qr[3],C1,0,0,0),   P1[14],P1[15],0.f,0.f,       pw3[2]=PKW(P1,12),pw3[3]=PKW(P1,14), pw3); \
    l_reg+=sacc; \
    if(GK){DMA_K((t)+3,sl_cur);} if(GV){DMA_V((t)+1,sl_next);} \
    CMASK(C0,C1,t); \
    SBAR(); \
    GAPB(o[0]=__builtin_amdgcn_mfma_f32_32x32x16_bf16(PAF(0),VFR(0),o[0],0,0,0), C0,0); \
    GAPB(o[1]=__builtin_amdgcn_mfma_f32_32x32x16_bf16(PAF(0),VFR(4),o[1],0,0,0), C0,4); \
    KRD(GL,0); GAPB(o[0]=__builtin_amdgcn_mfma_f32_32x32x16_bf16(PAF(1),VFR(1),o[0],0,0,0), C0,8); \
    KRD(GL,1); GAPB(o[1]=__builtin_amdgcn_mfma_f32_32x32x16_bf16(PAF(1),VFR(5),o[1],0,0,0), C0,12); \
    KRD(GL,2); GAPB(o[0]=__builtin_amdgcn_mfma_f32_32x32x16_bf16(PAF(2),VFR(2),o[0],0,0,0), C1,0); \
    KRD(GL,3); GAPB(o[1]=__builtin_amdgcn_mfma_f32_32x32x16_bf16(PAF(2),VFR(6),o[1],0,0,0), C1,4); \
    GAPB(o[0]=__builtin_amdgcn_mfma_f32_32x32x16_bf16(PAF(3),VFR(3),o[0],0,0,0), C1,8); \
    GAPB(o[1]=__builtin_amdgcn_mfma_f32_32x32x16_bf16(PAF(3),VFR(7),o[1],0,0,0), C1,12); \
    }while(0)
  int t=1;
  #undef CMASK
  #define CMASK(P0,P1,t) do{}while(0)
  for(;t+5<NT;t+=2){
    STEP(pB0,pB1,pA0,pA1,t,true,true,true);     WAIT_BAR(2); RESC(); ROT();
    STEP(pA0,pA1,pB0,pB1,t+1,true,true,true);   WAIT_BAR(2); RESC(); ROT();
  }
  #undef CMASK
  #define CMASK(P0,P1,t) do{int jb_=(t)-(NT-4); if(jb_>=0)cmask(P0,P1,jb_,qrel,hi);}while(0)
  #define ENDW(tt) do{ if((tt)+3<NT){WAIT_BAR(2);} else if((tt)+2<NT){WAIT_BAR(1);} else {WAIT_BAR(0);} }while(0)
  for(;t+1<NT;t+=2){
    STEP(pB0,pB1,pA0,pA1,t,(t+3<NT),(t+1<NT),(t+1<NT));       ENDW(t);   RESC(); ROT();
    STEP(pA0,pA1,pB0,pB1,t+1,(t+4<NT),(t+2<NT),(t+2<NT));     ENDW(t+1); RESC(); ROT();
  }
  STEP(pB0,pB1,pA0,pA1,NT-1,false,false,false); RESC();
  { float sacc=pB0[0]+pB0[1]; _Pragma("unroll") for(int r=2;r<16;++r)sacc+=pB0[r]; _Pragma("unroll") for(int r=0;r<16;++r)sacc+=pB1[r]; l_reg+=sacc;
    pw0=(u32x4){PKW(pB0,0),PKW(pB0,2),PKW(pB0,4),PKW(pB0,6)};pw1=(u32x4){PKW(pB0,8),PKW(pB0,10),PKW(pB0,12),PKW(pB0,14)};pw2=(u32x4){PKW(pB1,0),PKW(pB1,2),PKW(pB1,4),PKW(pB1,6)};pw3=(u32x4){PKW(pB1,8),PKW(pB1,10),PKW(pB1,12),PKW(pB1,14)};
    SBAR(); pv(o,vb0+sl_cur,PAF(0),PAF(1),PAF(2),PAF(3)); }
  #undef PKW
  #undef PAF
  #undef VFR
  #undef PIN
  #undef MX3
  #undef GAPA
  #undef GAPB
  #undef EX
  #undef VRD
  #undef KRD
  #undef STEP
  #undef ENDW
  {auto rr=__builtin_amdgcn_permlane32_swap(__float_as_uint(l_reg),__float_as_uint(l_reg),false,false);l_reg=__uint_as_float(rr[0])+__uint_as_float(rr[1]);}
  if(hi==0)wsf[32+r32]=l_reg;asm volatile("s_waitcnt lgkmcnt(0)":::"memory");
  float rli[16];
  #pragma unroll
  for(int r=0;r<16;++r)rli[r]=__builtin_amdgcn_rcpf(wsf[32+crow(r,hi)]);
  bf16*Ow=O+((long)b*XROWS+qb*QB+wid*QBLK)*OPITCH+OCOL0+h*D;
  { bf16*stg=(bf16*)(shm+LDS_OST)+wid*2048;
    #pragma unroll
    for(int r=0;r<16;++r){const int orow=crow(r,hi);
      #pragma unroll
      for(int d0=0;d0<2;++d0)stg[orow*64+d0*32+r32]=__float2bfloat16(o[d0][r]*rli[r]);}
    asm volatile("s_waitcnt lgkmcnt(0)":::"memory");
    #pragma unroll
    for(int i=0;i<4;++i){const int row=i*8+(lane>>3),ch=lane&7; const u32x4 v=*(const u32x4*)(stg+row*64+ch*8); ATTN_STORE16(Ow+(long)row*OPITCH+ch*8,v);} }
  asm volatile("s_waitcnt lgkmcnt(0)\n\ts_barrier":::"memory");
  #undef DMA_K
  #undef DMA_V
  #undef CMASK
  #undef BIASLD
  #undef START
  #undef RESC
  #undef ROT
}
constexpr int ATTN_LDS_BYTES=LDS_BYTES;
struct AttnTensors { const bf16* Q; const bf16* K; const bf16* V; const float* BIAS; bf16* O; };
struct AttnUnit { int bh; int qb; };
struct StaticOrder {
  int vcu, grid;
  __device__ __forceinline__ explicit StaticOrder(int grid_,int block):vcu((grid_%8==0)?(block%8)*(grid_/8)+block/8:block),grid(grid_){}
  __device__ __forceinline__ bool next(int i,AttnUnit&u)const{
    if(grid==256){ if(i>=4)return false; const int s=vcu&3; u.bh=vcu>>2; u.qb=(i==0)?15-s:(i==1)?8+s:(i==2)?7-s:s; return true; }
    const int L=i*grid+vcu; if(L>=BATCH*NHEAD*16)return false; u.bh=L>>4; u.qb=15-(L&15); return true; }
  __device__ __forceinline__ void a_ready(const AttnUnit&)const{}
  __device__ __forceinline__ void done(const AttnUnit&)const{}
};
template<class Sched,int THRL=8> __device__ __forceinline__ void attn_phase(char*lds,const AttnTensors&T,const Sched&S){
  AttnUnit u;
  for(int i=0;S.next(i,u);++i){ S.a_ready(u); attn_unit<THRL>(u.bh/NHEAD,u.bh%NHEAD,u.qb,(unsigned char*)T.O,lds,(int)threadIdx.x);    S.done(u); }
}
#undef SBAR
#undef WAIT_BAR
}


namespace ret_body {
typedef __attribute__((address_space(3))) const char* lds_cptr;
using bf16x8 = __attribute__((ext_vector_type(8))) short;
using s16x4 = __attribute__((ext_vector_type(4))) short;
using f32x16 = __attribute__((ext_vector_type(16))) float;
using u32x4 = __attribute__((ext_vector_type(4))) unsigned;
using u32x2 = __attribute__((ext_vector_type(2))) unsigned;
typedef short v4i16_t __attribute__((ext_vector_type(4)));
#define RLAS __attribute__((address_space(3)))
constexpr int TQ = 0, TK = 32768, TV = 65536, TS = 98304;
__device__ __forceinline__ unsigned off_b(unsigned row, unsigned ch) { return 256u * row + 16u * (ch ^ (((row & 3u) << 2) | ((row >> 2) & 3u))); }
__device__ __forceinline__ int crow(int r, int hi) { return (r & 3) + 8 * (r >> 2) + 4 * hi; }
__device__ __forceinline__ bf16x8 ldrow(lds_cptr tile, unsigned row, unsigned ch) { return *(const RLAS bf16x8*)(tile + off_b(row, ch)); }
__device__ __forceinline__ s16x4 ldtr(lds_cptr p) { return __builtin_bit_cast(s16x4, __builtin_amdgcn_ds_read_tr16_b64_v4i16((RLAS v4i16_t*)p)); }
__device__ __forceinline__ bf16x8 trfrag_nat(lds_cptr tile, unsigned lane, unsigned c, unsigned row0) {
    const unsigned h = lane >> 5, blk = (lane >> 4) & 1, q = (lane & 15) >> 2, p = lane & 3, ch = 4 * c + 2 * blk + (p >> 1), ob = 8 * (p & 1);
    const s16x4 lo = ldtr(tile + off_b(row0 + 8 * h + q, ch) + ob), hi = ldtr(tile + off_b(row0 + 8 * h + 4 + q, ch) + ob);
    return (bf16x8){lo[0], lo[1], lo[2], lo[3], hi[0], hi[1], hi[2], hi[3]};
}
__device__ __forceinline__ bf16x8 trfrag_acc(lds_cptr tile, unsigned lane, unsigned c, unsigned row0) {
    const unsigned h = lane >> 5, blk = (lane >> 4) & 1, q = (lane & 15) >> 2, p = lane & 3, ch = 4 * c + 2 * blk + (p >> 1), ob = 8 * (p & 1);
    const s16x4 lo = ldtr(tile + off_b(row0 + 4 * h + q, ch) + ob), hi = ldtr(tile + off_b(row0 + 8 + 4 * h + q, ch) + ob);
    return (bf16x8){lo[0], lo[1], lo[2], lo[3], hi[0], hi[1], hi[2], hi[3]};
}
typedef float f32x2_t __attribute__((ext_vector_type(2))); typedef __bf16 bf16x2_t __attribute__((ext_vector_type(2)));
__device__ __forceinline__ unsigned cvtpk(float lo, float hi) { f32x2_t v = {lo, hi}; bf16x2_t b = __builtin_convertvector(v, bf16x2_t); return __builtin_bit_cast(unsigned, b); }
__device__ __forceinline__ float bflo(unsigned u) { return __uint_as_float(u << 16); }
__device__ __forceinline__ float bfhi(unsigned u) { return __uint_as_float(u & 0xffff0000u); }
#define RMFMA(a, b, c) __builtin_amdgcn_mfma_f32_32x32x16_bf16(a, b, c, 0, 0, 0)

__device__ __forceinline__ void ret_unit(int b, int h, unsigned char* ws, char* shm, int tid_in) {
    const unsigned short* __restrict__ RQ = (const unsigned short*)(ws + WS_RQ); const unsigned short* __restrict__ RK = RQ + BUFE; const unsigned short* __restrict__ RV = RQ + 2 * BUFE; const unsigned short* __restrict__ RG = RQ + 3 * BUFE;
    unsigned short* MIXED = (unsigned short*)(ws + WS_MIXED); float* xch = (float*)(shm + 131072 + 1024);
    int tid = tid_in; const int wid = __builtin_amdgcn_readfirstlane(tid >> 6); const int ib = wid >> 1, ep = wid & 1;
    const lds_cptr s3 = (lds_cptr)shm; const lds_cptr Qt = s3 + TQ, Kt = s3 + TK, Vt = s3 + TV, St = s3 + TS;
    RLAS char* w3 = (RLAS char*)shm;
    const float lg = log2f(1.f - exp2f(-5.f - (float)h));
    const float g128 = exp2f(128.f * lg);
    f32x16 st0 = {}, st1 = {};
    const size_t rowbase = (size_t)b * LT;
    for (int i = tid; i < 2048; i += 512) *(RLAS u32x4*)(w3 + TS + 16 * i) = (u32x4){0u, 0u, 0u, 0u};
    for (int c = 1; c <= 33; ++c) {
        asm volatile("" : "+v"(tid));
        const int lane = tid & 63, r32 = lane & 31, hi = lane >> 5;
        const float xi = __builtin_amdgcn_exp2f((float)(32 * ib + r32 + 1) * lg);
#pragma unroll
        for (int i = 0; i < 4; ++i) {
            const int n = tid + 512 * i, row = n >> 4, ch = n & 15; const size_t go = (rowbase + 128 * c + row) * 512 + h * 128 + 8 * ch;
            u32x4 q = *(const u32x4*)(RQ + go), k = *(const u32x4*)(RK + go), v = *(const u32x4*)(RV + go);
            if (c == 1 && row < 112) { k = (u32x4){0u, 0u, 0u, 0u}; v = k; q = k; }
            const unsigned o = off_b(row, ch);
            *(RLAS u32x4*)(w3 + TQ + o) = q; *(RLAS u32x4*)(w3 + TK + o) = k; *(RLAS u32x4*)(w3 + TV + o) = v;
        }
        __syncthreads();
        bf16x8 qf[8];
#pragma unroll
        for (int s = 0; s < 8; ++s) qf[s] = ldrow(Qt, 32 * ib + r32, 2 * s + hi);
        f32x16 o0 = {}, o1 = {};
        if (c > 1) {
#pragma unroll
            for (int s = 0; s < 8; ++s) { const bf16x8 a0 = ldrow(St, 64 * ep + r32, 2 * s + hi), a1 = ldrow(St, 64 * ep + 32 + r32, 2 * s + hi); o0 = RMFMA(a0, qf[s], o0); o1 = RMFMA(a1, qf[s], o1); if (s & 1) __builtin_amdgcn_sched_barrier(0); }
        }
        for (int jb = 0; jb <= ib; ++jb) {
            f32x16 S = {};
#pragma unroll
            for (int s = 0; s < 8; ++s) { const bf16x8 kf = ldrow(Kt, 32 * jb + r32, 2 * s + hi); S = RMFMA(kf, qf[s], S); if ((s & 3) == 3) __builtin_amdgcn_sched_barrier(0); }
#pragma unroll
            for (int r = 0; r < 16; ++r) { float pv = S[r] * __builtin_amdgcn_exp2f(-(float)(32 * jb + crow(r, hi) + 1) * lg); if (jb == ib && crow(r, hi) > r32) pv = 0.f; S[r] = pv; }
            const u32x4 w0 = {cvtpk(S[0], S[1]), cvtpk(S[2], S[3]), cvtpk(S[4], S[5]), cvtpk(S[6], S[7])}, w1 = {cvtpk(S[8], S[9]), cvtpk(S[10], S[11]), cvtpk(S[12], S[13]), cvtpk(S[14], S[15])};
            const bf16x8 p0 = __builtin_bit_cast(bf16x8, w0), p1 = __builtin_bit_cast(bf16x8, w1);
            __builtin_amdgcn_sched_barrier(0);
            { const bf16x8 a0 = trfrag_acc(Vt, lane, 2 * ep, 32 * jb), a1 = trfrag_acc(Vt, lane, 2 * ep, 32 * jb + 16); o0 = RMFMA(a0, p0, o0); o0 = RMFMA(a1, p1, o0); }
            { const bf16x8 a0 = trfrag_acc(Vt, lane, 2 * ep + 1, 32 * jb), a1 = trfrag_acc(Vt, lane, 2 * ep + 1, 32 * jb + 16); o1 = RMFMA(a0, p0, o1); o1 = RMFMA(a1, p1, o1); }
            __builtin_amdgcn_sched_barrier(0);
        }
        float s1 = 0.f, s2 = 0.f;
#pragma unroll
        for (int r = 0; r < 16; ++r) { o0[r] *= xi; o1[r] *= xi; s1 += o0[r] + o1[r]; s2 += o0[r] * o0[r] + o1[r] * o1[r]; }
        s1 += __shfl_xor(s1, 32); s2 += __shfl_xor(s2, 32);
        if (hi == 0) { xch[(wid * 32 + r32) * 2] = s1; xch[(wid * 32 + r32) * 2 + 1] = s2; }
#pragma unroll
        for (int r = 0; r < 16; ++r) { st0[r] *= g128; st1[r] *= g128; }
#pragma unroll
        for (int ks = 0; ks < 8; ++ks) {
            const bf16x8 kr = trfrag_nat(Kt, lane, ib, 16 * ks);
            const float zx = (float)(127 - 16 * ks - 8 * hi) * lg;
#define ZF(j) __builtin_amdgcn_exp2f(zx - (float)(j) * lg)
            const u32x4 ku = __builtin_bit_cast(u32x4, kr);
            const u32x4 kz = {cvtpk(bflo(ku[0]) * ZF(0), bfhi(ku[0]) * ZF(1)), cvtpk(bflo(ku[1]) * ZF(2), bfhi(ku[1]) * ZF(3)),
                              cvtpk(bflo(ku[2]) * ZF(4), bfhi(ku[2]) * ZF(5)), cvtpk(bflo(ku[3]) * ZF(6), bfhi(ku[3]) * ZF(7))};
#undef ZF
            const bf16x8 ka = __builtin_bit_cast(bf16x8, kz);
            const bf16x8 v0 = trfrag_nat(Vt, lane, 2 * ep, 16 * ks), v1 = trfrag_nat(Vt, lane, 2 * ep + 1, 16 * ks);
            st0 = RMFMA(ka, v0, st0); st1 = RMFMA(ka, v1, st1);
            __builtin_amdgcn_sched_barrier(0);
        }
        __syncthreads();
        { const float* xp = xch + ((wid ^ 1) * 32 + r32) * 2; s1 += xp[0]; s2 += xp[1]; }
        const float mean = s1 * (1.f / 128.f), var = fmaxf(s2 * (1.f / 128.f) - mean * mean, 0.f), rstd = 1.f / sqrtf(var + LN_EPS);
        if (c >= 2) {
            const size_t grow = (rowbase + 128 * c + 32 * ib + r32) * 512 + h * 128, orow = ((size_t)b * SEQ + 128 * (c - 2) + 32 * ib + r32) * DM + h * 128;
#pragma unroll
            for (int g = 0; g < 4; ++g) {
                { const int e0 = 64 * ep + 8 * g + 4 * hi; const u32x2 gg = *(const u32x2*)(RG + grow + e0);
                  u32x2 w; w[0] = cvtpk((o0[4 * g] - mean) * rstd * bflo(gg[0]), (o0[4 * g + 1] - mean) * rstd * bfhi(gg[0])); w[1] = cvtpk((o0[4 * g + 2] - mean) * rstd * bflo(gg[1]), (o0[4 * g + 3] - mean) * rstd * bfhi(gg[1]));
                  *(u32x2*)(MIXED + orow + e0) = w; }
                { const int e0 = 64 * ep + 32 + 8 * g + 4 * hi; const u32x2 gg = *(const u32x2*)(RG + grow + e0);
                  u32x2 w; w[0] = cvtpk((o1[4 * g] - mean) * rstd * bflo(gg[0]), (o1[4 * g + 1] - mean) * rstd * bfhi(gg[0])); w[1] = cvtpk((o1[4 * g + 2] - mean) * rstd * bflo(gg[1]), (o1[4 * g + 3] - mean) * rstd * bfhi(gg[1]));
                  *(u32x2*)(MIXED + orow + e0) = w; }
            }
        }
#pragma unroll
        for (int g = 0; g < 4; ++g) {
            *(RLAS u32x2*)(w3 + TS + off_b(64 * ep + r32, 4 * ib + g) + 8 * hi) = (u32x2){cvtpk(st0[4 * g], st0[4 * g + 1]), cvtpk(st0[4 * g + 2], st0[4 * g + 3])};
            *(RLAS u32x2*)(w3 + TS + off_b(64 * ep + 32 + r32, 4 * ib + g) + 8 * hi) = (u32x2){cvtpk(st1[4 * g], st1[4 * g + 1]), cvtpk(st1[4 * g + 2], st1[4 * g + 3])};
        }
    }
    __syncthreads();
}

__device__ __forceinline__ void ret_kv_unit(int bh, int c, unsigned char* ws, float* KV, char* shm, int tid_in) {
    const unsigned short* __restrict__ RK = (const unsigned short*)(ws + WS_RQ) + BUFE; const unsigned short* __restrict__ RV = RK + BUFE;
    int tid = tid_in; asm volatile("" : "+v"(tid));
    const int lane = tid & 63, r32 = lane & 31, hi = lane >> 5; const int wid = __builtin_amdgcn_readfirstlane(tid >> 6); const int ib = wid >> 1, ep = wid & 1;
    const int b = bh >> 2, h = bh & 3;
    const lds_cptr s3 = (lds_cptr)shm; const lds_cptr Kt = s3 + TK, Vt = s3 + TV;
    RLAS char* w3 = (RLAS char*)shm;
    const float lg = log2f(1.f - exp2f(-5.f - (float)h));
    const size_t rowbase = (size_t)b * LT;
#pragma unroll
    for (int i = 0; i < 4; ++i) {
        const int n = tid + 512 * i, row = n >> 4, ch = n & 15; const size_t go = (rowbase + 128 * c + row) * 512 + h * 128 + 8 * ch;
        u32x4 k = *(const u32x4*)(RK + go), v = *(const u32x4*)(RV + go);
        if (c == 1 && row < 112) { k = (u32x4){0u, 0u, 0u, 0u}; v = k; }
        const unsigned o = off_b(row, ch);
        *(RLAS u32x4*)(w3 + TK + o) = k; *(RLAS u32x4*)(w3 + TV + o) = v;
    }
    __syncthreads();
    f32x16 st0 = {}, st1 = {};
#pragma unroll
    for (int ks = 0; ks < 8; ++ks) {
        const bf16x8 kr = trfrag_nat(Kt, lane, ib, 16 * ks);
        const float zx = (float)(127 - 16 * ks - 8 * hi) * lg;
#define ZF(j) __builtin_amdgcn_exp2f(zx - (float)(j) * lg)
        const u32x4 ku = __builtin_bit_cast(u32x4, kr);
        const u32x4 kz = {cvtpk(bflo(ku[0]) * ZF(0), bfhi(ku[0]) * ZF(1)), cvtpk(bflo(ku[1]) * ZF(2), bfhi(ku[1]) * ZF(3)),
                          cvtpk(bflo(ku[2]) * ZF(4), bfhi(ku[2]) * ZF(5)), cvtpk(bflo(ku[3]) * ZF(6), bfhi(ku[3]) * ZF(7))};
#undef ZF
        const bf16x8 ka = __builtin_bit_cast(bf16x8, kz);
        const bf16x8 v0 = trfrag_nat(Vt, lane, 2 * ep, 16 * ks), v1 = trfrag_nat(Vt, lane, 2 * ep + 1, 16 * ks);
        st0 = RMFMA(ka, v0, st0); st1 = RMFMA(ka, v1, st1);
        __builtin_amdgcn_sched_barrier(0);
    }
    float* dst = KV + ((size_t)(bh * 33 + c) << 14);
    typedef float f32x4s __attribute__((ext_vector_type(4)));
#pragma unroll
    for (int g = 0; g < 4; ++g) {
        *(f32x4s*)(dst + (64 * ep + r32) * 128 + 32 * ib + 8 * g + 4 * hi) = (f32x4s){st0[4 * g], st0[4 * g + 1], st0[4 * g + 2], st0[4 * g + 3]};
        *(f32x4s*)(dst + (64 * ep + 32 + r32) * 128 + 32 * ib + 8 * g + 4 * hi) = (f32x4s){st1[4 * g], st1[4 * g + 1], st1[4 * g + 2], st1[4 * g + 3]};
    }
    __syncthreads();
}
__device__ __forceinline__ void ret_scan(const float* KV, unsigned short* PREV, int gtid, int nthreads) {
    typedef float f32x4s __attribute__((ext_vector_type(4)));
    for (int grp = gtid; grp < 32 * 4096; grp += nthreads) {
        const int bh = grp >> 12, idx4 = (grp & 4095) * 4, h = bh & 3;
        const float g128 = exp2f(128.f * log2f(1.f - exp2f(-5.f - (float)h)));
        f32x4s sacc = {0.f, 0.f, 0.f, 0.f};
#pragma unroll 16
        for (int c = 1; c <= 32; ++c) {
            const f32x4s kv = *(const f32x4s*)(KV + ((size_t)(bh * 33 + c) << 14) + idx4);
            sacc = sacc * g128 + kv;
            *(u32x2*)(PREV + ((size_t)(bh * 33 + c + 1) << 14) + idx4) = (u32x2){cvtpk(sacc[0], sacc[1]), cvtpk(sacc[2], sacc[3])};
        }
    }
}
__device__ __forceinline__ void ret_out_unit(int bh, int c, unsigned char* ws, const unsigned short* PREV, char* shm, int tid_in) {
    const unsigned short* __restrict__ RQ = (const unsigned short*)(ws + WS_RQ); const unsigned short* __restrict__ RK = RQ + BUFE; const unsigned short* __restrict__ RV = RQ + 2 * BUFE; const unsigned short* __restrict__ RG = RQ + 3 * BUFE;
    unsigned short* MIXED = (unsigned short*)(ws + WS_MIXED); float* xch = (float*)(shm + 131072 + 1024);
    int tid = tid_in; asm volatile("" : "+v"(tid));
    const int lane = tid & 63, r32 = lane & 31, hi = lane >> 5; const int wid = __builtin_amdgcn_readfirstlane(tid >> 6); const int ib = wid >> 1, ep = wid & 1;
    const int b = bh >> 2, h = bh & 3;
    const lds_cptr s3 = (lds_cptr)shm; const lds_cptr Qt = s3 + TQ, Kt = s3 + TK, Vt = s3 + TV, St = s3 + TS;
    RLAS char* w3 = (RLAS char*)shm;
    const float lg = log2f(1.f - exp2f(-5.f - (float)h));
    const size_t rowbase = (size_t)b * LT;
    const unsigned short* pv_ = PREV + ((size_t)(bh * 33 + c) << 14);
#pragma unroll
    for (int i = 0; i < 4; ++i) {
        const int n = tid + 512 * i, row = n >> 4, ch = n & 15; const size_t go = (rowbase + 128 * c + row) * 512 + h * 128 + 8 * ch;
        const u32x4 q = *(const u32x4*)(RQ + go), k = *(const u32x4*)(RK + go), v = *(const u32x4*)(RV + go), p = *(const u32x4*)(pv_ + row * 128 + 8 * ch);
        const unsigned o = off_b(row, ch);
        *(RLAS u32x4*)(w3 + TQ + o) = q; *(RLAS u32x4*)(w3 + TK + o) = k; *(RLAS u32x4*)(w3 + TV + o) = v; *(RLAS u32x4*)(w3 + TS + o) = p;
    }
    __syncthreads();
    const float xi = __builtin_amdgcn_exp2f((float)(32 * ib + r32 + 1) * lg);
    bf16x8 qf[8];
#pragma unroll
    for (int s = 0; s < 8; ++s) qf[s] = ldrow(Qt, 32 * ib + r32, 2 * s + hi);
    f32x16 o0 = {}, o1 = {};
#pragma unroll
    for (int s = 0; s < 8; ++s) { const bf16x8 a0 = ldrow(St, 64 * ep + r32, 2 * s + hi), a1 = ldrow(St, 64 * ep + 32 + r32, 2 * s + hi); o0 = RMFMA(a0, qf[s], o0); o1 = RMFMA(a1, qf[s], o1); if (s & 1) __builtin_amdgcn_sched_barrier(0); }
    for (int jb = 0; jb <= ib; ++jb) {
        f32x16 S = {};
#pragma unroll
        for (int s = 0; s < 8; ++s) { const bf16x8 kf = ldrow(Kt, 32 * jb + r32, 2 * s + hi); S = RMFMA(kf, qf[s], S); if ((s & 3) == 3) __builtin_amdgcn_sched_barrier(0); }
#pragma unroll
        for (int r = 0; r < 16; ++r) { float pv = S[r] * __builtin_amdgcn_exp2f(-(float)(32 * jb + crow(r, hi) + 1) * lg); if (jb == ib && crow(r, hi) > r32) pv = 0.f; S[r] = pv; }
        const u32x4 w0 = {cvtpk(S[0], S[1]), cvtpk(S[2], S[3]), cvtpk(S[4], S[5]), cvtpk(S[6], S[7])}, w1 = {cvtpk(S[8], S[9]), cvtpk(S[10], S[11]), cvtpk(S[12], S[13]), cvtpk(S[14], S[15])};
        const bf16x8 p0 = __builtin_bit_cast(bf16x8, w0), p1 = __builtin_bit_cast(bf16x8, w1);
        __builtin_amdgcn_sched_barrier(0);
        { const bf16x8 a0 = trfrag_acc(Vt, lane, 2 * ep, 32 * jb), a1 = trfrag_acc(Vt, lane, 2 * ep, 32 * jb + 16); o0 = RMFMA(a0, p0, o0); o0 = RMFMA(a1, p1, o0); }
        { const bf16x8 a0 = trfrag_acc(Vt, lane, 2 * ep + 1, 32 * jb), a1 = trfrag_acc(Vt, lane, 2 * ep + 1, 32 * jb + 16); o1 = RMFMA(a0, p0, o1); o1 = RMFMA(a1, p1, o1); }
        __builtin_amdgcn_sched_barrier(0);
    }
    float s1 = 0.f, s2 = 0.f;
#pragma unroll
    for (int r = 0; r < 16; ++r) { o0[r] *= xi; o1[r] *= xi; s1 += o0[r] + o1[r]; s2 += o0[r] * o0[r] + o1[r] * o1[r]; }
    s1 += __shfl_xor(s1, 32); s2 += __shfl_xor(s2, 32);
    if (hi == 0) { xch[(wid * 32 + r32) * 2] = s1; xch[(wid * 32 + r32) * 2 + 1] = s2; }
    __syncthreads();
    { const float* xp = xch + ((wid ^ 1) * 32 + r32) * 2; s1 += xp[0]; s2 += xp[1]; }
    const float mean = s1 * (1.f / 128.f), var = fmaxf(s2 * (1.f / 128.f) - mean * mean, 0.f), rstd = 1.f / sqrtf(var + LN_EPS);
    const size_t grow = (rowbase + 128 * c + 32 * ib + r32) * 512 + h * 128, orow = ((size_t)b * SEQ + 128 * (c - 2) + 32 * ib + r32) * DM + h * 128;
#pragma unroll
    for (int g = 0; g < 4; ++g) {
        { const int e0 = 64 * ep + 8 * g + 4 * hi; const u32x2 gg = *(const u32x2*)(RG + grow + e0);
          u32x2 w; w[0] = cvtpk((o0[4 * g] - mean) * rstd * bflo(gg[0]), (o0[4 * g + 1] - mean) * rstd * bfhi(gg[0])); w[1] = cvtpk((o0[4 * g + 2] - mean) * rstd * bflo(gg[1]), (o0[4 * g + 3] - mean) * rstd * bfhi(gg[1]));
          *(u32x2*)(MIXED + orow + e0) = w; }
        { const int e0 = 64 * ep + 32 + 8 * g + 4 * hi; const u32x2 gg = *(const u32x2*)(RG + grow + e0);
          u32x2 w; w[0] = cvtpk((o1[4 * g] - mean) * rstd * bflo(gg[0]), (o1[4 * g + 1] - mean) * rstd * bfhi(gg[0])); w[1] = cvtpk((o1[4 * g + 2] - mean) * rstd * bflo(gg[1]), (o1[4 * g + 3] - mean) * rstd * bfhi(gg[1]));
          *(u32x2*)(MIXED + orow + e0) = w; }
    }
    __syncthreads();
}
#undef RLAS
#undef RMFMA
}

constexpr int NWAVES = 8;
constexpr int RING_OFF = 0, RING_BYTES = 131072;
constexpr int LDSCTL_OFF = RING_BYTES, MISC_OFF = LDSCTL_OFF + 320;
constexpr int LDS_BYTES = 163840;
constexpr int CW_BAR = 4096;
#define GAS __attribute__((address_space(1)))
#define LAS __attribute__((address_space(3)))
typedef unsigned short bf16;
typedef unsigned v4u __attribute__((ext_vector_type(4)));
typedef float f32x4 __attribute__((ext_vector_type(4)));
typedef short bf16x8 __attribute__((ext_vector_type(8)));
typedef GAS unsigned gu32;
typedef GAS unsigned long long gu64;
#define RLX_AGENT __ATOMIC_RELAXED, __HIP_MEMORY_SCOPE_AGENT
#define LDS_WAIT() asm volatile("s_waitcnt lgkmcnt(0)" ::: "memory")
#define VM_WAIT() asm volatile("s_waitcnt vmcnt(0)" ::: "memory")
__device__ __forceinline__ unsigned long long rt() { return __builtin_amdgcn_s_memrealtime(); }
__device__ __forceinline__ unsigned pk2(float lo, float hi) { return f2bf(lo) | (f2bf(hi) << 16); }

#define XB_TMO      128
#define XB_XCNT(j)  (256  + 64 * (j))
#define XB_XSUB(j)  (1280 + 64 * (j))
#define XB_XGEN(j)  (2304 + 64 * (j))
#define XB_TOP      3328
#define XB_TOPGEN   3392
#define XCD_BAR_WORDS 3456
#define XB_SPIN_CAP (1u << 18)

__device__ __forceinline__ unsigned xb_ld(unsigned* p)              { return __hip_atomic_load(p, __ATOMIC_RELAXED, __HIP_MEMORY_SCOPE_AGENT); }
__device__ __forceinline__ unsigned xb_add(unsigned* p, unsigned v) { return __hip_atomic_fetch_add(p, v, __ATOMIC_RELAXED, __HIP_MEMORY_SCOPE_AGENT); }
__device__ __forceinline__ unsigned xb_xcc_id() { return (unsigned)__builtin_amdgcn_s_getreg((3 << 11) | 20) & 0xFu; }
#define XB_SPIN(cond, bar) do { unsigned _sp = 0; while (cond) { __builtin_amdgcn_s_sleep(1); \
    if ((++_sp & 255u) == 0u) { if (xb_ld(&(bar)[XB_TMO])) break; if (_sp > XB_SPIN_CAP) { atomicAdd(&(bar)[XB_TMO], 1u); break; } } } } while (0)

struct XcdBarrier {
    unsigned* bar; unsigned x;
    volatile LAS unsigned* st;
};

__device__ __forceinline__ XcdBarrier xcd_barrier_post(unsigned* bar, volatile LAS unsigned* st) {
    XcdBarrier b; b.bar = bar; b.x = xb_xcc_id(); b.st = st;
    if (threadIdx.x == 0) (void)xb_add(&bar[XB_XCNT(b.x)], 1u);
    return b;
}
__device__ __forceinline__ void xcd_barrier_complete(unsigned* bar, unsigned x, unsigned& nloc, unsigned& nx) {
    const unsigned G = gridDim.x * gridDim.y * gridDim.z;
    unsigned sum, cnt, mine, sp = 0u;
    for (;;) {
        sum = 0u; cnt = 0u; mine = 0u;
#pragma unroll
        for (unsigned j = 0; j < 16; ++j) { const unsigned c = xb_ld(&bar[XB_XCNT(j)]); sum += c; cnt += (c > 0u) ? 1u : 0u; mine = (j == x) ? c : mine; }
        if (sum == G) break;
        __builtin_amdgcn_s_sleep(1);
        if ((++sp & 255u) == 0u) { if (xb_ld(&bar[XB_TMO])) break; if (sp > XB_SPIN_CAP) { atomicAdd(&bar[XB_TMO], 1u); break; } }
    }
    nloc = mine > 0u ? mine : 1u; nx = cnt > 0u ? cnt : 1u;
}

__device__ __forceinline__ void xcd_barrier(const XcdBarrier& b) {
    asm volatile("s_waitcnt vmcnt(0)" ::: "memory");
    __syncthreads();
    if (threadIdx.x == 0) {
        unsigned* bar = b.bar;
        __builtin_amdgcn_s_waitcnt(0);
        unsigned nloc = b.st[0], nx = b.st[1];
        if (nloc == 0u) { xcd_barrier_complete(bar, b.x, nloc, nx); b.st[0] = nloc; b.st[1] = nx; }
        const unsigned old = xb_add(&bar[XB_XSUB(b.x)], 1u);
        const unsigned gen = old / nloc;
        if (old + 1u == (gen + 1u) * nloc) {
            __builtin_amdgcn_fence(__ATOMIC_RELEASE, "agent");
            asm volatile("s_waitcnt vmcnt(0)" ::: "memory");
            const unsigned og = xb_add(&bar[XB_TOP], 1u);
            const unsigned tg = og / nx;
            if (og + 1u == (tg + 1u) * nx) xb_add(&bar[XB_TOPGEN], 1u);
            else XB_SPIN(xb_ld(&bar[XB_TOPGEN]) == tg, bar);
            __builtin_amdgcn_fence(__ATOMIC_ACQUIRE, "agent");
            xb_add(&bar[XB_XGEN(b.x)], 1u);
            asm volatile("s_waitcnt vmcnt(0)" ::: "memory");
        } else {
            XB_SPIN(xb_ld(&bar[XB_XGEN(b.x)]) == gen, bar);
            __builtin_amdgcn_fence(__ATOMIC_ACQUIRE, "agent");
            asm volatile("s_waitcnt vmcnt(0)" ::: "memory");
        }
    }
    __syncthreads();
}

template <class SrcF>
__device__ __forceinline__ void transpose_item(const SrcF& src, int K, bf16* WT, LAS float* scr, int kb, int nb, int lane) {
    const int k0 = 64 * kb, n0 = 32 * nb;
#pragma unroll 8
    for (int i = 0; i < 32; ++i) { const int kk = 2 * i + (lane >> 5); scr[kk * 33 + (lane & 31)] = src(k0 + kk, n0 + (lane & 31)); }
    LDS_WAIT(); asm volatile("" ::: "memory");
    const int c = lane & 7;
#pragma unroll
    for (int j = 0; j < 4; ++j) { const int n = (lane >> 3) + 8 * j; const LAS float* s = scr + (8 * c) * 33 + n;
        v4u o; o.x = pk2(s[0 * 33], s[1 * 33]); o.y = pk2(s[2 * 33], s[3 * 33]); o.z = pk2(s[4 * 33], s[5 * 33]); o.w = pk2(s[6 * 33], s[7 * 33]);
        *(GAS v4u*)(WT + (size_t)(n0 + n) * K + k0 + 8 * c) = o; }
    LDS_WAIT(); asm volatile("" ::: "memory");
}
template <class SrcF>
__device__ __forceinline__ void transpose_item4(const SrcF& src, int K, bf16* WT, LAS float* scr, int kb, int nb, int lane) {
    const int k0 = 64 * kb, n0 = 32 * nb;
    f32x4 v[8];
#pragma unroll
    for (int i = 0; i < 8; ++i) v[i] = src(k0 + 8 * i + (lane >> 3), n0 + 4 * (lane & 7));
#pragma unroll
    for (int i = 0; i < 8; ++i) *(LAS f32x4*)(scr + (8 * i + (lane >> 3)) * 36 + 4 * (lane & 7)) = v[i];
    LDS_WAIT(); asm volatile("" ::: "memory");
    const int c = lane & 7;
#pragma unroll
    for (int j = 0; j < 4; ++j) { const int n = (lane >> 3) + 8 * j; const LAS float* sp = scr + (8 * c) * 36 + n;
        v4u o; o.x = pk2(sp[0 * 36], sp[1 * 36]); o.y = pk2(sp[2 * 36], sp[3 * 36]); o.z = pk2(sp[4 * 36], sp[5 * 36]); o.w = pk2(sp[6 * 36], sp[7 * 36]);
        *(GAS v4u*)(WT + (size_t)(n0 + n) * K + k0 + 8 * c) = o; }
    LDS_WAIT(); asm volatile("" ::: "memory");
}
struct Src4Plain { const float* w; int ld; __device__ __forceinline__ f32x4 operator()(int k, int n) const { return *(const f32x4*)(w + (size_t)k * ld + n); } };
struct Src4GU { const float* wg; const float* wu; __device__ __forceinline__ f32x4 operator()(int k, int n) const { const long long d = (long long)(wu - wg); return *(const f32x4*)(wg + (long long)((n >> 2) & 1) * d + (long long)k * EFF + 4 * (n >> 3)); } };
struct SrcWin { const float* w; __device__ __forceinline__ float operator()(int k, int n) const { int col = n; if (n < 1024) { const int cp = n & 127; col = (n & ~127) + (cp & 1) * 64 + (cp >> 1); } return w[(size_t)k * INC + col]; } };
struct SrcPlain { const float* w; int ld; __device__ __forceinline__ float operator()(int k, int n) const { return w[(size_t)k * ld + n]; } };
struct SrcGU { const float* wg; const float* wu; __device__ __forceinline__ float operator()(int k, int n) const { const long long d = (long long)(wu - wg); return wg[(long long)(n & 1) * d + (long long)k * EFF + (n >> 1)]; } };

struct Args {
    const float* in[19]; float* out; unsigned char* ws; int ph_lo, ph_hi;
};

__device__ __forceinline__ void ln0_row(float4 (&v)[4], const float* g, const float* bta, const LAS float* wf, const float* b_forget, bf16* xn_row, float* logf_row, int lane) {
    float s = 0.f;
#pragma unroll
    for (int j = 0; j < 4; ++j) s += (v[j].x + v[j].y) + (v[j].z + v[j].w);
    const float mean = wave_sum(s) * (1.f / DM);
    float s2 = 0.f;
#pragma unroll
    for (int j = 0; j < 4; ++j) { v[j].x -= mean; v[j].y -= mean; v[j].z -= mean; v[j].w -= mean; s2 += (v[j].x * v[j].x + v[j].y * v[j].y) + (v[j].z * v[j].z + v[j].w * v[j].w); }
    const float rstd = 1.f / sqrtf(wave_sum(s2) * (1.f / DM) + LN_EPS);
    float f[8];
#pragma unroll
    for (int h = 0; h < 8; ++h) f[h] = 0.f;
#pragma unroll
    for (int j = 0; j < 4; ++j) {
        const float4 gg = ((const float4*)g)[lane + 64 * j], bb = ((const float4*)bta)[lane + 64 * j];
        const float y0 = v[j].x * rstd * gg.x + bb.x, y1 = v[j].y * rstd * gg.y + bb.y, y2 = v[j].z * rstd * gg.z + bb.z, y3 = v[j].w * rstd * gg.w + bb.w;
        uint2 o; o.x = pk2(y0, y1); o.y = pk2(y2, y3);
        ((uint2*)xn_row)[lane + 64 * j] = o;
        const LAS float* wp = wf + 32 * (lane + 64 * j);
#pragma unroll
        for (int h = 0; h < 8; ++h) f[h] += y0 * wp[h] + y1 * wp[8 + h] + y2 * wp[16 + h] + y3 * wp[24 + h];
    }
    float z = 0.f;
#pragma unroll
    for (int h = 0; h < 8; ++h) { const float t = wave_sum(f[h]); if (lane == h) z = t; }
    if (lane < 8) { z += b_forget[lane]; logf_row[lane] = fminf(z, 0.f) - log1pf(expf(-fabsf(z))); }
}

__device__ __forceinline__ void metaproj_item(const Args& a, LAS unsigned char* lds, int item, int tid, int lane, int wave) {
    const int g = item >> 2, qt = item & 3;
    LAS float* xm = (LAS float*)lds;
    LAS float* T = (LAS float*)(lds + 65536);
    const float* meta = a.in[1]; const float* g0 = a.in[2]; const float* b0 = a.in[3]; const float* w_in = a.in[4];
#pragma unroll
    for (int rr = 0; rr < 2; ++rr) {
        const int m = wave * 2 + rr; const float* src = meta + (size_t)m * DM;
        float4 v[4]; float s = 0.f;
#pragma unroll
        for (int j = 0; j < 4; ++j) { v[j] = ((const float4*)src)[lane + 64 * j]; s += (v[j].x + v[j].y) + (v[j].z + v[j].w); }
        const float mean = wave_sum(s) * (1.f / DM);
        float s2 = 0.f;
#pragma unroll
        for (int j = 0; j < 4; ++j) { v[j].x -= mean; v[j].y -= mean; v[j].z -= mean; v[j].w -= mean; s2 += (v[j].x * v[j].x + v[j].y * v[j].y) + (v[j].z * v[j].z + v[j].w * v[j].w); }
        const float rstd = 1.f / sqrtf(wave_sum(s2) * (1.f / DM) + LN_EPS);
#pragma unroll
        for (int j = 0; j < 4; ++j) {
            const float4 gg = ((const float4*)g0)[lane + 64 * j], bb = ((const float4*)b0)[lane + 64 * j]; const int k0 = 4 * (lane + 64 * j);
            xm[(k0 + 0) * 16 + m] = __uint_as_float(f2bf(v[j].x * rstd * gg.x + bb.x) << 16); xm[(k0 + 1) * 16 + m] = __uint_as_float(f2bf(v[j].y * rstd * gg.y + bb.y) << 16);
            xm[(k0 + 2) * 16 + m] = __uint_as_float(f2bf(v[j].z * rstd * gg.z + bb.z) << 16); xm[(k0 + 3) * 16 + m] = __uint_as_float(f2bf(v[j].w * rstd * gg.w + bb.w) << 16);
        }
    }
    __syncthreads();
    const int cb = g * 512 + qt * 128;
    float acc[16][2];
#pragma unroll
    for (int m = 0; m < 16; ++m) { acc[m][0] = 0.f; acc[m][1] = 0.f; }
    const float* wc = w_in + cb + 2 * lane;
#pragma unroll 16
    for (int kk = 0; kk < 128; ++kk) {
        const int k = wave * 128 + kk;
        const float2 w = *(const float2*)(wc + (size_t)k * INC);
        const f32x4 x0 = *(const LAS f32x4*)(xm + k * 16), x1 = *(const LAS f32x4*)(xm + k * 16 + 4), x2 = *(const LAS f32x4*)(xm + k * 16 + 8), x3 = *(const LAS f32x4*)(xm + k * 16 + 12);
#pragma unroll
        for (int q = 0; q < 4; ++q) { acc[q][0] += w.x * x0[q]; acc[q][1] += w.y * x0[q]; acc[4 + q][0] += w.x * x1[q]; acc[4 + q][1] += w.y * x1[q];
                                      acc[8 + q][0] += w.x * x2[q]; acc[8 + q][1] += w.y * x2[q]; acc[12 + q][0] += w.x * x3[q]; acc[12 + q][1] += w.y * x3[q]; }
    }
    for (int r = 0; r < NWAVES; ++r) {
        if (wave == r) {
#pragma unroll
            for (int m = 0; m < 16; ++m) { LAS float* tp = T + m * 128 + 2 * lane; if (r == 0) { tp[0] = acc[m][0]; tp[1] = acc[m][1]; } else { tp[0] += acc[m][0]; tp[1] += acc[m][1]; } }
        }
        __syncthreads();
    }
    bf16* base = (bf16*)(a.ws + WS_RQ) + (size_t)g * BUFE;
    const int m = tid >> 5, t5 = tid & 31;
    if (g < 2) {
        const float sc = (g == 1) ? RK_SCALE : 1.f; unsigned o[2];
#pragma unroll
        for (int jj = 0; jj < 2; ++jj) { const int j = 2 * t5 + jj;
            const double rr = exp2(-(double)j * (13.287712379549449 / 64.0)) * 0.15915494309189535;
            double rv = (double)m * rr; rv -= floor(rv); const float fr = (float)rv, sn = __builtin_amdgcn_sinf(fr), cs = __builtin_amdgcn_cosf(fr);
            const float x1 = T[m * 128 + j], x2 = T[m * 128 + 64 + j];
            o[jj] = pk2((x1 * cs - x2 * sn) * sc, (x2 * cs + x1 * sn) * sc); }
        for (int b = 0; b < NB; ++b) *(uint2*)(base + ((size_t)b * LT + RMETA0 + m) * 512 + qt * 128 + 4 * t5) = make_uint2(o[0], o[1]);
    } else {
        const int pos0 = (g < 4) ? RMETA0 : FMETA0; float v[4];
#pragma unroll
        for (int q = 0; q < 4; ++q) { v[q] = T[m * 128 + 4 * t5 + q]; if (g == 3) v[q] = v[q] / (1.f + __expf(-v[q])); else if (g == 4) v[q] *= C2; }
        const uint2 o = make_uint2(pk2(v[0], v[1]), pk2(v[2], v[3]));
        for (int b = 0; b < NB; ++b) *(uint2*)(base + ((size_t)b * LT + pos0 + m) * 512 + qt * 128 + 4 * t5) = o;
    }
    __syncthreads();
}

__device__ __forceinline__ void unpack8f(const uint4 u, float* d) {
    d[0] = __uint_as_float(u.x << 16); d[1] = __uint_as_float(u.x & 0xffff0000u); d[2] = __uint_as_float(u.y << 16); d[3] = __uint_as_float(u.y & 0xffff0000u);
    d[4] = __uint_as_float(u.z << 16); d[5] = __uint_as_float(u.z & 0xffff0000u); d[6] = __uint_as_float(u.w << 16); d[7] = __uint_as_float(u.w & 0xffff0000u);
}
__device__ __forceinline__ void qk_norms(unsigned char* ws, int gw, int NGW, int lane) {
    const bf16* FQ = (const bf16*)(ws + WS_RQ) + 4 * BUFE; const bf16* FK = FQ + BUFE;
    unsigned* qk = (unsigned*)(ws + WS_CTL) + CW_QK2;
    constexpr int RB = NMETA + SEQ, NR = NB * RB;
    const int rpw = (NR + NGW - 1) / NGW, r0 = gw * rpw, r1 = (r0 + rpw < NR) ? r0 + rpw : NR;
    int curb = -1; float mq = 0.f, mk = 0.f;
    for (int rb = r0; rb < r1; rb += 4) {
        uint4 qv[4], kv[4];
#pragma unroll
        for (int j = 0; j < 4; ++j) { const int r = (rb + j < r1) ? rb + j : r1 - 1; const int b = r / RB, t = r - b * RB, pos = t < NMETA ? FMETA0 + t : XPOS0 + t - NMETA;
            const size_t o = ((size_t)b * LT + pos) * 512 + lane * 8; qv[j] = *(const uint4*)(FQ + o); kv[j] = *(const uint4*)(FK + o); }
#pragma unroll
        for (int j = 0; j < 4; ++j) {
            const int r = (rb + j < r1) ? rb + j : r1 - 1; const int b = r / RB;
            if (b != curb) { if (curb >= 0 && (lane & 7) == 0) { atomicMax(qk + 2 * (curb * 8 + (lane >> 3)), __float_as_uint(mq)); atomicMax(qk + 2 * (curb * 8 + (lane >> 3)) + 1, __float_as_uint(mk)); } curb = b; mq = 0.f; mk = 0.f; }
            float a[8], c[8]; unpack8f(qv[j], a); unpack8f(kv[j], c);
            float sq = 0.f, sk = 0.f;
#pragma unroll
            for (int i = 0; i < 8; ++i) { sq += a[i] * a[i]; sk += c[i] * c[i]; }
            sq += __shfl_xor(sq, 1); sq += __shfl_xor(sq, 2); sq += __shfl_xor(sq, 4); sk += __shfl_xor(sk, 1); sk += __shfl_xor(sk, 2); sk += __shfl_xor(sk, 4);
            mq = fmaxf(mq, sq); mk = fmaxf(mk, sk);
        }
    }
    if (curb >= 0 && (lane & 7) == 0) { atomicMax(qk + 2 * (curb * 8 + (lane >> 3)), __float_as_uint(mq)); atomicMax(qk + 2 * (curb * 8 + (lane >> 3)) + 1, __float_as_uint(mk)); }
}
__device__ __forceinline__ void bias_scan(const float* LOGF, float* BIAS, int bh, int lane) {
    const int b = bh >> 3, h = bh & 7;
    float* out = BIAS + (size_t)bh * LT;
    for (int p = lane; p < XPOS0; p += 64) if (p < FMETA0 || p >= FMETA0 + NMETA) out[p] = -1e30f;
    float carry = 0.f;
    for (int t0 = 0; t0 < NMETA + SEQ; t0 += 64) {
        const int t = t0 + lane; float v = 0.f;
        if (t < NMETA + SEQ) { const int row = t < NMETA ? NX + t : b * SEQ + t - NMETA; v = LOGF[(size_t)row * 8 + h]; }
#pragma unroll
        for (int o = 1; o < 64; o <<= 1) { const float u = __shfl_up(v, o); if (lane >= o) v += u; }
        v += carry;
        if (t < NMETA + SEQ) { const int pos = t < NMETA ? FMETA0 + t : XPOS0 + t - NMETA; out[pos] = -v * LOG2E; }
        carry = __shfl(v, 63);
    }
}
__device__ __forceinline__ void ln_row_f32_to_bf16(const uint2 (&yv)[4], const uint2 (&hv)[4], const float* g, const float* bta, bf16* dst, int lane) {
    float4 v[4]; float s = 0.f;
#pragma unroll
    for (int j = 0; j < 4; ++j) { const uint2 y2 = yv[j]; v[j].x = __uint_as_float(y2.x << 16); v[j].y = __uint_as_float(y2.x & 0xffff0000u); v[j].z = __uint_as_float(y2.y << 16); v[j].w = __uint_as_float(y2.y & 0xffff0000u);
        const uint2 h = hv[j];
        v[j].x += ALPHA * __uint_as_float(h.x << 16); v[j].y += ALPHA * __uint_as_float(h.x & 0xffff0000u); v[j].z += ALPHA * __uint_as_float(h.y << 16); v[j].w += ALPHA * __uint_as_float(h.y & 0xffff0000u);
        s += (v[j].x + v[j].y) + (v[j].z + v[j].w); }
    const float mean = wave_sum(s) * (1.f / DM);
    float s2 = 0.f;
#pragma unroll
    for (int j = 0; j < 4; ++j) { v[j].x -= mean; v[j].y -= mean; v[j].z -= mean; v[j].w -= mean; s2 += (v[j].x * v[j].x + v[j].y * v[j].y) + (v[j].z * v[j].z + v[j].w * v[j].w); }
    const float rstd = 1.f / sqrtf(wave_sum(s2) * (1.f / DM) + LN_EPS);
#pragma unroll
    for (int j = 0; j < 4; ++j) {
        const float4 gg = ((const float4*)g)[lane + 64 * j], bb = ((const float4*)bta)[lane + 64 * j];
        uint2 o; o.x = pk2(v[j].x * rstd * gg.x + bb.x, v[j].y * rstd * gg.y + bb.y); o.y = pk2(v[j].z * rstd * gg.z + bb.z, v[j].w * rstd * gg.w + bb.w);
        ((uint2*)dst)[lane + 64 * j] = o;
    }
}
struct FinA { int a[6]; uint4 b0, b1; };
struct FinY { uint4 w[6]; float gt[6]; };
__device__ __forceinline__ void fin_loadA(FinA& A, const bf16* BASE, const int* ASG, int tok, int lane) {
#pragma unroll
    for (int r = 0; r < 6; ++r) A.a[r] = ASG[(size_t)tok * 6 + r];
    const bf16* src = BASE + (size_t)tok * DM + 16 * lane; A.b0 = ((const uint4*)src)[0]; A.b1 = ((const uint4*)src)[1];
}
__device__ __forceinline__ void fin_loadY(FinY& Yr, const FinA& A, const unsigned char* Y, const float* GATEL, const LAS int* ys, int lane) {
#pragma unroll
    for (int r = 0; r < 6; ++r) { const int e = A.a[r] >> 16, rank = A.a[r] & 0xffff; Yr.w[r] = *(const uint4*)(Y + (size_t)(ys[e] + rank) * DM + 16 * lane); Yr.gt[r] = GATEL[(size_t)e * CAP + rank]; }
}
__device__ __forceinline__ void fin_compute(const FinA& A, const FinY& Yr, const float* g, const float* bta, float* out, int tok, int lane) {
    float v[16];
    unpack8f(A.b0, v); unpack8f(A.b1, v + 8);
    typedef float f32x2v __attribute__((ext_vector_type(2)));
#pragma unroll
    for (int r = 0; r < 6; ++r) {
        const float gt = Yr.gt[r] * (1.f / 64.f); const unsigned ww[4] = {Yr.w[r].x, Yr.w[r].y, Yr.w[r].z, Yr.w[r].w};
#pragma unroll
        for (int q = 0; q < 4; ++q) { const f32x2v lo = __builtin_amdgcn_cvt_pk_f32_fp8((int)ww[q], false), hi = __builtin_amdgcn_cvt_pk_f32_fp8((int)ww[q], true);
            v[4 * q] += gt * lo[0]; v[4 * q + 1] += gt * lo[1]; v[4 * q + 2] += gt * hi[0]; v[4 * q + 3] += gt * hi[1]; }
    }
    float s = 0.f;
#pragma unroll
    for (int q = 0; q < 16; ++q) s += v[q];
    const float mean = wave_sum(s) * (1.f / DM);
    float s2 = 0.f;
#pragma unroll
    for (int q = 0; q < 16; ++q) { v[q] -= mean; s2 += v[q] * v[q]; }
    const float rstd = 1.f / sqrtf(wave_sum(s2) * (1.f / DM) + LN_EPS);
    const int c0 = 16 * lane;
#pragma unroll
    for (int j = 0; j < 4; ++j) {
        const float4 gg = *(const float4*)(g + c0 + 4 * j), bb = *(const float4*)(bta + c0 + 4 * j);
        float4 o; o.x = v[4 * j] * rstd * gg.x + bb.x; o.y = v[4 * j + 1] * rstd * gg.y + bb.y; o.z = v[4 * j + 2] * rstd * gg.z + bb.z; o.w = v[4 * j + 3] * rstd * gg.w + bb.w;
        *(float4*)(out + (size_t)tok * DM + c0 + 4 * j) = o;
    }
}
__global__ void __launch_bounds__(NWAVES * 64, 2) mega(Args args) {
    extern __shared__ __attribute__((aligned(16))) unsigned char lds_raw[];
    LAS unsigned char* lds = (LAS unsigned char*)lds_raw;
    volatile LAS unsigned* MISC = (volatile LAS unsigned*)(lds + MISC_OFF);
    const int tid = threadIdx.x, lane = tid & 63, wave = __builtin_amdgcn_readfirstlane(tid >> 6);
    const int G = gridDim.x; const int bx = blockIdx.x; const int vcu = (G % 8 == 0) ? (bx % 8) * (G / 8) + bx / 8 : bx;
    unsigned char* ws = args.ws;
    gu32* ctl = (gu32*)(ws + WS_CTL);
    for (int u = tid; u < (LDS_BYTES - LDSCTL_OFF) / 4; u += NWAVES * 64) ((LAS unsigned*)(lds + LDSCTL_OFF))[u] = 0u;
    __syncthreads();
    XcdBarrier bar = xcd_barrier_post((unsigned*)(ctl + CW_BAR), MISC + 8);
    const int lo = args.ph_lo, hi = args.ph_hi;
#ifndef PROBE_PHASE
#define PROBE_PHASE -1
#endif
#define REP(k) for (int rep_ = 0; rep_ < ((PROBE_PHASE == (k)) ? 2 : 1); ++rep_)
#define IN(k) (lo <= (k) && (k) < hi)
#define BOTH(k) (IN(k) && IN((k) + 1))
    bf16* XN = (bf16*)(ws + WS_XN); float* LOGF = (float*)(ws + WS_LOGF); float* TAB = (float*)(ws + WS_TAB);
    bf16* WIN_T = (bf16*)(ws + WS_WIN_T); bf16* WOUT_T = (bf16*)(ws + WS_WOUT_T); bf16* WGU_T = (bf16*)(ws + WS_WGU_T); bf16* WSD_T = (bf16*)(ws + WS_WSD_T); bf16* WR_T = (bf16*)(ws + WS_WR_T); bf16* WD_T = (bf16*)(ws + WS_WD_T);

    if (IN(0)) REP(0) {
        for (int it = vcu; it < 28; it += G) metaproj_item(args, lds, it, tid, lane, wave);
        {
            const int gw = vcu * NWAVES + wave, NGW = G * NWAVES;
            LAS float* scr = (LAS float*)(lds + wave * 9216);
            LAS float* wf = (LAS float*)(lds + 98304);
            const float* w_in = args.in[4];
            for (int i = tid; i < 1024 * 8; i += NWAVES * 64) { const int k = i >> 3, h = i & 7; wf[i] = w_in[(size_t)k * INC + 3584 + h]; }
            __syncthreads();
            if (gw == 0) { const double rr = exp2(-(double)lane * (13.287712379549449 / 64.0)) * 0.15915494309189535; const float h = (float)rr; TAB[2 * lane] = h; TAB[2 * lane + 1] = (float)(rr - (double)h); }
            {
                float4 cur[4], nxt[4];
#define LD_ROW(dst, row) do { const float* src_ = (row) < NX ? args.in[0] + (size_t)(row) * DM : args.in[1] + (size_t)((row) - NX) * DM; _Pragma("unroll") for (int j = 0; j < 4; ++j) dst[j] = ((const float4*)src_)[lane + 64 * j]; } while (0)
                if (gw < NX + NMETA) LD_ROW(cur, gw);
                for (int row = gw; row < NX + NMETA; row += NGW) {
                    const int nr = row + NGW;
                    if (nr < NX + NMETA) LD_ROW(nxt, nr);
                    ln0_row(cur, args.in[2], args.in[3], wf, args.in[5], XN + (size_t)row * DM, LOGF + (size_t)row * 8, lane);
#pragma unroll
                    for (int j = 0; j < 4; ++j) cur[j] = nxt[j];
                }
#undef LD_ROW
            }
            constexpr int I0 = 16 * 112, I1 = 16 * 32, I2 = 16 * 2, I3 = 16 * 16, I4 = 4 * 32, ITOT = I0 + I1 + I2 + I3 + I4;
            for (int it = gw; it < ITOT; it += NGW) {
                int r = it;
                if (r < I0) { transpose_item(SrcWin{w_in}, DM, WIN_T, scr, r / 112, r % 112, lane); continue; } r -= I0;
                if (r < I1) { transpose_item4(Src4Plain{args.in[6], DM}, DM, WOUT_T, scr, r / 32, r % 32, lane); continue; } r -= I1;
                if (r < I2) { transpose_item(SrcPlain{args.in[9], NEXP}, DM, WR_T, scr, r / 2, r % 2, lane); continue; } r -= I2;
                if (r < I3) { transpose_item4(Src4GU{args.in[14], args.in[15]}, DM, WGU_T + (size_t)64 * 512 * DM, scr, r / 16, r % 16, lane); continue; } r -= I3;
                { transpose_item4(Src4Plain{args.in[16], DM}, EFF, WSD_T, scr, r / 32, r % 32, lane); }
            }
        }
        if (BOTH(0)) xcd_barrier(bar);
    }
    if (IN(1)) REP(1) {
        if (vcu < 64 && wave == 0) bias_scan(LOGF, (float*)(ws + WS_BIAS), vcu, lane);
        pg8::Gemm g{(const pg8::bf16_t*)XN, (const pg8::bf16_t*)WIN_T, NX, 3584, DM}; pg8::StaticOrder S; S.init(NX, 3584, G, (int)blockIdx.x);
        LAS float* tabl = (LAS float*)(lds + LDSCTL_OFF + 3072);
        if (tid < 128) tabl[tid] = TAB[tid];
        __syncthreads();
        pg8::EpiInproj E{(pg8::bf16_t*)(ws + WS_RQ), (const LAS float*)tabl};
        pg8::gemm_phase<pg8::EpiInproj, pg8::StaticOrder, true, true>(lds + RING_OFF, g, S, E);
        if (BOTH(1)) xcd_barrier(bar);
    }
    if (IN(2)) {
        static_assert(attn_body::ATTN_LDS_BYTES <= RING_BYTES, "attention LDS");
        float* KV = (float*)args.out;
        unsigned short* PREV = (unsigned short*)((unsigned char*)args.out + 66 * MiB);
        for (int uu = vcu; uu < 1024; uu += G) { int tid_o = tid; asm volatile("" : "+v"(tid_o)); ret_body::ret_kv_unit(uu >> 5, 1 + (uu & 31), ws, KV, (char*)lds_raw + RING_OFF, tid_o); }
        xcd_barrier(bar);
        ret_body::ret_scan(KV, PREV, vcu * (NWAVES * 64) + tid, G * NWAVES * 64);
        qk_norms(ws, vcu * NWAVES + wave, G * NWAVES, lane);
        xcd_barrier(bar);
        REP(2) {
        for (int uu = vcu; uu < 1024; uu += G) { int tid_o = tid; asm volatile("" : "+v"(tid_o)); ret_body::ret_out_unit(uu >> 5, 2 + (uu & 31), ws, PREV, (char*)lds_raw + RING_OFF, tid_o); }
        const int qid = bx & 7;
        for (int dq = 0; dq < 8; ++dq) {
            const int q = (qid + dq) & 7;
            for (;;) {
                if (tid == 0) MISC[0] = __hip_atomic_fetch_add(ctl + CW_Q2 + 64 * q + 512 * rep_, 1u, RLX_AGENT);
                __syncthreads();
                const int grp = (int)MISC[0];
                __syncthreads();
                if (grp >= 128) break;
                {   LAS float* scr = (LAS float*)(lds + wave * 9216);
#pragma unroll 1
                    for (int sub = 0; sub < 3; ++sub) {
                        const int ci = (q * 384 + grp * 3 + sub) * 8 + wave;
                        if (ci < 16384) { const int e = ci >> 8, qq = ci & 255; transpose_item4(Src4GU{args.in[11] + (size_t)e * DM * EFF, args.in[12] + (size_t)e * DM * EFF}, DM, WGU_T + (size_t)e * 512 * DM, scr, qq / 16, qq % 16, lane); }
                        else { const int r = ci - 16384, e = r >> 7, qq = r & 127; transpose_item4(Src4Plain{args.in[13] + (size_t)e * EFF * DM, DM}, EFF, WD_T + (size_t)e * DM * EFF, scr, qq / 32, qq % 32, lane); }
                    }
                    __syncthreads(); }
                int tid_o = tid; asm volatile("" : "+v"(tid_o));
                { const int qb = 15 - (grp >> 3), bh = 8 * q + (grp & 7); attn_body::attn_unit<8>(bh >> 3, bh & 7, qb, ws, (char*)lds_raw + RING_OFF, tid_o); }
            }
        }
        }
        if (BOTH(2)) xcd_barrier(bar);
    }
    if (IN(3)) REP(3) {
        pg8::Gemm g{(const pg8::bf16_t*)(ws + WS_MIXED), (const pg8::bf16_t*)WOUT_T, NX, DM, DM}; pg8::StaticOrder S; S.init(NX, DM, G, (int)blockIdx.x);
        pg8::EpiOutproj E{(pg8::bf16_t*)args.out};
        pg8::gemm_phase<pg8::EpiOutproj, pg8::StaticOrder, true, true>(lds + RING_OFF, g, S, E);
        if (BOTH(3)) xcd_barrier(bar);
    }
    if (IN(4)) REP(4) {
        const int gw = vcu * NWAVES + wave, NGW = G * NWAVES;
        {   uint2 cy[4], ch[4], ny[4], nh[4];
#define LD_ROW(dy, dh, row) do { _Pragma("unroll") for (int j = 0; j < 4; ++j) { dy[j] = ((const uint2*)((const bf16*)args.out + (size_t)(row) * DM))[lane + 64 * j]; dh[j] = ((const uint2*)(XN + (size_t)(row) * DM))[lane + 64 * j]; } } while (0)
            if (gw < NX) LD_ROW(cy, ch, gw);
            for (int row = gw; row < NX; row += NGW) {
                const int nr = row + NGW;
                if (nr < NX) LD_ROW(ny, nh, nr);
                ln_row_f32_to_bf16(cy, ch, args.in[7], args.in[8], XN + (size_t)row * DM, lane);
#pragma unroll
                for (int j = 0; j < 4; ++j) { cy[j] = ny[j]; ch[j] = nh[j]; }
            }
#undef LD_ROW
        }
        if (BOTH(4)) xcd_barrier(bar);
    }
    int* cnt = (int*)(ws + WS_CTL) + CW_CNT; int* TOKL = (int*)(ws + WS_TOKL); float* GATEL = (float*)(ws + WS_GATEL); int* ASG = (int*)(ws + WS_ASG);
    bf16* HID = (bf16*)args.out;
    if (IN(5)) {
        for (int pm = vcu; pm < 128; pm += G) {
            pg8::Gemm g{(const pg8::bf16_t*)XN, (const pg8::bf16_t*)WR_T, NX, 256, DM}; pg8::SingleUnit S{pm, 0, 1};
            pg8::EpiRouter E{args.in[10], cnt, TOKL, GATEL, ASG};
            pg8::gemm_phase<pg8::EpiRouter, pg8::SingleUnit, false, true>(lds + RING_OFF, g, S, E);
        }
        REP(5) { pg8::Gemm g{(const pg8::bf16_t*)XN, (const pg8::bf16_t*)(WGU_T + (size_t)64 * 512 * DM), NX, 512, DM};
          pg8::EpiGU<false> E{(pg8::bf16_t*)(HID + (size_t)HID_S_ROW0 * EFF), nullptr};
          if (G == 256) { pg8::PairOrder S{2 * (vcu - 128), 2 * (vcu - 128) + 1, vcu >= 128 ? 2 : 0, 2};
              pg8::gemm_phase<pg8::EpiGU<false>, pg8::PairOrder, true, true>(lds + RING_OFF, g, S, E); }
          else { pg8::StaticOrder S; S.init(NX, 512, G, (int)blockIdx.x); pg8::gemm_phase<pg8::EpiGU<false>, pg8::StaticOrder, true, true>(lds + RING_OFF, g, S, E); } }
        if (BOTH(5)) xcd_barrier(bar);
    }
    LAS int* tabs = (LAS int*)(lds + LDSCTL_OFF + 4096);
    LAS int* ulist = (LAS int*)(lds + LDSCTL_OFF + 8192);
#define BUILD_UNITS(NPN, nunits_out) do { \
        __syncthreads(); \
        if (tid < 64) tabs[3 * 65 + tid] = cnt[tid]; \
        __syncthreads(); \
        if (tid == 0) { int us = 0, hs = 0, ys = 0; for (int e = 0; e < 64; ++e) { const int c = tabs[3 * 65 + e], nt = (c + 255) >> 8; tabs[e] = us; tabs[65 + e] = hs; tabs[130 + e] = ys; us += nt * (NPN); hs += nt << 8; ys += c; } tabs[64] = us; tabs[129] = hs; tabs[194] = ys; } \
        __syncthreads(); \
        if (tid < 32) { const int Lu = tid * G + vcu; int e = -1; if (Lu < tabs[64]) { int lo_ = 0, hi_ = 63; while (lo_ < hi_) { const int mid = (lo_ + hi_ + 1) >> 1; if (tabs[mid] <= Lu) lo_ = mid; else hi_ = mid - 1; } e = lo_; } \
            LAS int* q_ = ulist + 6 * tid; if (e >= 0) { const int loc = Lu - tabs[e], rt = loc / (NPN), pn = loc % (NPN); q_[0] = e; q_[1] = rt; q_[2] = pn; q_[3] = tabs[65 + e] + (rt << 8); q_[4] = tabs[130 + e] + (rt << 8); q_[5] = tabs[3 * 65 + e] - (rt << 8); } else q_[0] = -1; } \
        __syncthreads(); \
        { const int tot_ = tabs[64]; nunits_out = (tot_ > vcu) ? (tot_ - vcu + G - 1) / G : 0; if (nunits_out > 32) nunits_out = 32; } \
    } while (0)
    if (IN(6)) REP(6) {
        int nun; BUILD_UNITS(2, nun);
        LAS int* tokL = (LAS int*)(lds + LDSCTL_OFF + 16384);
        if (nun > 16) nun = 16;
        for (int i = 0; i < nun; ++i) if (tid < 256) { const LAS int* q_ = ulist + 6 * i; tokL[i * 256 + tid] = (tid < q_[5]) ? TOKL[(size_t)q_[0] * CAP + q_[1] * 256 + tid] : 0; }
        __syncthreads();
        pg8::Gemm g{(const pg8::bf16_t*)XN, (const pg8::bf16_t*)WGU_T, NX, 512, DM}; pg8::GroupOrder<true> S{(const LAS int*)ulist, nun, (const LAS int*)tokL, 512};
        pg8::EpiGU<true> E{(pg8::bf16_t*)HID, (const LAS int*)ulist};
        pg8::gemm_phase<pg8::EpiGU<true>, pg8::GroupOrder<true>, true, true>(lds + RING_OFF, g, S, E);
        {
            const int tot = tabs[64], rem = tot % G, nlight = rem ? G - rem : G, rk = rem ? vcu - rem : vcu;
            pg8::Gemm g2{(const pg8::bf16_t*)(HID + (size_t)HID_S_ROW0 * EFF), (const pg8::bf16_t*)WSD_T, NX, DM, EFF}; pg8::StrideOrder S2{rk, nlight, 512, 4};
            pg8::EpiBase E2{(const pg8::bf16_t*)XN, (pg8::bf16_t*)(ws + WS_BASE2)};
            pg8::gemm_phase<pg8::EpiBase, pg8::StrideOrder, true, true>(lds + RING_OFF, g2, S2, E2); }
        if (BOTH(6)) xcd_barrier(bar);
    }
    if (IN(7)) {
        int nun; BUILD_UNITS(4, nun);
        REP(7) { pg8::Gemm g{(const pg8::bf16_t*)HID, (const pg8::bf16_t*)WD_T, NX, DM, EFF}; pg8::GroupOrder<false> S{(const LAS int*)ulist, nun, nullptr, DM};
          pg8::EpiY E{(unsigned char*)(ws + WS_Y), (const LAS int*)ulist};
          pg8::gemm_phase<pg8::EpiY, pg8::GroupOrder<false>, true, true>(lds + RING_OFF, g, S, E); }
        if (BOTH(7)) xcd_barrier(bar);
    }
    if (IN(8)) REP(8) {
        __syncthreads();
        if (tid == 0) { int a = 0; for (int e = 0; e < 64; ++e) { tabs[e] = a; a += cnt[e]; } }
        __syncthreads();
        const int gw = vcu * NWAVES + wave, NGW = G * NWAVES;
        {
            const bf16* BASE = (const bf16*)(ws + WS_BASE2); const unsigned char* Yp = (const unsigned char*)(ws + WS_Y); const LAS int* ysl = (const LAS int*)tabs;
            FinA A0, A1, A2; FinY Y0, Y1;
            if (gw < NX) { fin_loadA(A0, BASE, ASG, gw, lane); if (gw + NGW < NX) fin_loadA(A1, BASE, ASG, gw + NGW, lane); fin_loadY(Y0, A0, Yp, GATEL, ysl, lane); }
            for (int tok = gw; tok < NX; tok += NGW) {
                if (tok + 2 * NGW < NX) fin_loadA(A2, BASE, ASG, tok + 2 * NGW, lane);
                if (tok + NGW < NX) fin_loadY(Y1, A1, Yp, GATEL, ysl, lane);
                fin_compute(A0, Y0, args.in[17], args.in[18], args.out, tok, lane);
                A0 = A1; A1 = A2; Y0 = Y1;
            }
        }
    }
#undef BUILD_UNITS
#undef REP
#undef IN
#undef BOTH
}

extern "C" void kernel_launch(void* const* d_in, const int* in_sizes, int n_in, void* d_out, int out_size, void* d_ws, size_t ws_size, hipStream_t stream) {
    if (n_in != 19 || ws_size < WS_END || out_size != NX * DM) { fprintf(stderr, "kernel_launch: unexpected sizes n_in=%d ws=%zu out=%d\n", n_in, ws_size, out_size); return; }
    static int grid = 0;
    if (grid == 0) {
        int dev = 0, cus = 0, per_cu = 0;
        if (hipGetDevice(&dev) != hipSuccess || hipDeviceGetAttribute(&cus, hipDeviceAttributeMultiprocessorCount, dev) != hipSuccess) { fprintf(stderr, "kernel_launch: device query failed\n"); grid = -1; return; }
        if (hipFuncSetAttribute((const void*)mega, hipFuncAttributeMaxDynamicSharedMemorySize, LDS_BYTES) != hipSuccess) { fprintf(stderr, "kernel_launch: hipFuncSetAttribute failed\n"); grid = -1; return; }
        if (hipOccupancyMaxActiveBlocksPerMultiprocessor(&per_cu, (const void*)mega, NWAVES * 64, LDS_BYTES) != hipSuccess || per_cu < 1) { fprintf(stderr, "kernel_launch: occupancy query says %d blocks per CU\n", per_cu); grid = -1; return; }
        (void)hipGetLastError();
        grid = cus;
    }
    if (grid < 0) return;
    const float* x = (const float*)d_in[0];
    const float* w_out = (const float*)d_in[6];
    const float* ln1_g = (const float*)d_in[7]; const float* ln1_b = (const float*)d_in[8]; const float* w_router = (const float*)d_in[9]; const float* router_bias = (const float*)d_in[10];
    const float* we_gate = (const float*)d_in[11]; const float* we_up = (const float*)d_in[12]; const float* we_down = (const float*)d_in[13];
    const float* ws_gate = (const float*)d_in[14]; const float* ws_up = (const float*)d_in[15]; const float* ws_down = (const float*)d_in[16];
    const float* ln2_g = (const float*)d_in[17]; const float* ln2_b = (const float*)d_in[18];
    (void)x;
    unsigned char* ws = (unsigned char*)d_ws; float* out = (float*)d_out;
    int* cnt = (int*)(ws + WS_CTL) + CW_CNT;
    float* LOGF = (float*)(ws + WS_LOGF); float* BIAS = (float*)(ws + WS_BIAS); int* ASG = (int*)(ws + WS_ASG); int* TOKL = (int*)(ws + WS_TOKL); float* GATEL = (float*)(ws + WS_GATEL);
    float* LOGITS = (float*)(ws + WS_LOGITS); bf16_t* XN = (bf16_t*)(ws + WS_XN); bf16_t* H1 = XN;
    bf16_t* RQ = (bf16_t*)(ws + WS_RQ); bf16_t* RK = RQ + BUFE; bf16_t* RV = RQ + 2 * BUFE; bf16_t* RG = RQ + 3 * BUFE; bf16_t* FQ = RQ + 4 * BUFE; bf16_t* FK = RQ + 5 * BUFE; bf16_t* FV = RQ + 6 * BUFE;
    bf16_t* MIXED = (bf16_t*)(ws + WS_MIXED); bf16_t* Y = (bf16_t*)(ws + WS_Y);
    float* yb = out;
    bf16_t* HID = (bf16_t*)d_out;

    (void)hipMemsetAsync(ws + WS_CTL, 0, 1 * MiB, stream);
    Args a{};
    for (int i = 0; i < 19; ++i) a.in[i] = (const float*)d_in[i];
#if defined(PROBE_HOST)
    a.out = out; a.ws = ws; a.ph_lo = 0; a.ph_hi = PROBE_HOST + 1;
    { void* kargs[] = {&a}; (void)hipLaunchCooperativeKernel((const void*)mega, dim3(grid), dim3(NWAVES * 64), kargs, LDS_BYTES, stream); }
    (void)hipMemsetAsync(ws + WS_CTL, 0, 1 * MiB, stream);
#endif
    a.out = out; a.ws = ws; a.ph_lo = 0; a.ph_hi = 9;
    { void* kargs[] = {&a}; hipError_t e = hipLaunchCooperativeKernel((const void*)mega, dim3(grid), dim3(NWAVES * 64), kargs, LDS_BYTES, stream);
      if (e != hipSuccess) fprintf(stderr, "kernel_launch: cooperative launch failed: %s\n", hipGetErrorString(e)); }
}
```
